# Optimizing an MI355X kernel written in HIP

```python
import math
import jax, jax.numpy as jnp
from jax import lax
import numpy as np


D_MODEL = 2048
BATCH = 2
SEQ = 16384
DEPTH = 2

GRID_W = 64
CTX_LEN = 256
EPS = 1e-6
NEG_INF = -1e30
HEAD_DIM = 64

NA_WIDTH = D_MODEL // 4
NA_HEADS = NA_WIDTH // HEAD_DIM
NA_WIN_R = 8
NA_WIN_C = 16

GLA_WIDTH = D_MODEL // 4
GLA_HEADS = 4
GLA_DV = GLA_WIDTH // GLA_HEADS
GLA_DK = GLA_DV // 2
GLA_GATE_RANK = 16
GLA_NORMALIZER = 16.0
GLA_CHUNK = 64

DIFF_WIDTH = D_MODEL // 2
DIFF_DV = 2 * HEAD_DIM
DIFF_DK = HEAD_DIM
DIFF_HEADS = DIFF_WIDTH // DIFF_DV
ATTN_BLOCK = 128
ROPE_BASE = 10000.0

MIX_WIDTH = NA_WIDTH + GLA_WIDTH + DIFF_WIDTH
NA_IN = 3 * NA_WIDTH
GLA_IN = 2 * GLA_HEADS * GLA_DK + 2 * GLA_WIDTH + 2 * GLA_GATE_RANK
DIFF_IN = 2 * DIFF_HEADS * 2 * DIFF_DK + DIFF_WIDTH
IN_WIDTH = NA_IN + GLA_IN + DIFF_IN
MLP_HIDDEN = 4 * D_MODEL

kernel_name = 'hybrid_na_gla_diffattn_dit_block'


def rms_norm(x, g):
    xf = x.astype(jnp.float32)
    y = xf * lax.rsqrt(jnp.mean(xf * xf, axis=-1, keepdims=True) + EPS)
    return (y * g.astype(jnp.float32)).astype(x.dtype)


def split_groups(p):
    return jnp.split(p, [NA_IN, NA_IN + GLA_IN], axis=-1)


def axial_rope_tables(n_tokens, dim):
    t = jnp.arange(n_tokens, dtype=jnp.int32)
    row = (t // GRID_W).astype(jnp.float32)
    col = (t % GRID_W).astype(jnp.float32)
    n_freq = dim // 4
    inv = ROPE_BASE ** (-jnp.arange(n_freq, dtype=jnp.float32) / n_freq)
    ang = jnp.concatenate([row[:, None] * inv, col[:, None] * inv], axis=-1)
    return jnp.cos(ang), jnp.sin(ang)


def apply_rope(x, cos, sin):
    half = x.shape[-1] // 2
    shp = (1, cos.shape[0]) + (1,) * (x.ndim - 3) + (half,)
    cs, sn = cos.reshape(shp), sin.reshape(shp)
    xf = x.astype(jnp.float32)
    x1, x2 = xf[..., :half], xf[..., half:]
    return jnp.concatenate([x1 * cs - x2 * sn, x1 * sn + x2 * cs], axis=-1).astype(x.dtype)


def dense_softmax_attention(q, k, v):
    s = jnp.einsum('bnhd,bmhd->bhnm', q, k).astype(jnp.float32) * (q.shape[-1] ** -0.5)
    p = jax.nn.softmax(s, axis=-1).astype(v.dtype)
    return jnp.einsum('bhnm,bmhd->bnhd', p, v)


def neighbourhood_attention(p_lat, p_ctx, rel_bias, need_ctx_out):
    B, T, _ = p_lat.shape
    N = p_ctx.shape[1]
    H, d = NA_HEADS, HEAD_DIM
    rows = T // GRID_W
    wr, wc = min(NA_WIN_R, rows), NA_WIN_C
    q, k, v = [z.reshape(B, T, H, d) for z in jnp.split(p_lat, 3, axis=-1)]
    qc, kc, vc = [z.reshape(B, N, H, d) for z in jnp.split(p_ctx, 3, axis=-1)]
    r = jnp.arange(rows, dtype=jnp.int32)
    col = jnp.arange(GRID_W, dtype=jnp.int32)
    key_rows = jnp.clip(r - wr // 2, 0, rows - wr)[:, None] + jnp.arange(wr, dtype=jnp.int32)[None, :]
    c0 = jnp.clip(col - wc // 2, 0, GRID_W - wc)
    col_ok = (col[None, :] >= c0[:, None]) & (col[None, :] < c0[:, None] + wc)
    dr = key_rows - r[:, None] + (NA_WIN_R - 1)
    dc = jnp.clip(col[None, :] - col[:, None] + (NA_WIN_C - 1), 0, 2 * NA_WIN_C - 2)
    bias = rel_bias[:, dr[:, None, :, None], dc[None, :, None, :]].astype(jnp.float32)
    qg = q.reshape(B, rows, GRID_W, H, d)
    kg = k.reshape(B, rows, GRID_W, H, d)[:, key_rows]
    vg = v.reshape(B, rows, GRID_W, H, d)[:, key_rows]
    scale = d ** -0.5
    s_loc = jnp.einsum('brqhd,brjkhd->bhrqjk', qg, kg).astype(jnp.float32) * scale + bias[None]
    s_loc = jnp.where(col_ok[:, None, :], s_loc, NEG_INF).reshape(B, H, rows, GRID_W, wr * GRID_W)
    s_ctx = jnp.einsum('brqhd,bnhd->bhrqn', qg, kc).astype(jnp.float32) * scale
    p = jax.nn.softmax(jnp.concatenate([s_loc, s_ctx], axis=-1), axis=-1).astype(v.dtype)
    p_loc = p[..., : wr * GRID_W].reshape(B, H, rows, GRID_W, wr, GRID_W)
    p_ctx = p[..., wr * GRID_W:]
    o = jnp.einsum('bhrqjk,brjkhd->brqhd', p_loc, vg) + jnp.einsum('bhrqn,bnhd->brqhd', p_ctx, vc)
    o = o.reshape(B, T, H * d)
    oc = dense_softmax_attention(qc, kc, vc).reshape(B, N, H * d) if need_ctx_out else None
    return o, oc


def gla_split(p, w_gate, b_gate):
    B, n, _ = p.shape
    hk = GLA_HEADS * GLA_DK
    q, k, v, g, a = jnp.split(p, [hk, 2 * hk, 2 * hk + GLA_WIDTH, 2 * hk + 2 * GLA_WIDTH], axis=-1)
    q = q.reshape(B, n, GLA_HEADS, GLA_DK) * (GLA_DK ** -0.5)
    k = k.reshape(B, n, GLA_HEADS, GLA_DK)
    v = v.reshape(B, n, GLA_HEADS, GLA_DV)
    a = a.reshape(B, n, 2, GLA_GATE_RANK)
    pre = jnp.einsum('bnzr,zrk->bnzk', a, w_gate).astype(jnp.float32) + b_gate.astype(jnp.float32)
    log_a = (jax.nn.log_sigmoid(pre) / GLA_NORMALIZER).reshape(B, n, 2, GLA_HEADS, GLA_DK)
    return q, k, v, g, log_a[:, :, 0], log_a[:, :, 1]


def gla_chunked(q, k, v, log_a, s0, strict):
    B, T, H, dk = q.shape
    dv = v.shape[-1]
    n = T // GLA_CHUNK

    def blocks(z):
        return z.astype(jnp.float32).reshape(B, n, GLA_CHUNK, H, z.shape[-1]).transpose(1, 0, 3, 2, 4)

    mask = jnp.tril(jnp.ones((GLA_CHUNK, GLA_CHUNK), dtype=bool), k=-1 if strict else 0)

    def step(S, inp):
        qc, kc, vc, gc = inp
        b = jnp.cumsum(gc, axis=-2)
        b_last = b[..., -1:, :]
        q_in = qc * jnp.exp(b)
        att = jnp.where(mask, jnp.einsum('bhtd,bhsd->bhts', q_in, kc * jnp.exp(-b)), 0.0)
        o = jnp.einsum('bhts,bhsv->bhtv', att, vc) + jnp.einsum('bhtd,bhdv->bhtv', q_in, S)
        S_new = jnp.exp(b_last[..., 0, :])[..., None] * S + jnp.einsum('bhsd,bhsv->bhdv', kc * jnp.exp(b_last - b), vc)
        return S_new, o

    S, o = lax.scan(step, s0, (blocks(q), blocks(k), blocks(v), blocks(log_a)))
    return o.transpose(1, 0, 3, 2, 4).reshape(B, T, H, dv), S


def gla_final_state(k, v, log_a):
    b = jnp.cumsum(log_a.astype(jnp.float32), axis=1)
    w = jnp.exp(b[:, -1:] - b)
    return jnp.einsum('bthd,bthv->bhdv', k.astype(jnp.float32) * w, v.astype(jnp.float32))


def gla_output(o, g, g_norm):
    B, n = g.shape[:2]
    o = rms_norm(o, g_norm) * jax.nn.silu(g.reshape(B, n, GLA_HEADS, GLA_DV).astype(jnp.float32))
    return o.astype(g.dtype).reshape(B, n, GLA_WIDTH)


def gla_mixer(p_lat, p_ctx, w_gate, b_gate, g_norm, need_ctx_out):
    q, k, v, g, la_f, la_b = gla_split(p_lat, w_gate, b_gate)
    qc, kc, vc, gc, lac_f, lac_b = gla_split(p_ctx, w_gate, b_gate)
    flip = lambda z: jnp.flip(z, axis=1)
    B = q.shape[0]
    if need_ctx_out:
        zeros = jnp.zeros((B, GLA_HEADS, GLA_DK, GLA_DV), jnp.float32)
        oc_f, S_f = gla_chunked(qc, kc, vc, lac_f, zeros, False)
        oc_b, S_b = gla_chunked(flip(qc), flip(kc), flip(vc), flip(lac_b), zeros, True)
        oc = gla_output(oc_f + flip(oc_b), gc, g_norm)
    else:
        S_f = gla_final_state(kc, vc, lac_f)
        S_b = gla_final_state(flip(kc), flip(vc), flip(lac_b))
        oc = None
    o_f, _ = gla_chunked(q, k, v, la_f, S_f, False)
    o_b, _ = gla_chunked(flip(q), flip(k), flip(v), flip(la_b), S_b, True)
    return gla_output(o_f + flip(o_b), g, g_norm), oc


def diff_attention(p_lat, p_ctx, lam_params, g_norm, layer_idx, need_ctx_out):
    B, T, _ = p_lat.shape
    N = p_ctx.shape[1]
    H, dk, dv = DIFF_HEADS, DIFF_DK, DIFF_DV
    qk_w = H * 2 * dk
    lam_init = 0.8 - 0.6 * math.exp(-0.3 * layer_idx)
    lp = lam_params.astype(jnp.float32)
    lam = jnp.exp(jnp.sum(lp[0] * lp[1])) - jnp.exp(jnp.sum(lp[2] * lp[3])) + lam_init

    def split(p, n):
        q, k, v = jnp.split(p, [qk_w, 2 * qk_w], axis=-1)
        return q.reshape(B, n, H, 2, dk), k.reshape(B, n, H, 2, dk), v.reshape(B, n, H, dv)

    q, k, v = split(p_lat, T)
    qc, kc, vc = split(p_ctx, N)
    cos, sin = axial_rope_tables(T, dk)
    q, k = apply_rope(q, cos, sin), apply_rope(k, cos, sin)
    scale = dk ** -0.5

    def diff_weights(s):
        p = jax.nn.softmax(s * scale, axis=-1)
        return (p[:, :, 0] - lam * p[:, :, 1]).astype(v.dtype)

    def attend(q_blk):
        s = jnp.concatenate([jnp.einsum('bqhpd,bkhpd->bhpqk', q_blk, k).astype(jnp.float32),
                             jnp.einsum('bqhpd,bnhpd->bhpqn', q_blk, kc).astype(jnp.float32)], axis=-1)
        a = diff_weights(s)
        return jnp.einsum('bhqk,bkhv->bqhv', a[..., :T], v) + jnp.einsum('bhqn,bnhv->bqhv', a[..., T:], vc)

    n_blk = T // ATTN_BLOCK
    q_blocks = q.reshape(B, n_blk, ATTN_BLOCK, H, 2, dk).transpose(1, 0, 2, 3, 4, 5)
    o = lax.map(attend, q_blocks).transpose(1, 0, 2, 3, 4).reshape(B, T, H, dv)
    o = (rms_norm(o, g_norm) * (1.0 - lam_init)).reshape(B, T, H * dv)
    if need_ctx_out:
        a = diff_weights(jnp.einsum('bnhpd,bmhpd->bhpnm', qc, kc).astype(jnp.float32))
        oc = jnp.einsum('bhnm,bmhv->bnhv', a, vc)
        oc = (rms_norm(oc, g_norm) * (1.0 - lam_init)).reshape(B, N, H * dv)
    else:
        oc = None
    return o, oc


def sq_relu_mlp(h, w1, w2):
    return jnp.square(jax.nn.relu(h @ w1)) @ w2


def setup_inputs(seed: int = 0) -> dict:
    key = jax.random.key(seed)
    ks = jax.random.split(key, 20)
    D = D_MODEL

    def nrm(k, shape, scale):
        return jax.random.normal(k, shape, jnp.float32) * scale

    return {
        'x': nrm(ks[0], (BATCH, SEQ, D), 1.0),
        'c': nrm(ks[1], (BATCH, D), 1.0),
        'ctx': nrm(ks[2], (BATCH, CTX_LEN, D), 1.0),
        'c_ctx': nrm(ks[3], (D,), 1.0),
        'w_ada': nrm(ks[4], (DEPTH, D, 6 * D), 0.5 * D ** -0.5),
        'b_ada': nrm(ks[5], (DEPTH, 6 * D), 0.02),
        'g_pre_mix': 1.0 + nrm(ks[6], (DEPTH, D), 0.05),
        'g_post_mix': 1.0 + nrm(ks[7], (DEPTH, D), 0.05),
        'g_pre_mlp': 1.0 + nrm(ks[8], (DEPTH, D), 0.05),
        'g_post_mlp': 1.0 + nrm(ks[9], (DEPTH, D), 0.05),
        'w_in': nrm(ks[10], (DEPTH, D, IN_WIDTH), D ** -0.5),
        'w_out': nrm(ks[11], (DEPTH, MIX_WIDTH, D), MIX_WIDTH ** -0.5),
        'na_rel_bias': nrm(ks[12], (DEPTH, NA_HEADS, 2 * NA_WIN_R - 1, 2 * NA_WIN_C - 1), 0.5),
        'gla_w_gate': nrm(ks[13], (DEPTH, 2, GLA_GATE_RANK, GLA_HEADS * GLA_DK), GLA_GATE_RANK ** -0.5),
        'gla_b_gate': nrm(ks[14], (DEPTH, 2, GLA_HEADS * GLA_DK), 0.1),
        'gla_g_norm': 1.0 + nrm(ks[15], (DEPTH, GLA_DV), 0.05),
        'diff_lambda': nrm(ks[16], (DEPTH, 4, DIFF_DK), 0.1),
        'diff_g_norm': 1.0 + nrm(ks[17], (DEPTH, DIFF_DV), 0.05),
        'w_mlp_in': nrm(ks[18], (DEPTH, D, MLP_HIDDEN), D ** -0.5),
        'w_mlp_out': nrm(ks[19], (DEPTH, MLP_HIDDEN, D), MLP_HIDDEN ** -0.5),
    }


def reference(x, c, ctx, c_ctx, w_ada, b_ada, g_pre_mix, g_post_mix, g_pre_mlp, g_post_mlp,
              w_in, w_out, na_rel_bias, gla_w_gate, gla_b_gate, gla_g_norm, diff_lambda,
              diff_g_norm, w_mlp_in, w_mlp_out):
    B, T, D = x.shape
    h_ctx = ctx
    for l in range(DEPTH):
        need_ctx = l < DEPTH - 1
        mx = (jax.nn.silu(c) @ w_ada[l] + b_ada[l]).reshape(B, 6, 1, D)
        mc = (jax.nn.silu(c_ctx) @ w_ada[l] + b_ada[l]).reshape(6, D)
        hx = rms_norm(x, g_pre_mix[l]) * (1 + mx[:, 1]) + mx[:, 0]
        hc = rms_norm(h_ctx, g_pre_mix[l]) * (1 + mc[1]) + mc[0]
        na_x, gla_x, diff_x = split_groups(hx @ w_in[l])
        na_c, gla_c, diff_c = split_groups(hc @ w_in[l])
        ya, ya_c = neighbourhood_attention(na_x, na_c, na_rel_bias[l], need_ctx)
        yb, yb_c = gla_mixer(gla_x, gla_c, gla_w_gate[l], gla_b_gate[l], gla_g_norm[l], need_ctx)
        yd, yd_c = diff_attention(diff_x, diff_c, diff_lambda[l], diff_g_norm[l], l, need_ctx)
        y = jnp.concatenate([ya, yb, yd], axis=-1) @ w_out[l]
        x = x + mx[:, 2] * rms_norm(y, g_post_mix[l])
        hx = rms_norm(x, g_pre_mlp[l]) * (1 + mx[:, 4]) + mx[:, 3]
        x = x + mx[:, 5] * rms_norm(sq_relu_mlp(hx, w_mlp_in[l], w_mlp_out[l]), g_post_mlp[l])
        if need_ctx:
            yc = jnp.concatenate([ya_c, yb_c, yd_c], axis=-1) @ w_out[l]
            h_ctx = h_ctx + mc[2] * rms_norm(yc, g_post_mix[l])
            hc = rms_norm(h_ctx, g_pre_mlp[l]) * (1 + mc[4]) + mc[3]
            h_ctx = h_ctx + mc[5] * rms_norm(sq_relu_mlp(hc, w_mlp_in[l], w_mlp_out[l]), g_post_mlp[l])
    return x
```

```cpp
#include <hip/hip_runtime.h>
#include <hip/hip_cooperative_groups.h>
#include <cstdio>
#include <cstdint>
namespace cg = cooperative_groups;
__device__ __forceinline__ int otid() { int t = threadIdx.x; asm volatile("" : "+v"(t)); return t; }
__device__ __forceinline__ int obid() { int t = blockIdx.x; asm volatile("" : "+s"(t)); return t; }
namespace pg8 {
#define PG8_LAS __attribute__((address_space(3)))
typedef unsigned short bf16_t;
typedef short bf16x8 __attribute__((ext_vector_type(8)));
typedef float f32x4 __attribute__((ext_vector_type(4)));
typedef unsigned u32x4 __attribute__((ext_vector_type(4)));
constexpr int BM = 256, BK = 64, HALF = 128, HTB = HALF * BK * 2  , STAGE_BYTES = 8 * HTB, NXCD = 8, WGM = 8;

__host__ __device__ __forceinline__ int lds_byte(int r, int c) { const int st = (r >> 4) * 2 + (c >> 5), rr = r & 15, cc = c & 31, ob = rr * 64 + cc * 2; return st * 1024 + (ob ^ (((ob >> 9) & 1) << 5)); }
__host__ __device__ __forceinline__ void stage_rc(int b, int& R, int& C) { const int st = b / 1024, sb = b % 1024, swz = sb ^ (((sb >> 9) & 1) << 5); R = (st >> 1) * 16 + swz / 64; C = (st & 1) * 32 + (swz % 64) / 2; }
__host__ __device__ __forceinline__ int perm32(int rho) { const int n = rho >> 4, i = rho & 15; return 8 * (i >> 2) + 4 * n + (i & 3); }

struct Unit { int pm, pn; };
struct Gemm { const bf16_t* A; const bf16_t* Bt; int M, N, K; };

struct StaticOrder {
    int nM, nN, nwg, G, c;
    __host__ __device__ void init(int M, int N, int G_, int c_) { nM = M / BM; nN = N / BM; nwg = nM * nN; G = G_; c = c_; }
    __host__ __device__ bool next(int i, Unit& u) const {
        const long L = (long)i * G + c; if (L >= nwg) return false;
        int wgid = (int)L; { const int q = nwg / NXCD, r = nwg % NXCD, xcd = wgid % NXCD, off = wgid / NXCD; wgid = (xcd < r ? xcd * (q + 1) : r * (q + 1) + (xcd - r) * q) + off; }
        const int nig = WGM * nN, gid = wgid / nig, fm = gid * WGM, gsz = (nM - fm) < WGM ? (nM - fm) : WGM;
        u.pm = fm + ((wgid % nig) % gsz); u.pn = (wgid % nig) / gsz; return true;
    }
    __device__ __forceinline__ void a_ready(const Unit&) const {}
    __device__ __forceinline__ void done(const Unit&) const {}
};

__device__ __forceinline__ unsigned cvt_pk_bf16(float lo, float hi) { unsigned r; asm volatile("v_cvt_pk_bf16_f32 %0, %1, %2" : "=v"(r) : "v"(lo), "v"(hi)); return r; }
typedef float f32x2 __attribute__((ext_vector_type(2)));
struct EpiAct {
    static constexpr bool PERM = true, AFTER_DRAIN = false;
    bf16_t* O; int ldc; int act;
    __device__ __forceinline__ void operator()(const f32x4 (&acc)[2][2][4][2], const Unit& u, int wr, int wc, int fr, int fq) const {
        const int row0 = u.pm * BM + wr * 64 + fr; const int col0 = u.pn * BM + wc * 32 + 8 * fq;
#pragma unroll
        for (int ai = 0; ai < 2; ++ai)
#pragma unroll
            for (int m = 0; m < 4; ++m) { bf16_t* rowp = O + (size_t)(row0 + ai * HALF + m * 16) * ldc + col0;
#pragma unroll
                for (int bj = 0; bj < 2; ++bj) { f32x4 v0 = acc[ai][bj][m][0], v1 = acc[ai][bj][m][1];
                    if (act) {
#pragma unroll
                        for (int e = 0; e < 4; ++e) { float a = fmaxf(v0[e], 0.f), b = fmaxf(v1[e], 0.f); v0[e] = a * a; v1[e] = b * b; } }
                    u32x4 w; w.x = cvt_pk_bf16(v0[0], v0[1]); w.y = cvt_pk_bf16(v0[2], v0[3]); w.z = cvt_pk_bf16(v1[0], v1[1]); w.w = cvt_pk_bf16(v1[2], v1[3]);
                    *(u32x4*)(rowp + bj * HALF) = w; } }
    }
};
template <class Epi, class Sched, bool ALIGN_EPI = false, bool SP2 = false>
__device__ __forceinline__ void gemm_phase(PG8_LAS unsigned char* lds, const Gemm g, const Sched& S, const Epi& E) {
    const int tid = otid(), wid = __builtin_amdgcn_readfirstlane(tid >> 6), lane = tid & 63, wr = wid >> 2, wc = wid & 3, fr = lane & 15, fq = lane >> 4;
    const int K = g.K, nt = K / BK;
    unsigned voffA[2], voffB[2];
#pragma unroll
    for (int i = 0; i < 2; ++i) { int R, C; stage_rc(tid * 16 + i * 8192, R, C); const int Rb = Epi::PERM ? ((R & ~31) + perm32(R & 31)) : R;
        voffA[i] = (unsigned)(R * K + C) * 2u; voffB[i] = (unsigned)(Rb * K + C) * 2u; }
    const size_t kstep = (size_t)(BK * 2);
    const size_t hstep = (size_t)HALF * K * 2;
    const size_t tstep = 2 * hstep;
    const unsigned ldsw = (unsigned)wid * 1024u;
    const int aoff = lds_byte(wr * 64 + fr, fq * 8), boff = lds_byte(wc * 32 + fr, fq * 8);
#define PG8_SA(b, h) (((b) * 2 + (h)) * HTB)
#define PG8_SB(b, h) ((4 + (b) * 2 + (h)) * HTB)
#define PG8_STAGE(bufoff, gbase, voff) do { _Pragma("unroll") for (int _i = 0; _i < 2; ++_i) \
        __builtin_amdgcn_global_load_lds((const unsigned*)((const char*)(gbase) + (voff)[_i]), (PG8_LAS unsigned*)(lds + (bufoff) + ldsw + _i * 8192), 16, 0, 0); } while (0)
#define PG8_LDA(dst, b, h) do { _Pragma("unroll") for (int m = 0; m < 4; ++m) _Pragma("unroll") for (int k = 0; k < 2; ++k) dst[m][k] = *(const PG8_LAS bf16x8*)(lds + PG8_SA(b, h) + aoff + m * 2048 + k * 1024); } while (0)
#define PG8_LDB(dst, b, h) do { _Pragma("unroll") for (int n = 0; n < 2; ++n) _Pragma("unroll") for (int k = 0; k < 2; ++k) dst[n][k] = *(const PG8_LAS bf16x8*)(lds + PG8_SB(b, h) + boff + n * 2048 + k * 1024); } while (0)
#define PG8_MMA(ai, bj, At, Bt) do { __builtin_amdgcn_s_setprio(1); _Pragma("unroll") for (int m = 0; m < 4; ++m) _Pragma("unroll") for (int n = 0; n < 2; ++n) _Pragma("unroll") for (int k = 0; k < 2; ++k) \
        acc[ai][bj][m][n] = __builtin_amdgcn_mfma_f32_16x16x32_bf16(Bt[n][k], At[m][k], acc[ai][bj][m][n], 0, 0, 0); __builtin_amdgcn_s_setprio(0); } while (0)
#define PG8_WAIT_V(n) asm volatile("s_waitcnt vmcnt(" #n ")" ::: "memory")
#define PG8_WAIT_L(n) asm volatile("s_waitcnt lgkmcnt(" #n ")" ::: "memory")
#define PG8_BAR __builtin_amdgcn_s_barrier()
#define PG8_SCHED __builtin_amdgcn_sched_barrier(0)
    Unit cur, nxt; int ui = 0;
    if (!S.next(0, cur)) return;
    f32x4 acc[2][2][4][2];
#pragma unroll
    for (int a = 0; a < 2; ++a)
#pragma unroll
        for (int b = 0; b < 2; ++b)
#pragma unroll
            for (int m = 0; m < 4; ++m)
#pragma unroll
                for (int n = 0; n < 2; ++n) acc[a][b][m][n] = (f32x4){0.f, 0.f, 0.f, 0.f};
    bf16x8 At[4][2], B0[2][2], B1[2][2];
    const char* cA = (const char*)g.A + (size_t)cur.pm * tstep; const char* cB = (const char*)g.Bt + (size_t)cur.pn * tstep;
    S.a_ready(cur);
    if constexpr (SP2) {
        PG8_STAGE(PG8_SB(0, 0), cB, voffB); PG8_STAGE(PG8_SB(0, 1), cB + hstep, voffB); PG8_STAGE(PG8_SA(0, 0), cA, voffA); PG8_STAGE(PG8_SA(0, 1), cA + hstep, voffA);
        if (wr == 1) PG8_BAR;
        PG8_WAIT_V(2); PG8_BAR;
        PG8_STAGE(PG8_SB(1, 0), cB + kstep, voffB); PG8_STAGE(PG8_SA(1, 0), cA + kstep, voffA); PG8_STAGE(PG8_SB(1, 1), cB + hstep + kstep, voffB);
        PG8_WAIT_V(6); PG8_BAR;
    } else {
        PG8_STAGE(PG8_SB(0, 0), cB, voffB); PG8_STAGE(PG8_SA(0, 0), cA, voffA); PG8_STAGE(PG8_SB(0, 1), cB + hstep, voffB); PG8_STAGE(PG8_SA(0, 1), cA + hstep, voffA);
        if (wr == 1) PG8_BAR;
        PG8_WAIT_V(4); PG8_BAR;
        PG8_STAGE(PG8_SB(1, 0), cB + kstep, voffB); PG8_STAGE(PG8_SA(1, 0), cA + kstep, voffA); PG8_STAGE(PG8_SB(1, 1), cB + hstep + kstep, voffB);
        PG8_WAIT_V(6); PG8_BAR;
    }
    for (;;) {
        const bool has_next = S.next(ui + 1, nxt);
        const char* nA = has_next ? (const char*)g.A + (size_t)nxt.pm * tstep : cA; const char* nB = has_next ? (const char*)g.Bt + (size_t)nxt.pn * tstep : cB;
        for (int t = 0; t < nt; t += 2) {
            const bool last = (t == nt - 2);
            const char* a1 = cA + (size_t)(t + 1) * kstep;
            const char* a2 = last ? nA : cA + (size_t)(t + 2) * kstep; const char* b2 = last ? nB : cB + (size_t)(t + 2) * kstep;
            const char* a3 = a2 + kstep; const char* b3 = b2 + kstep;
            if (last && has_next) S.a_ready(nxt);
            if constexpr (SP2) {
            PG8_LDB(B0, 0, 0); PG8_LDB(B1, 0, 1); PG8_SCHED; PG8_LDA(At, 0, 0); PG8_STAGE(PG8_SA(1, 1), a1 + hstep, voffA);
            PG8_WAIT_V(8); PG8_WAIT_L(0); PG8_BAR; PG8_MMA(0, 0, At, B0); PG8_MMA(0, 1, At, B1); PG8_BAR; PG8_SCHED;
            PG8_LDA(At, 0, 1); PG8_STAGE(PG8_SB(0, 0), b2, voffB); PG8_STAGE(PG8_SB(0, 1), b2 + hstep, voffB); PG8_STAGE(PG8_SA(0, 0), a2, voffA);
            PG8_WAIT_V(8); PG8_WAIT_L(0); PG8_BAR; PG8_MMA(1, 0, At, B0); PG8_MMA(1, 1, At, B1); PG8_BAR; PG8_SCHED;
            PG8_LDB(B0, 1, 0); PG8_LDB(B1, 1, 1); PG8_SCHED; PG8_LDA(At, 1, 0); PG8_STAGE(PG8_SA(0, 1), a2 + hstep, voffA);
            PG8_WAIT_V(8); PG8_WAIT_L(0); PG8_BAR; PG8_MMA(0, 0, At, B0); PG8_MMA(0, 1, At, B1); PG8_BAR; PG8_SCHED;
            PG8_LDA(At, 1, 1); PG8_STAGE(PG8_SB(1, 0), b3, voffB); PG8_STAGE(PG8_SB(1, 1), b3 + hstep, voffB); PG8_STAGE(PG8_SA(1, 0), a3, voffA);
            PG8_WAIT_V(8); PG8_WAIT_L(0); PG8_BAR; PG8_MMA(1, 0, At, B0); PG8_MMA(1, 1, At, B1); PG8_BAR; PG8_SCHED;
            } else {
            PG8_LDB(B0, 0, 0); PG8_SCHED; PG8_LDA(At, 0, 0); PG8_STAGE(PG8_SA(1, 1), a1 + hstep, voffA);
            PG8_WAIT_L(8); PG8_BAR; PG8_WAIT_L(0); PG8_MMA(0, 0, At, B0); PG8_BAR; PG8_SCHED;
            PG8_LDB(B1, 0, 1); PG8_STAGE(PG8_SB(0, 0), b2, voffB);
            PG8_BAR; PG8_WAIT_L(0); PG8_MMA(0, 1, At, B1); PG8_BAR;
            PG8_LDA(At, 0, 1); PG8_STAGE(PG8_SA(0, 0), a2, voffA);
            PG8_BAR; PG8_WAIT_L(0); PG8_MMA(1, 0, At, B0); PG8_BAR; PG8_SCHED;
            PG8_STAGE(PG8_SB(0, 1), b2 + hstep, voffB);
            PG8_WAIT_V(6); PG8_BAR; PG8_MMA(1, 1, At, B1); PG8_BAR;
            PG8_LDB(B0, 1, 0); PG8_SCHED; PG8_LDA(At, 1, 0); PG8_STAGE(PG8_SA(0, 1), a2 + hstep, voffA);
            PG8_WAIT_L(8); PG8_BAR; PG8_WAIT_L(0); PG8_MMA(0, 0, At, B0); PG8_BAR; PG8_SCHED;
            PG8_LDB(B1, 1, 1); PG8_STAGE(PG8_SB(1, 0), b3, voffB);
            PG8_BAR; PG8_WAIT_L(0); PG8_MMA(0, 1, At, B1); PG8_BAR;
            PG8_LDA(At, 1, 1); PG8_STAGE(PG8_SA(1, 0), a3, voffA);
            PG8_BAR; PG8_WAIT_L(0); PG8_MMA(1, 0, At, B0); PG8_BAR; PG8_SCHED;
            PG8_STAGE(PG8_SB(1, 1), b3 + hstep, voffB);
            PG8_WAIT_V(6); PG8_BAR; PG8_MMA(1, 1, At, B1); PG8_BAR;
            }
        }
        if constexpr (ALIGN_EPI) { if (wr == 0) PG8_BAR; }
        if constexpr (!Epi::AFTER_DRAIN) { E(acc, cur, wr, wc, fr, fq); S.done(cur); }
        if (!has_next) break;
#pragma unroll
        for (int a = 0; a < 2; ++a)
#pragma unroll
            for (int b = 0; b < 2; ++b)
#pragma unroll
                for (int m = 0; m < 4; ++m)
#pragma unroll
                    for (int n = 0; n < 2; ++n) acc[a][b][m][n] = (f32x4){0.f, 0.f, 0.f, 0.f};
        cur = nxt; cA = nA; cB = nB; ++ui;
        if constexpr (ALIGN_EPI) { if (wr == 1) PG8_BAR; }
    }
    PG8_WAIT_V(0);
    if constexpr (!ALIGN_EPI) { if (wr == 0) PG8_BAR; }
    PG8_BAR;
    if constexpr (Epi::AFTER_DRAIN) { E.fused(acc, cur, wr, wc, fr, fq, lds, wid, lane); S.done(cur); }
#undef PG8_SA
#undef PG8_SB
#undef PG8_STAGE
#undef PG8_LDA
#undef PG8_LDB
#undef PG8_MMA
#undef PG8_WAIT_V
#undef PG8_WAIT_L
#undef PG8_BAR
#undef PG8_SCHED
}
}
constexpr int D = 2048, NB = 2, SEQ = 16384, NCTX = 256, DEPTH = 2;
constexpr int MLAT = NB * SEQ, MCTX = NB * NCTX, MTOT = MLAT + MCTX;
constexpr int INW = 6176, INWP = 6400, HID = 8192;
constexpr int NKEY = SEQ + NCTX;
constexpr int NTILE = NKEY / 64;
constexpr int GLA_OFF = 1536, DIFF_OFF = 3104;
constexpr float EPS = 1e-6f;
constexpr float LOG2E = 1.4426950408889634f;
constexpr float C2 = 0.125f * LOG2E;
constexpr int NPH = 2 + 9 * DEPTH;
constexpr int LDS_BYTES = 158720;
#ifndef PHMASK
#define PHMASK 0xFFFF
#endif
#define EN(x) (((PHMASK) >> (x)) & 1)

constexpr size_t MiB = 1u << 20;
constexpr size_t WS_MOD = 1 * MiB, WS_ZERO_BYTES = 2 * MiB;
constexpr size_t WS_WIN = 2 * MiB, WS_WOUT = 27 * MiB, WS_W1 = 35 * MiB, WS_W2 = 67 * MiB;
constexpr size_t WS_XN = 99 * MiB;
constexpr size_t WS_DQ = WS_XN, WS_DK = WS_XN + 65 * MiB;
constexpr size_t WS_P = 229 * MiB;
constexpr size_t WS_MIX = WS_P + (size_t)MTOT * INWP * 2;
constexpr size_t WS_H = WS_P;
constexpr size_t WS_YG = 766 * MiB;
constexpr size_t WS_HC = 896 * MiB;
constexpr size_t WS_DVT = 900 * MiB;
constexpr size_t WS_NAVT = 965 * MiB;
constexpr size_t WS_GD = 998 * MiB;
constexpr size_t WS_END = 1000 * MiB;
static_assert(WS_MIX + (size_t)MTOT * D * 2 <= WS_YG && WS_H + (size_t)MTOT * HID * 2 <= WS_MIX + (size_t)MTOT * D * 2, "ws map");
static_assert((size_t)NB * 16 * NKEY * 64 * 2 == 65 * MiB, "dq size");

typedef unsigned short bf16_t;
typedef float f32x2 __attribute__((ext_vector_type(2)));
typedef float f32x4 __attribute__((ext_vector_type(4)));
typedef float f32x16 __attribute__((ext_vector_type(16)));
typedef short bf16x8 __attribute__((ext_vector_type(8)));
typedef unsigned u32x4 __attribute__((ext_vector_type(4)));
typedef unsigned u32x2 __attribute__((ext_vector_type(2)));
#define LAS __attribute__((address_space(3)))
#define LDS_WAIT() asm volatile("s_waitcnt lgkmcnt(0)" ::: "memory")

struct Params {
    const float *x, *c, *ctx, *c_ctx, *w_ada, *b_ada, *g_pre_mix, *g_post_mix, *g_pre_mlp, *g_post_mlp,
                *w_in, *w_out, *na_rel_bias, *gla_w_gate, *gla_b_gate, *gla_g_norm, *diff_lambda, *diff_g_norm, *w_mlp_in, *w_mlp_out;
    float* out; unsigned char* ws; int ph_lo, ph_hi;
};

__device__ __forceinline__ float bf2f(unsigned u) { return __uint_as_float(u << 16); }
__device__ __forceinline__ unsigned f2bf(float f) { unsigned u = __float_as_uint(f); return (u + 0x7fffu + ((u >> 16) & 1u)) >> 16; }
__device__ __forceinline__ unsigned pk2(float lo, float hi) { return f2bf(lo) | (f2bf(hi) << 16); }
__device__ __forceinline__ float wave_sum(float v) {
#pragma unroll
    for (int o = 1; o < 64; o <<= 1) v += __shfl_xor(v, o);
    return v;
}
__device__ __forceinline__ int prow(int b, int n) { return n < SEQ ? b * SEQ + n : MLAT + b * NCTX + (n - SEQ); }

__device__ __forceinline__ void ph_mod(const Params& p, LAS unsigned char* lds) {
    LAS float* sc = (LAS float*)lds;
    const int tid = otid();
    for (int i = tid; i < 3 * D; i += 512) { const float v = i < 2 * D ? p.c[i] : p.c_ctx[i - 2 * D]; sc[i] = v / (1.f + __expf(-v)); }
    __syncthreads();
    float* MOD = (float*)(p.ws + WS_MOD);
    const int col_in = tid & 255, kh = tid >> 8;
    for (int it = obid(); it < 2 * 48 * 8; it += gridDim.x) {
        const int ks = it & 7, cb = (it >> 3) % 48, l = it / 384;
        const int col = cb * 256 + col_in;
        const float* W = p.w_ada + (size_t)l * D * 12288 + col;
        const int k0 = ks * 256 + kh * 128;
        float a0 = 0.f, a1 = 0.f, a2 = 0.f;
#pragma unroll 8
        for (int k = k0; k < k0 + 128; ++k) { const float w = W[(size_t)k * 12288]; a0 += sc[k] * w; a1 += sc[D + k] * w; a2 += sc[2 * D + k] * w; }
        if (ks == 0 && kh == 0) { const float bb = p.b_ada[l * 12288 + col]; a0 += bb; a1 += bb; a2 += bb; }
        float* m = MOD + (size_t)l * 3 * 12288 + col;
        atomicAdd(m, a0); atomicAdd(m + 12288, a1); atomicAdd(m + 2 * 12288, a2);
    }
    __syncthreads();
}

__device__ __forceinline__ void transpose_item(const float* W, int K, int N, bf16_t* WT, LAS float* scr, int item, int lane) {
    const int nblk = N / 32, kb = item / nblk, nb = item % nblk, k0 = 64 * kb, n0 = 32 * nb;
#pragma unroll 8
    for (int i = 0; i < 32; ++i) { const int kk = 2 * i + (lane >> 5); scr[kk * 33 + (lane & 31)] = W[(size_t)(k0 + kk) * N + n0 + (lane & 31)]; }
    LDS_WAIT();
    const int c = lane & 7;
#pragma unroll
    for (int j = 0; j < 4; ++j) { const int n = (lane >> 3) + 8 * j; const LAS float* s = scr + (8 * c) * 33 + n;
        u32x4 o; o.x = pk2(s[0 * 33], s[1 * 33]); o.y = pk2(s[2 * 33], s[3 * 33]); o.z = pk2(s[4 * 33], s[5 * 33]); o.w = pk2(s[6 * 33], s[7 * 33]);
        *(u32x4*)(WT + (size_t)(n0 + n) * K + k0 + 8 * c) = o; }
    LDS_WAIT();
}
__device__ __forceinline__ void ph_wconv(const Params& p, LAS unsigned char* lds, int l) {
    const int tid = otid(), lane = tid & 63, wave = tid >> 6;
    LAS float* scr = (LAS float*)(lds + wave * 16384);
    const int gw = obid() * 8 + wave, NGW = gridDim.x * 8;
    constexpr int I_IN = (D / 64) * (INW / 32), I_OUT = (D / 64) * (D / 32), I_1 = (D / 64) * (HID / 32), I_2 = (HID / 64) * (D / 32);
    const float* win = p.w_in + (size_t)l * D * INW; const float* wout = p.w_out + (size_t)l * D * D;
    const float* w1 = p.w_mlp_in + (size_t)l * D * HID; const float* w2 = p.w_mlp_out + (size_t)l * HID * D;
    for (int it = gw; it < I_IN + I_OUT + I_1 + I_2; it += NGW) {
        int r = it;
        if (r < I_IN) { transpose_item(win, D, INW, (bf16_t*)(p.ws + WS_WIN), scr, r, lane); continue; } r -= I_IN;
        if (r < I_OUT) { transpose_item(wout, D, D, (bf16_t*)(p.ws + WS_WOUT), scr, r, lane); continue; } r -= I_OUT;
        if (r < I_1) { transpose_item(w1, D, HID, (bf16_t*)(p.ws + WS_W1), scr, r, lane); continue; } r -= I_1;
        transpose_item(w2, HID, D, (bf16_t*)(p.ws + WS_W2), scr, r, lane);
    }
    __syncthreads();
}

__device__ __forceinline__ void row_pass(const Params& p, int l, int mode) {
    const int tid = otid(), lane = tid & 63, wave = tid >> 6;
    const int gw = obid() * 8 + wave, NGW = gridDim.x * 8;
    const float* MOD = (const float*)(p.ws + WS_MOD);
    float* HC = (float*)(p.ws + WS_HC);
    const bf16_t* Y = (const bf16_t*)(p.ws + WS_YG);
    bf16_t* XN = (bf16_t*)(p.ws + WS_XN);
    const int nrows = (l == 0) ? MTOT : MLAT;
    const float* xin_lat; const float* xin_ctx; const float* gpost = nullptr; const float* gn; int jg = 0, jsh, jsc, lnext; bool do_next = true;
    if (mode == 0) { xin_lat = p.x; xin_ctx = p.ctx; gn = p.g_pre_mix; jsh = 0; jsc = 1; lnext = 0; }
    else if (mode == 1) { xin_lat = (l == 0) ? p.x : p.out; xin_ctx = (l == 0) ? p.ctx : HC; gpost = p.g_post_mix + l * D; jg = 2; gn = p.g_pre_mlp + l * D; jsh = 3; jsc = 4; lnext = l; }
    else { xin_lat = p.out; xin_ctx = HC; gpost = p.g_post_mlp + l * D; jg = 5; lnext = l + 1; do_next = (l + 1 < DEPTH); gn = p.g_pre_mix + (do_next ? lnext : l) * D; jsh = 0; jsc = 1; }
    f32x4 nxv[8]; u32x2 nyr[8];
#define ROW_LOAD(mm) do { const int m_ = (mm); const float* xr_ = m_ < MLAT ? xin_lat + (size_t)m_ * D : xin_ctx + (size_t)(m_ - MLAT) * D; \
        _Pragma("unroll") for (int j = 0; j < 8; ++j) nxv[j] = *(const f32x4*)(xr_ + j * 256 + lane * 4); \
        if (mode != 0) { const bf16_t* yr_ = Y + (size_t)m_ * D; _Pragma("unroll") for (int j = 0; j < 8; ++j) nyr[j] = *(const u32x2*)(yr_ + j * 256 + lane * 4); } } while (0)
    if (gw < nrows) ROW_LOAD(gw);
    for (int m = gw; m < nrows; m += NGW) {
        const int s = m < MLAT ? (m >> 14) : 2;
        f32x4 xv[8]; u32x2 yraw[8];
#pragma unroll
        for (int j = 0; j < 8; ++j) { xv[j] = nxv[j]; yraw[j] = nyr[j]; }
        if (m + NGW < nrows) ROW_LOAD(m + NGW);
        if (mode != 0) {
            f32x4 yv[8]; float ss = 0.f;
#pragma unroll
            for (int j = 0; j < 8; ++j) { const u32x2 raw = yraw[j];
                yv[j] = (f32x4){bf2f(raw.x & 0xffffu), bf2f(raw.x >> 16), bf2f(raw.y & 0xffffu), bf2f(raw.y >> 16)};
                ss += (yv[j].x * yv[j].x + yv[j].y * yv[j].y) + (yv[j].z * yv[j].z + yv[j].w * yv[j].w); }
            ss = wave_sum(ss);
            const float r = rsqrtf(ss * (1.f / D) + EPS);
            const float* gate = MOD + ((size_t)(l * 3 + s) * 6 + jg) * D;
            float* xo = m < MLAT ? p.out + (size_t)m * D : HC + (size_t)(m - MLAT) * D;
#pragma unroll
            for (int j = 0; j < 8; ++j) { const int col = j * 256 + lane * 4;
                const f32x4 g4 = *(const f32x4*)(gpost + col), gt = *(const f32x4*)(gate + col);
                xv[j] = xv[j] + gt * (yv[j] * r * g4);
                *(f32x4*)(xo + col) = xv[j]; }
        }
        if (do_next) {
            float ss = 0.f;
#pragma unroll
            for (int j = 0; j < 8; ++j) ss += (xv[j].x * xv[j].x + xv[j].y * xv[j].y) + (xv[j].z * xv[j].z + xv[j].w * xv[j].w);
            ss = wave_sum(ss);
            const float r = rsqrtf(ss * (1.f / D) + EPS);
            const float* sh = MOD + ((size_t)(lnext * 3 + s) * 6 + jsh) * D; const float* scl = MOD + ((size_t)(lnext * 3 + s) * 6 + jsc) * D;
            bf16_t* xn = XN + (size_t)m * D;
#pragma unroll
            for (int j = 0; j < 8; ++j) { const int col = j * 256 + lane * 4;
                const f32x4 g4 = *(const f32x4*)(gn + col), s4 = *(const f32x4*)(sh + col), c4 = *(const f32x4*)(scl + col);
                const f32x4 h = (xv[j] * r * g4) * (c4 + 1.f) + s4;
                u32x2 w; w.x = pk2(h.x, h.y); w.y = pk2(h.z, h.w);
                *(u32x2*)(xn + col) = w; }
        }
    }
#undef ROW_LOAD
}

constexpr int TSB = 144;
constexpr int KTB = 64 * TSB;
__device__ __forceinline__ int crow(int r, int hi) { return (r & 3) + 8 * (r >> 2) + 4 * hi; }
__device__ __forceinline__ float xhalf_max(float m) { auto rr = __builtin_amdgcn_permlane32_swap(__float_as_uint(m), __float_as_uint(m), false, false); return fmaxf(__uint_as_float(rr[0]), __uint_as_float(rr[1])); }
__device__ __forceinline__ float xhalf_sum(float m) { auto rr = __builtin_amdgcn_permlane32_swap(__float_as_uint(m), __float_as_uint(m), false, false); return __uint_as_float(rr[0]) + __uint_as_float(rr[1]); }
__device__ __forceinline__ float max3f(float a, float b, float c) { float r; asm("v_max3_f32 %0, %1, %2, %3" : "=v"(r) : "v"(a), "v"(b), "v"(c)); return r; }
__device__ __forceinline__ float fadd_s(float a, float b) { float r; asm("v_add_f32_e32 %0, %1, %2" : "=v"(r) : "v"(a), "v"(b)); return r; }
__device__ __forceinline__ void glds16(const void* gsrc, unsigned lds_dst) { unsigned keep;
    asm volatile("s_mov_b32 %0, m0\n\ts_mov_b32 m0, %2\n\ts_nop 0\n\tglobal_load_lds_dwordx4 %1, off\n\ts_mov_b32 m0, %0" : "=&s"(keep) : "v"(gsrc), "s"(lds_dst) : "memory"); }
__device__ __forceinline__ void glds16s(unsigned voff, const void* sbase, unsigned lds_dst) { unsigned keep;
    asm volatile("s_mov_b32 %0, m0\n\ts_mov_b32 m0, %3\n\ts_nop 0\n\tglobal_load_lds_dwordx4 %1, %2\n\ts_mov_b32 m0, %0" : "=&s"(keep) : "v"(voff), "s"(sbase), "s"(lds_dst) : "memory"); }
#define LBARV() asm volatile("s_waitcnt vmcnt(0) lgkmcnt(0)\n\ts_barrier" ::: "memory")
#define LBAR() asm volatile("s_waitcnt lgkmcnt(0)\n\ts_barrier" ::: "memory")
typedef __bf16 bf16x2_t __attribute__((ext_vector_type(2)));
__device__ __forceinline__ unsigned cvtpk(float lo, float hi) { f32x2 v = {lo, hi}; bf16x2_t b = __builtin_convertvector(v, bf16x2_t); return __builtin_bit_cast(unsigned, b); }

__device__ __forceinline__ void wave_qk(f32x16& s0, f32x16& s1, const LAS unsigned char* Kt, const bf16x8 (&qf)[4], int r32, int hi) {
    s0 = (f32x16){}; s1 = (f32x16){};
#pragma unroll
    for (int d0 = 0; d0 < 4; ++d0) {
        const bf16x8 k0 = *(const LAS bf16x8*)(Kt + r32 * TSB + d0 * 32 + hi * 16);
        const bf16x8 k1 = *(const LAS bf16x8*)(Kt + (32 + r32) * TSB + d0 * 32 + hi * 16);
        s0 = __builtin_amdgcn_mfma_f32_32x32x16_bf16(k0, qf[d0], s0, 0, 0, 0);
        s1 = __builtin_amdgcn_mfma_f32_32x32x16_bf16(k1, qf[d0], s1, 0, 0, 0);
    }
}
template <int NDB, bool MASKED>
__device__ __forceinline__ void wave_softmax_pv(f32x16& s0, f32x16& s1, f32x16 (&o)[NDB], float& m, float& l, const LAS unsigned char* Vt, LAS float* scr, int r32, int hi) {
    float mx = fmaxf(s0[0], s1[0]);
#pragma unroll
    for (int r = 1; r < 16; ++r) mx = fmaxf(mx, fmaxf(s0[r], s1[r]));
    mx = xhalf_max(mx);
    if (__any(mx > m + 8.f)) {
        const float mn = fmaxf(m, mx); const float alpha = __builtin_amdgcn_exp2f(m - mn); m = mn; l *= alpha;
        if (hi == 0) scr[r32] = alpha;
        LDS_WAIT();
#pragma unroll
        for (int r = 0; r < 16; ++r) { const float a = scr[crow(r, hi)];
#pragma unroll
            for (int db = 0; db < NDB; ++db) o[db][r] *= a; }
        LDS_WAIT();
    }
    float ls = 0.f;
#pragma unroll
    for (int r = 0; r < 16; ++r) {
        float p0 = __builtin_amdgcn_exp2f(s0[r] - m), p1 = __builtin_amdgcn_exp2f(s1[r] - m);
        if (MASKED) { p0 = s0[r] < -1e29f ? 0.f : p0; p1 = s1[r] < -1e29f ? 0.f : p1; }
        s0[r] = p0; s1[r] = p1; ls += p0 + p1;
    }
    l += ls;
    bf16x8 pa[2][2];
#pragma unroll
    for (int s2 = 0; s2 < 2; ++s2) {
        u32x4 w0, w1;
        w0.x = cvtpk(s0[8 * s2 + 0], s0[8 * s2 + 1]); w0.y = cvtpk(s0[8 * s2 + 2], s0[8 * s2 + 3]); w0.z = cvtpk(s0[8 * s2 + 4], s0[8 * s2 + 5]); w0.w = cvtpk(s0[8 * s2 + 6], s0[8 * s2 + 7]);
        w1.x = cvtpk(s1[8 * s2 + 0], s1[8 * s2 + 1]); w1.y = cvtpk(s1[8 * s2 + 2], s1[8 * s2 + 3]); w1.z = cvtpk(s1[8 * s2 + 4], s1[8 * s2 + 5]); w1.w = cvtpk(s1[8 * s2 + 6], s1[8 * s2 + 7]);
        pa[0][s2] = __builtin_bit_cast(bf16x8, w0); pa[1][s2] = __builtin_bit_cast(bf16x8, w1);
    }
#pragma unroll
    for (int db = 0; db < NDB; ++db)
#pragma unroll
        for (int pp = 0; pp < 2; ++pp)
#pragma unroll
            for (int s2 = 0; s2 < 2; ++s2) {
                const bf16x8 v = *(const LAS bf16x8*)(Vt + (db * 32 + r32) * TSB + (32 * pp + 16 * s2 + 8 * hi) * 2);
                o[db] = __builtin_amdgcn_mfma_f32_32x32x16_bf16(pa[pp][s2], v, o[db], 0, 0, 0);
            }
}

constexpr int DTILEB = 2 * KTB + 128 * TSB;
__device__ __forceinline__ void diff_unit(LAS unsigned char* lds, const bf16_t* DQ, const bf16_t* DK, const bf16_t* DVt, bf16_t* MIX,
                                          int b, int h, int q0, int t0, int t1, float lam, const float* gnorm, float oscale) {
    const int tid = otid(), lane = tid & 63, wid = __builtin_amdgcn_readfirstlane(tid >> 6), r32 = lane & 31, hi = lane >> 5;
    const int grp = wid >> 2, p = wid & 1, qg = grp * 2 + ((wid >> 1) & 1);
    const int T = t1 - t0;
    LAS float* scr = (LAS float*)(lds + 3 * DTILEB) + wid * 32;
    const bf16_t* k0src = DK + ((size_t)((b * 8 + h) * 2 + 0) * NKEY) * 64 + tid * 8;
    const bf16_t* k1src = DK + ((size_t)((b * 8 + h) * 2 + 1) * NKEY) * 64 + tid * 8;
    const bf16_t* v0src = DVt + ((size_t)((b * 8 + h) * 128 + (tid >> 3)) * NKEY) + (tid & 7) * 8;
    const bf16_t* v1src = v0src + (size_t)64 * NKEY;
    const int kdst = (tid >> 3) * TSB + (tid & 7) * 16;
    u32x4 rk0, rk1, rv0, rv1;
#define DLOADK(t) do { rk0 = *(const u32x4*)(k0src + (size_t)(t) * 4096); rk1 = *(const u32x4*)(k1src + (size_t)(t) * 4096); } while (0)
#define DLOADV(t) do { rv0 = *(const u32x4*)(v0src + (t) * 64); rv1 = *(const u32x4*)(v1src + (t) * 64); } while (0)
#define DSTOREK(buf) do { LAS unsigned char* bb_ = lds + (buf) * DTILEB; *(LAS u32x4*)(bb_ + kdst) = rk0; *(LAS u32x4*)(bb_ + KTB + kdst) = rk1; } while (0)
#define DSTOREV(buf) do { LAS unsigned char* bb_ = lds + (buf) * DTILEB; *(LAS u32x4*)(bb_ + 2 * KTB + kdst) = rv0; *(LAS u32x4*)(bb_ + 2 * KTB + 64 * TSB + kdst) = rv1; } while (0)
    const bf16_t* qsrc = DQ + ((size_t)((b * 8 + h) * 2 + p) * NKEY + q0 + qg * 32 + r32) * 64 + hi * 8;
    bf16x8 qf[4];
#pragma unroll
    for (int d0 = 0; d0 < 4; ++d0) qf[d0] = *(const bf16x8*)(qsrc + d0 * 16);
    LAS unsigned char* qlds = lds + 3 * DTILEB + 1024 + wid * 4096 + lane * 16;
#pragma unroll
    for (int d0 = 0; d0 < 4; ++d0) *(LAS bf16x8*)(qlds + d0 * 1024) = qf[d0];
    f32x16 o[4]; o[0] = (f32x16){}; o[1] = (f32x16){}; o[2] = (f32x16){}; o[3] = (f32x16){};
    float m = 0.f, l = 0.f;
    f32x16 negm = (f32x16){};
    bf16x8 pa[2][2];
    f32x16 s0, s1;
    DLOADK(t0); DSTOREK(2); DLOADK(t0 + 1); DLOADV(t0); DSTOREK(0); DSTOREV(0);
    __syncthreads();
    wave_qk(s0, s1, lds + 2 * DTILEB + p * KTB, qf, r32, hi);
    const int wsub = wid & 3;
    const char* dsrc[5];
#pragma unroll
    for (int k = 0; k < 5; ++k) {
        const int B = (wsub + 4 * k) * 1024 + lane * 16;
        if (grp == 0) { const int pp = B >= KTB ? 1 : 0, Bp = B - pp * KTB, row = Bp / TSB; int col = Bp % TSB; if (col >= 128) col = 0;
            dsrc[k] = (const char*)(DK + ((size_t)((b * 8 + h) * 2 + pp) * NKEY) * 64) + row * 128 + col + (size_t)(t0 + 2) * 8192; }
        else { const int row = B / TSB; int col = B % TSB; if (col >= 128) col = 0;
            dsrc[k] = (const char*)(DVt + ((size_t)((b * 8 + h) * 128 + row) * NKEY)) + col + (size_t)(t0 + 1) * 128; }
    }
    const int dstride = grp == 0 ? 8192 : 128, gahead = 2 - grp;
    const unsigned ldsb = (unsigned)(size_t)(lds + (grp ? 2 * KTB : 0)) + wsub * 1024;
    auto STG = [&](const int e) __attribute__((always_inline)) {
        if (e + gahead < T) {
            const unsigned dbase = ldsb + (unsigned)(((e + 1) % 3) * DTILEB);
            const size_t off = (size_t)e * dstride;
#pragma unroll
            for (int k = 0; k < 4; ++k) glds16(dsrc[k] + off, (unsigned)__builtin_amdgcn_readfirstlane(dbase + k * 4096));
            if (wsub < 2) glds16(dsrc[4] + off, (unsigned)__builtin_amdgcn_readfirstlane(dbase + 16384));
        }
    };
    auto XH = [&](const int j) __attribute__((always_inline)) {
            {
                if (!(j & 1)) {
                asm volatile("s_nop 15\n\ts_nop 7" : "+v"(s0), "+v"(s1));
                float mxa = max3f(s0[0], s0[1], s1[0]), mxb = max3f(s0[2], s0[3], s1[1]); mxa = max3f(mxa, s1[2], s1[3]);
#pragma unroll
                for (int r = 4; r < 16; r += 4) { mxa = max3f(mxa, s0[r], s0[r + 1]); mxb = max3f(mxb, s0[r + 2], s0[r + 3]); mxa = max3f(mxa, s1[r], s1[r + 1]); mxb = max3f(mxb, s1[r + 2], s1[r + 3]); }
                float mx = max3f(mxa, mxb, mxb);
                { auto rr = __builtin_amdgcn_permlane32_swap(__float_as_uint(mx), __float_as_uint(mx), false, false); mx = max3f(__uint_as_float(rr[0]), __uint_as_float(rr[1]), __uint_as_float(rr[1])); }
                if (j == 0) {
                    m = mx;
#pragma unroll
                    for (int r = 0; r < 16; ++r) { s0[r] -= mx; s1[r] -= mx; negm[r] = -mx; }
                } else if (__any(mx > 8.f)) {
                    const float delta = fmaxf(mx, 0.f); const float alpha = __builtin_amdgcn_exp2f(-delta); m += delta; l *= alpha;
#pragma unroll
                    for (int r = 0; r < 16; ++r) { s0[r] -= delta; s1[r] -= delta; negm[r] = -m; }
                    if (hi == 0) scr[r32] = alpha;
                    LDS_WAIT();
#pragma unroll
                    for (int r = 0; r < 16; ++r) { const float a = scr[crow(r, hi)];
#pragma unroll
                        for (int db = 0; db < 4; ++db) o[db][r] *= a; }
                    LDS_WAIT();
                }
                }
                float ls = 0.f;
#pragma unroll
                for (int r = 0; r < 16; ++r) { s0[r] = __builtin_amdgcn_exp2f(s0[r]); s1[r] = __builtin_amdgcn_exp2f(s1[r]); }
                __builtin_amdgcn_sched_barrier(0);
                f32x2 la2 = {0.f, 0.f}, lb2 = {0.f, 0.f};
#pragma unroll
                for (int r = 0; r < 16; r += 2) {
                    const f32x2 pa2 = {s0[r], s0[r + 1]}, pb2 = {s1[r], s1[r + 1]};
                    asm("v_pk_add_f32 %0, %1, %2" : "=v"(la2) : "v"(la2), "v"(pa2));
                    asm("v_pk_add_f32 %0, %1, %2" : "=v"(lb2) : "v"(lb2), "v"(pb2));
                }
                l += (la2.x + la2.y) + (lb2.x + lb2.y) + ls;
#pragma unroll
                for (int s2 = 0; s2 < 2; ++s2) {
                    u32x4 w0, w1;
                    w0.x = cvtpk(s0[8 * s2 + 0], s0[8 * s2 + 1]); w0.y = cvtpk(s0[8 * s2 + 2], s0[8 * s2 + 3]); w0.z = cvtpk(s0[8 * s2 + 4], s0[8 * s2 + 5]); w0.w = cvtpk(s0[8 * s2 + 6], s0[8 * s2 + 7]);
                    w1.x = cvtpk(s1[8 * s2 + 0], s1[8 * s2 + 1]); w1.y = cvtpk(s1[8 * s2 + 2], s1[8 * s2 + 3]); w1.z = cvtpk(s1[8 * s2 + 4], s1[8 * s2 + 5]); w1.w = cvtpk(s1[8 * s2 + 6], s1[8 * s2 + 7]);
                    pa[0][s2] = __builtin_bit_cast(bf16x8, w0); pa[1][s2] = __builtin_bit_cast(bf16x8, w1);
                }
            }
    };
    auto YH = [&](const int j) __attribute__((always_inline)) {
            {
                const LAS unsigned char* bb = lds + (j % 3) * DTILEB;
                const LAS unsigned char* Vt = bb + 2 * KTB + r32 * TSB + hi * 16;
                const LAS unsigned char* Kt = bb + p * KTB + r32 * TSB + hi * 16;
                const bool more = (j + 1 < T);
                bf16x8 fa[4], fb[4];
#define VLD(dst, db) do { _Pragma("unroll") for (int pp = 0; pp < 2; ++pp) _Pragma("unroll") for (int s2 = 0; s2 < 2; ++s2) \
                        dst[pp * 2 + s2] = *(const LAS bf16x8*)(Vt + (db) * 32 * TSB + (32 * pp + 16 * s2) * 2); } while (0)
#define KLD(dst, dh) do { _Pragma("unroll") for (int dd = 0; dd < 2; ++dd) { dst[dd * 2] = *(const LAS bf16x8*)(Kt + ((dh) * 2 + dd) * 32); \
                        dst[dd * 2 + 1] = *(const LAS bf16x8*)(Kt + 32 * TSB + ((dh) * 2 + dd) * 32); } } while (0)
#define PVM(src, db) do { _Pragma("unroll") for (int pp = 0; pp < 2; ++pp) _Pragma("unroll") for (int s2 = 0; s2 < 2; ++s2) \
                        o[db] = __builtin_amdgcn_mfma_f32_32x32x16_bf16(pa[pp][s2], src[pp * 2 + s2], o[db], 0, 0, 0); } while (0)
#define QKM(src, dh) do { _Pragma("unroll") for (int dd = 0; dd < 2; ++dd) { s0 = __builtin_amdgcn_mfma_f32_32x32x16_bf16(src[dd * 2], qf[(dh) * 2 + dd], s0, 0, 0, 0); \
                        s1 = __builtin_amdgcn_mfma_f32_32x32x16_bf16(src[dd * 2 + 1], qf[(dh) * 2 + dd], s1, 0, 0, 0); } } while (0)
#define FENCE() do { asm volatile("" ::: "memory"); __builtin_amdgcn_sched_barrier(0); } while (0)
                VLD(fa, 0); FENCE();
                __builtin_amdgcn_s_setprio(1);
                VLD(fb, 1); FENCE(); PVM(fa, 0); FENCE();
                VLD(fa, 2); FENCE(); PVM(fb, 1); FENCE();
                VLD(fb, 3); FENCE(); PVM(fa, 2); FENCE();
                if (more) {
                    bf16x8 q0 = qf[0], q1 = qf[1];
                    KLD(fa, 0); FENCE(); PVM(fb, 3); FENCE();
                    KLD(fb, 1); FENCE();
                    s0 = __builtin_amdgcn_mfma_f32_32x32x16_bf16(fa[0], q0, negm, 0, 0, 0); s1 = __builtin_amdgcn_mfma_f32_32x32x16_bf16(fa[1], q0, negm, 0, 0, 0);
                    s0 = __builtin_amdgcn_mfma_f32_32x32x16_bf16(fa[2], q1, s0, 0, 0, 0);   s1 = __builtin_amdgcn_mfma_f32_32x32x16_bf16(fa[3], q1, s1, 0, 0, 0);
                    q0 = qf[2]; q1 = qf[3];
                    FENCE();
                    s0 = __builtin_amdgcn_mfma_f32_32x32x16_bf16(fb[0], q0, s0, 0, 0, 0); s1 = __builtin_amdgcn_mfma_f32_32x32x16_bf16(fb[1], q0, s1, 0, 0, 0);
                    s0 = __builtin_amdgcn_mfma_f32_32x32x16_bf16(fb[2], q1, s0, 0, 0, 0); s1 = __builtin_amdgcn_mfma_f32_32x32x16_bf16(fb[3], q1, s1, 0, 0, 0);
                } else { PVM(fb, 3); }
                __builtin_amdgcn_s_setprio(0);
#undef VLD
#undef KLD
#undef PVM
#undef QKM
#undef FENCE
            }
    };
    if (grp == 0) {
        for (int j = 0; j < T; ++j) { STG(j); XH(j); __builtin_amdgcn_sched_barrier(0); YH(j); LBARV(); __builtin_amdgcn_sched_barrier(0); }
        LBARV();
    } else {
        STG(0); XH(0); LBARV(); __builtin_amdgcn_sched_barrier(0);
        for (int j = 1; j < T; ++j) { STG(j); YH(j - 1); __builtin_amdgcn_sched_barrier(0); XH(j); LBARV(); __builtin_amdgcn_sched_barrier(0); }
        YH(T - 1); LBARV();
    }
#undef DLOADK
#undef DLOADV
#undef DSTOREK
#undef DSTOREV
    {
        const float lt = xhalf_sum(l); const float inv = 1.f / lt; const float coef = p ? -lam * inv : inv;
        if (hi == 0) scr[r32] = coef;
        LDS_WAIT();
#pragma unroll
        for (int r = 0; r < 16; ++r) { const float a = scr[crow(r, hi)];
#pragma unroll
            for (int db = 0; db < 4; ++db) o[db][r] *= a; }
        LDS_WAIT();
    }
    LAS float* stage = (LAS float*)lds;
    if (p == 1) {
#pragma unroll
        for (int r = 0; r < 16; ++r)
#pragma unroll
            for (int db = 0; db < 4; ++db) stage[(qg * 32 + crow(r, hi)) * 128 + db * 32 + r32] = o[db][r];
    }
    __syncthreads();
    if (p == 0) {
#pragma unroll
        for (int r = 0; r < 16; ++r)
#pragma unroll
            for (int db = 0; db < 4; ++db) { const int idx = (qg * 32 + crow(r, hi)) * 128 + db * 32 + r32; stage[idx] = stage[idx] + o[db][r]; }
    }
    __syncthreads();
    const float g0 = gnorm[lane], g1 = gnorm[64 + lane];
    for (int i = 0; i < 16; ++i) {
        const int row = wid * 16 + i;
        const float v0 = stage[row * 128 + lane], v1 = stage[row * 128 + 64 + lane];
        const float ss = wave_sum(v0 * v0 + v1 * v1);
        const float rs = rsqrtf(ss * (1.f / 128.f) + EPS) * oscale;
        bf16_t* dst = MIX + (size_t)prow(b, q0 + row) * D + 1024 + h * 128;
        dst[lane] = (bf16_t)f2bf(v0 * rs * g0); dst[64 + lane] = (bf16_t)f2bf(v1 * rs * g1);
    }
    __syncthreads();
}

constexpr int NHB = 2 * KTB;
__device__ __forceinline__ void na_unit(LAS unsigned char* lds, const bf16_t* P, const bf16_t* NAVt, bf16_t* MIX, const float* relb, int b, int hg, int qblk) {
    const int tid = otid(), lane = tid & 63, wid = __builtin_amdgcn_readfirstlane(tid >> 6), r32 = lane & 31, hi = lane >> 5;
    const int hh = wid >> 1, qg = wid & 1, head = hg * 4 + hh;
    const bool isctx = qblk >= 256;
    const int n0q = isctx ? SEQ + (qblk - 256) * 64 : qblk * 64;
    const int kr0 = isctx ? 0 : min(max(qblk - 4, 0), 248);
    const int NT = isctx ? 4 : 12;
#define NTILE_OF(i) (isctx ? 256 + (i) : ((i) < 4 ? 256 + (i) : kr0 + (i) - 4))
    LAS float* biasL = (LAS float*)(lds + 8 * NHB);
    LAS float* scr = (LAS float*)(lds + 8 * NHB + 7680) + wid * 32;
    for (int i = tid; i < 4 * 15 * 32; i += 512) { const int hh_ = i / 480, rem = i % 480, dr_ = rem >> 5, dc_ = rem & 31;
        biasL[i] = dc_ < 31 ? relb[(hg * 4 + hh_) * 465 + dr_ * 31 + dc_] * LOG2E : -1e30f; }
    unsigned boff0[4] = {0u, 0u, 0u, 0u}, boff1[4] = {0u, 0u, 0u, 0u};
    { const int qc = qg * 32 + r32, c0 = min(max(qc - 8, 0), 48);
#pragma unroll
      for (int r = 0; r < 16; ++r) { const int kc0 = crow(r, hi), kc1 = kc0 + 32;
          boff0[r >> 2] |= (unsigned)(((kc0 >= c0 && kc0 < c0 + 16) ? (kc0 - qc + 15) : 31) * 4) << (8 * (r & 3));
          boff1[r >> 2] |= (unsigned)(((kc1 >= c0 && kc1 < c0 + 16) ? (kc1 - qc + 15) : 31) * 4) << (8 * (r & 3)); } }
    const bf16_t* qsrc = P + (size_t)prow(b, n0q + qg * 32 + r32) * INWP + head * 64 + hi * 8;
    bf16x8 qf[4];
#pragma unroll
    for (int d0 = 0; d0 < 4; ++d0) qf[d0] = *(const bf16x8*)(qsrc + d0 * 16);
    unsigned poff[9];
#pragma unroll
    for (int k = 0; k < 9; ++k) { const int c = wid + 8 * k, j = c / 18, cc = c % 18; const int B = (cc % 9) * 1024 + lane * 16; const int row = B / TSB; int col = B % TSB; if (col >= 128) col = 0;
        poff[k] = (cc < 9) ? (unsigned)(row * (INWP * 2) + (512 + (hg * 4 + j) * 64) * 2 + col) : (unsigned)((((b * 8 + hg * 4 + j) * 64 + row) * NKEY) * 2 + col); }
    const unsigned ldsw = (unsigned)(size_t)lds;
#define NDMA(tile, bsel) do { const int n0_ = (tile) * 64; \
        const char* kb_ = (const char*)(P + (size_t)prow(b, n0_) * INWP); const char* vb_ = (const char*)(NAVt + n0_); \
        const unsigned long long kbu_ = (unsigned long long)kb_, vbu_ = (unsigned long long)vb_; \
        const unsigned long long kbs_ = ((unsigned long long)(unsigned)__builtin_amdgcn_readfirstlane((int)(kbu_ >> 32)) << 32) | (unsigned)__builtin_amdgcn_readfirstlane((int)kbu_); \
        const unsigned long long vbs_ = ((unsigned long long)(unsigned)__builtin_amdgcn_readfirstlane((int)(vbu_ >> 32)) << 32) | (unsigned)__builtin_amdgcn_readfirstlane((int)vbu_); \
        _Pragma("unroll") for (int k = 0; k < 9; ++k) { const int c = wid + 8 * k, j = c / 18, cc = c % 18; \
            glds16s(poff[k], (cc < 9) ? (const void*)kbs_ : (const void*)vbs_, (unsigned)__builtin_amdgcn_readfirstlane((int)(ldsw + (bsel) * (4 * NHB) + j * NHB + cc * 1024))); } } while (0)
    f32x16 o[2]; o[0] = (f32x16){}; o[1] = (f32x16){};
    float m = -1e30f, l = 0.f;
    NDMA(NTILE_OF(0), 0);
    LBARV();
    for (int i = 0; i < NT; ++i) {
        const int tl = NTILE_OF(i);
        const LAS unsigned char* tb = lds + (i & 1) * (4 * NHB);
        if (i + 1 < NT) NDMA(NTILE_OF(i + 1), (i + 1) & 1);
        f32x16 s0, s1;
        wave_qk(s0, s1, tb + hh * NHB, qf, r32, hi);
        if (tl < 256) {
            const LAS unsigned char* bl = (const LAS unsigned char*)biasL + hh * 1920 + (tl - qblk + 7) * 128;
#pragma unroll
            for (int r = 0; r < 16; ++r) {
                s0[r] = s0[r] * C2 + *(const LAS float*)(bl + ((boff0[r >> 2] >> (8 * (r & 3))) & 0xffu));
                s1[r] = s1[r] * C2 + *(const LAS float*)(bl + ((boff1[r >> 2] >> (8 * (r & 3))) & 0xffu));
            }
        } else {
#pragma unroll
            for (int r = 0; r < 16; ++r) { s0[r] *= C2; s1[r] *= C2; }
        }
        wave_softmax_pv<2, false>(s0, s1, o, m, l, tb + hh * NHB + KTB, scr, r32, hi);
        LBARV();
    }
#undef NDMA
#undef NTILE_OF
    {
        const float lt = xhalf_sum(l); const float inv = 1.f / lt;
        if (hi == 0) scr[r32] = inv;
        LDS_WAIT();
#pragma unroll
        for (int r = 0; r < 16; ++r) { const float a = scr[crow(r, hi)];
            bf16_t* dst = MIX + (size_t)prow(b, n0q + qg * 32 + crow(r, hi)) * D + head * 64 + r32;
            dst[0] = (bf16_t)f2bf(o[0][r] * a); dst[32] = (bf16_t)f2bf(o[1][r] * a); }
        LDS_WAIT();
    }
    __syncthreads();
}

__device__ __forceinline__ void rope_rows(const Params& p) {
    const bf16_t* P = (const bf16_t*)(p.ws + WS_P); bf16_t* DQ = (bf16_t*)(p.ws + WS_DQ); bf16_t* DK = (bf16_t*)(p.ws + WS_DK);
    const int tid = otid(), rsel = tid >> 8, hp = (tid >> 4) & 15, i2 = (tid & 15) * 2;
    const float inv0 = __builtin_amdgcn_exp2f(-(float)(i2 & 15) * (13.287712379549449f / 16.f));
    const float inv1 = __builtin_amdgcn_exp2f(-(float)((i2 + 1) & 15) * (13.287712379549449f / 16.f));
    for (int m0 = obid() * 8; m0 < MTOT; m0 += gridDim.x * 8) {
        unsigned q1[4], q2[4], k1[4], k2[4];
#pragma unroll
        for (int r = 0; r < 4; ++r) { const bf16_t* src = P + (size_t)(m0 + 2 * r + rsel) * INWP + DIFF_OFF + hp * 64 + i2;
            q1[r] = *(const unsigned*)src; q2[r] = *(const unsigned*)(src + 32); k1[r] = *(const unsigned*)(src + 1024); k2[r] = *(const unsigned*)(src + 1024 + 32); }
#pragma unroll
        for (int r = 0; r < 4; ++r) {
            const int m = m0 + 2 * r + rsel; int b, n; float cs0 = 1.f, sn0 = 0.f, cs1 = 1.f, sn1 = 0.f;
            if (m < MLAT) { b = m >> 14; const int t = m & (SEQ - 1); n = t; const float pos = (float)((i2 < 16) ? (t >> 6) : (t & 63));
                float rev0 = pos * inv0 * 0.15915494309189535f; rev0 -= rintf(rev0); sn0 = __builtin_amdgcn_sinf(rev0); cs0 = __builtin_amdgcn_cosf(rev0);
                float rev1 = pos * inv1 * 0.15915494309189535f; rev1 -= rintf(rev1); sn1 = __builtin_amdgcn_sinf(rev1); cs1 = __builtin_amdgcn_cosf(rev1); }
            else { b = (m - MLAT) >> 8; n = SEQ + ((m - MLAT) & 255); }
            const float qa0 = bf2f(q1[r] & 0xffffu), qa1 = bf2f(q1[r] >> 16), qb0 = bf2f(q2[r] & 0xffffu), qb1 = bf2f(q2[r] >> 16);
            const float ka0 = bf2f(k1[r] & 0xffffu), ka1 = bf2f(k1[r] >> 16), kb0 = bf2f(k2[r] & 0xffffu), kb1 = bf2f(k2[r] >> 16);
            const size_t dst = ((size_t)(b * 16 + hp) * NKEY + n) * 64 + i2;
            *(unsigned*)(DQ + dst) = pk2((qa0 * cs0 - qb0 * sn0) * C2, (qa1 * cs1 - qb1 * sn1) * C2);
            *(unsigned*)(DQ + dst + 32) = pk2((qa0 * sn0 + qb0 * cs0) * C2, (qa1 * sn1 + qb1 * cs1) * C2);
            *(unsigned*)(DK + dst) = pk2(ka0 * cs0 - kb0 * sn0, ka1 * cs1 - kb1 * sn1);
            *(unsigned*)(DK + dst + 32) = pk2(ka0 * sn0 + kb0 * cs0, ka1 * sn1 + kb1 * cs1);
        }
    }
}
template <int DV>
__device__ __forceinline__ void vtrans_item(LAS unsigned char* lds, const bf16_t* P, int colbase, bf16_t* Vt, int b, int hh, int tile) {
    constexpr int ST = DV + 2;
    LAS bf16_t* L = (LAS bf16_t*)lds;
    const int tid = otid();
    constexpr int CPR = DV / 8;
#pragma unroll
    for (int j = 0; j < (64 * CPR) / 512; ++j) {
        const int c = tid + 512 * j, key = c / CPR, ch = c % CPR;
        const u32x4 raw = *(const u32x4*)(P + (size_t)prow(b, tile * 64 + key) * INWP + colbase + hh * DV + ch * 8);
        LAS unsigned* d = (LAS unsigned*)(L + key * ST + ch * 8);
        d[0] = raw.x; d[1] = raw.y; d[2] = raw.z; d[3] = raw.w;
    }
    __syncthreads();
    if (tid < DV * 4) {
        const int d = tid >> 2, pg = tid & 3;
        unsigned w[8];
#pragma unroll
        for (int j2 = 0; j2 < 8; ++j2) {
            const int ja = 2 * j2, jb = 2 * j2 + 1;
            const int ka = 16 * pg + ((ja & 3) | ((ja & 4) << 1) | ((ja & 8) >> 1)), kb = 16 * pg + ((jb & 3) | ((jb & 4) << 1) | ((jb & 8) >> 1));
            w[j2] = (unsigned)L[ka * ST + d] | ((unsigned)L[kb * ST + d] << 16);
        }
        bf16_t* dst = Vt + ((size_t)((b * 8 + hh) * DV + d) * NKEY) + tile * 64 + 16 * pg;
        *(u32x4*)dst = (u32x4){w[0], w[1], w[2], w[3]}; *(u32x4*)(dst + 8) = (u32x4){w[4], w[5], w[6], w[7]};
    }
    __syncthreads();
}

template <int DV>
__device__ __forceinline__ void vtrans_loop(LAS unsigned char* lds, const bf16_t* P, int colbase, bf16_t* Vt, int bx, int G) {
    constexpr int ST = DV + 2, CPR = DV / 8, NCH = (64 * CPR) / 512, NITEMS = NB * 8 * NTILE;
    LAS bf16_t* L = (LAS bf16_t*)lds;
    const int tid = otid();
    u32x4 nx[NCH];
#define VT_LOAD(it_) do { const int b_ = (it_) / (8 * NTILE), hh_ = ((it_) / NTILE) % 8, tile_ = (it_) % NTILE; \
        _Pragma("unroll") for (int j = 0; j < NCH; ++j) { const int c = tid + 512 * j, key = c / CPR, ch = c % CPR; \
            nx[j] = *(const u32x4*)(P + (size_t)prow(b_, tile_ * 64 + key) * INWP + colbase + hh_ * DV + ch * 8); } } while (0)
    int it = bx;
    if (it < NITEMS) VT_LOAD(it);
    for (; it < NITEMS; it += G) {
        const int b = it / (8 * NTILE), hh = (it / NTILE) % 8, tile = it % NTILE;
#pragma unroll
        for (int j = 0; j < NCH; ++j) { const int c = tid + 512 * j, key = c / CPR, ch = c % CPR;
            LAS unsigned* d = (LAS unsigned*)(L + key * ST + ch * 8);
            d[0] = nx[j].x; d[1] = nx[j].y; d[2] = nx[j].z; d[3] = nx[j].w; }
        if (it + G < NITEMS) VT_LOAD(it + G);
        __syncthreads();
        if (tid < DV * 4) {
            const int d = tid >> 2, pg = tid & 3;
            unsigned w[8];
#pragma unroll
            for (int j2 = 0; j2 < 8; ++j2) {
                const int ja = 2 * j2, jb = 2 * j2 + 1;
                const int ka = 16 * pg + ((ja & 3) | ((ja & 4) << 1) | ((ja & 8) >> 1)), kb = 16 * pg + ((jb & 3) | ((jb & 4) << 1) | ((jb & 8) >> 1));
                w[j2] = (unsigned)L[ka * ST + d] | ((unsigned)L[kb * ST + d] << 16);
            }
            bf16_t* dst = Vt + ((size_t)((b * 8 + hh) * DV + d) * NKEY) + tile * 64 + 16 * pg;
            *(u32x4*)dst = (u32x4){w[0], w[1], w[2], w[3]}; *(u32x4*)(dst + 8) = (u32x4){w[4], w[5], w[6], w[7]};
        }
        __syncthreads();
    }
#undef VT_LOAD
}

__device__ __forceinline__ float logsig16(float x) { return (fminf(x, 0.f) - __logf(1.f + __expf(-fabsf(x)))) * (1.f / 16.f); }
__device__ __forceinline__ void gla_gates(LAS unsigned char* lds, const bf16_t* P, const float* wg, const float* bg, int b, int c, int h) {
    LAS float* la = (LAS float*)lds; LAS float* aL = (LAS float*)(lds + 33280);
    const int tid = otid();
    {
        const int t = tid >> 3, q4 = (tid & 7) * 4;
        const u32x2 raw = *(const u32x2*)(P + (size_t)prow(b, c * 64 + t) * INWP + GLA_OFF + 1536 + q4);
        LAS float* dst = aL + ((q4 >> 4) * 64 + t) * 16 + (q4 & 15);
        dst[0] = bf2f(raw.x & 0xffffu); dst[1] = bf2f(raw.x >> 16); dst[2] = bf2f(raw.y & 0xffffu); dst[3] = bf2f(raw.y >> 16);
    }
    const int d = tid & 63, tq = tid >> 6;
    float w0[16], w1[16];
#pragma unroll
    for (int r = 0; r < 16; ++r) { w0[r] = wg[r * 256 + h * 64 + d]; w1[r] = wg[(16 + r) * 256 + h * 64 + d]; }
    const float b0 = bg[h * 64 + d], b1 = bg[256 + h * 64 + d];
    __syncthreads();
#pragma unroll
    for (int tt = 0; tt < 8; ++tt) {
        const int t = tq * 8 + tt;
        float p0 = b0, p1 = b1;
#pragma unroll
        for (int r4 = 0; r4 < 4; ++r4) {
            const f32x4 a0 = *(const LAS f32x4*)(aL + t * 16 + r4 * 4), a1 = *(const LAS f32x4*)(aL + (64 + t) * 16 + r4 * 4);
            p0 += a0.x * w0[r4 * 4] + a0.y * w0[r4 * 4 + 1] + a0.z * w0[r4 * 4 + 2] + a0.w * w0[r4 * 4 + 3];
            p1 += a1.x * w1[r4 * 4] + a1.y * w1[r4 * 4 + 1] + a1.z * w1[r4 * 4 + 2] + a1.w * w1[r4 * 4 + 3];
        }
        la[t * 65 + d] = logsig16(p0); la[4160 + t * 65 + d] = logsig16(p1);
    }
    __syncthreads();
    {
        const int cz = (tid >> 6) & 1, seg = tid >> 7; LAS float* col = la + cz * 4160 + (tid & 63);
        float v[16];
#pragma unroll
        for (int i = 0; i < 16; ++i) v[i] = col[(seg * 16 + i) * 65];
        if (cz == 0) {
#pragma unroll
            for (int i = 1; i < 16; ++i) v[i] += v[i - 1];
        } else {
#pragma unroll
            for (int i = 14; i >= 0; --i) v[i] += v[i + 1];
        }
        LAS float* tot = aL + (tid & 127);
        tot[seg * 128] = cz == 0 ? v[15] : v[0];
        __syncthreads();
        float off = 0.f;
#pragma unroll
        for (int q = 0; q < 4; ++q) { const float tq_ = tot[q * 128]; off += ((cz == 0) ? (q < seg) : (q > seg)) ? tq_ : 0.f; }
#pragma unroll
        for (int i = 0; i < 16; ++i) col[(seg * 16 + i) * 65] = v[i] + off;
    }
    __syncthreads();
}
__device__ __forceinline__ void gla_g1_item(LAS unsigned char* lds, const bf16_t* P, const float* wg, const float* bg, float* GS, float* GD, int b, int c, int h) {
    gla_gates(lds, P, wg, bg, b, c, h);
    const LAS float* la = (const LAS float*)lds; LAS float* kd = (LAS float*)(lds + 41472); LAS float* vL = (LAS float*)(lds + 74240);
    const int tid = otid();
    {   const int t = tid >> 3, ch = tid & 7;
        const u32x4 rk = *(const u32x4*)(P + (size_t)prow(b, c * 64 + t) * INWP + GLA_OFF + 256 + h * 64 + ch * 8);
        u32x4 rv[2];
#pragma unroll
        for (int jj = 0; jj < 2; ++jj) { const int cc_ = tid + 512 * jj; rv[jj] = *(const u32x4*)(P + (size_t)prow(b, c * 64 + (cc_ >> 4)) * INWP + GLA_OFF + 512 + h * 128 + (cc_ & 15) * 8); }
        const unsigned kw[4] = {rk.x, rk.y, rk.z, rk.w};
#pragma unroll
        for (int e = 0; e < 8; ++e) { const int d = ch * 8 + e; const float k = bf2f((e & 1) ? (kw[e >> 1] >> 16) : (kw[e >> 1] & 0xffffu));
            kd[t * 64 + d] = k * __expf(la[63 * 65 + d] - la[t * 65 + d]);
            kd[4096 + t * 64 + d] = k * __expf(la[4160 + d] - la[4160 + t * 65 + d]); }
#pragma unroll
        for (int jj = 0; jj < 2; ++jj) { const int cc_ = tid + 512 * jj; LAS float* dv = vL + (cc_ >> 4) * 128 + (cc_ & 15) * 8;
            *(LAS f32x4*)dv = (f32x4){bf2f(rv[jj].x & 0xffffu), bf2f(rv[jj].x >> 16), bf2f(rv[jj].y & 0xffffu), bf2f(rv[jj].y >> 16)};
            *(LAS f32x4*)(dv + 4) = (f32x4){bf2f(rv[jj].z & 0xffffu), bf2f(rv[jj].z >> 16), bf2f(rv[jj].w & 0xffffu), bf2f(rv[jj].w >> 16)}; }
    }
    __syncthreads();
    const int v = tid & 127, dg = tid >> 7;
    f32x4 af4[4], ab4[4];
#pragma unroll
    for (int i = 0; i < 4; ++i) { af4[i] = (f32x4){0.f, 0.f, 0.f, 0.f}; ab4[i] = (f32x4){0.f, 0.f, 0.f, 0.f}; }
    for (int t = 0; t < 64; ++t) {
        const float vs = vL[t * 128 + v];
#pragma unroll
        for (int q = 0; q < 4; ++q) {
            const f32x4 kf = *(const LAS f32x4*)(kd + t * 64 + dg * 16 + q * 4), kb = *(const LAS f32x4*)(kd + 4096 + t * 64 + dg * 16 + q * 4);
            af4[q] += kf * vs; ab4[q] += kb * vs;
        }
    }
    float* gf = GS + ((size_t)((b * 2 + 0) * 4 + h) * NTILE + c) * 8192 + (dg * 16) * 128 + v;
    float* gb = GS + ((size_t)((b * 2 + 1) * 4 + h) * NTILE + c) * 8192 + (dg * 16) * 128 + v;
#pragma unroll
    for (int i = 0; i < 16; ++i) { gf[i * 128] = af4[i >> 2][i & 3]; gb[i * 128] = ab4[i >> 2][i & 3]; }
    if (tid < 128) { const int z = tid >> 6, d = tid & 63;
        GD[((size_t)((b * 2 + z) * 4 + h) * NTILE + c) * 64 + d] = __expf(z == 0 ? la[63 * 65 + d] : la[4160 + d]); }
    __syncthreads();
}
__device__ __forceinline__ void gla_scan(float* GS, const float* GD) {
    for (int gid = obid() * 512 + otid(); gid < 16 * 8192; gid += gridDim.x * 512) {
        const int v = gid & 127, d = (gid >> 7) & 63, chain = gid >> 13, z = (chain >> 2) & 1;
        float* gs = GS + (size_t)chain * NTILE * 8192 + d * 128 + v; const float* gd = GD + (size_t)chain * NTILE * 64 + d;
        float S = 0.f;
        for (int k0 = 0; k0 < NTILE; k0 += 10) {
            float L[10], Dc[10]; int cc[10];
#pragma unroll
            for (int j = 0; j < 10; ++j) { const int k = k0 + j; const int c = z ? (NTILE - 1 - k) : (k < 4 ? 256 + k : k - 4); cc[j] = c; L[j] = gs[(size_t)c * 8192]; Dc[j] = gd[c * 64]; }
#pragma unroll
            for (int j = 0; j < 10; ++j) { gs[(size_t)cc[j] * 8192] = S; S = Dc[j] * S + L[j]; }
        }
    }
}
__device__ __forceinline__ void gla_g3_item(LAS unsigned char* lds, const bf16_t* P, const float* wg, const float* bg, const float* GS, const float* gn, bf16_t* MIX, int b, int c, int h) {
    gla_gates(lds, P, wg, bg, b, c, h);
    const LAS float* la = (const LAS float*)lds;
    LAS float* QfT = (LAS float*)(lds + 41472); LAS float* QbT = (LAS float*)(lds + 57856);
    LAS float* KfT = (LAS float*)(lds + 74240); LAS float* KbT = (LAS float*)(lds + 90624);
    LAS float* VR = (LAS float*)(lds + 107008);
    LAS float* AT = (LAS float*)lds;
    LAS float* OL = KfT;
    const int tid = otid(), lane = tid & 63, wid = tid >> 6;
    {   const int t = tid >> 3, ch = tid & 7;
        const bf16_t* src = P + (size_t)prow(b, c * 64 + t) * INWP + GLA_OFF + h * 64 + ch * 8;
        const u32x4 rq = *(const u32x4*)src, rk = *(const u32x4*)(src + 256);
        LAS float* dq = VR + t * 65 + ch * 8; LAS float* dk = VR + 4160 + t * 65 + ch * 8;
        dq[0] = bf2f(rq.x & 0xffffu) * 0.125f; dq[1] = bf2f(rq.x >> 16) * 0.125f; dq[2] = bf2f(rq.y & 0xffffu) * 0.125f; dq[3] = bf2f(rq.y >> 16) * 0.125f;
        dq[4] = bf2f(rq.z & 0xffffu) * 0.125f; dq[5] = bf2f(rq.z >> 16) * 0.125f; dq[6] = bf2f(rq.w & 0xffffu) * 0.125f; dq[7] = bf2f(rq.w >> 16) * 0.125f;
        dk[0] = bf2f(rk.x & 0xffffu); dk[1] = bf2f(rk.x >> 16); dk[2] = bf2f(rk.y & 0xffffu); dk[3] = bf2f(rk.y >> 16);
        dk[4] = bf2f(rk.z & 0xffffu); dk[5] = bf2f(rk.z >> 16); dk[6] = bf2f(rk.w & 0xffffu); dk[7] = bf2f(rk.w >> 16); }
    __syncthreads();
    for (int idx = tid; idx < 4096; idx += 512) { const int t = idx & 63, d = idx >> 6;
        const float q = VR[t * 65 + d], k = VR[4160 + t * 65 + d], bp = la[t * 65 + d], bs = la[4160 + t * 65 + d];
        QfT[d * 64 + t] = q * __expf(bp); QbT[d * 64 + t] = q * __expf(bs); KfT[d * 64 + t] = k * __expf(-bp); KbT[d * 64 + t] = k * __expf(-bs); }
    __syncthreads();
#pragma unroll
    for (int jj = 0; jj < 2; ++jj) { const int cc_ = tid + 512 * jj, t = cc_ >> 4, ch = cc_ & 15;
        const u32x4 rv = *(const u32x4*)(P + (size_t)prow(b, c * 64 + t) * INWP + GLA_OFF + 512 + h * 128 + ch * 8);
        LAS float* dv = VR + t * 128 + ch * 8;
        *(LAS f32x4*)dv = (f32x4){bf2f(rv.x & 0xffffu), bf2f(rv.x >> 16), bf2f(rv.y & 0xffffu), bf2f(rv.y >> 16)};
        *(LAS f32x4*)(dv + 4) = (f32x4){bf2f(rv.z & 0xffffu), bf2f(rv.z >> 16), bf2f(rv.w & 0xffffu), bf2f(rv.w >> 16)}; }
    {
        const int t0 = 2 * (tid >> 4), s0 = 4 * (tid & 15);
        f32x4 af[2], ab[2];
#pragma unroll
        for (int i = 0; i < 2; ++i) { af[i] = (f32x4){0.f, 0.f, 0.f, 0.f}; ab[i] = (f32x4){0.f, 0.f, 0.f, 0.f}; }
        for (int d = 0; d < 64; ++d) {
            const f32x2 qf = *(const LAS f32x2*)(QfT + d * 64 + t0), qb = *(const LAS f32x2*)(QbT + d * 64 + t0);
            const f32x4 kf = *(const LAS f32x4*)(KfT + d * 64 + s0), kb = *(const LAS f32x4*)(KbT + d * 64 + s0);
#pragma unroll
            for (int i = 0; i < 2; ++i) { af[i] += kf * qf[i]; ab[i] += kb * qb[i]; }
        }
#pragma unroll
        for (int i = 0; i < 2; ++i)
#pragma unroll
            for (int j = 0; j < 4; ++j) { const int t = t0 + i, s = s0 + j; AT[s * 64 + t] = (s <= t) ? af[i][j] : ab[i][j]; }
    }
    __syncthreads();
    {
        const int v = tid & 127, tg = tid >> 7;
        f32x4 acc4[4];
#pragma unroll
        for (int i = 0; i < 4; ++i) acc4[i] = (f32x4){0.f, 0.f, 0.f, 0.f};
        const float* Sf = GS + ((size_t)((b * 2 + 0) * 4 + h) * NTILE + c) * 8192 + v; const float* Sb = GS + ((size_t)((b * 2 + 1) * 4 + h) * NTILE + c) * 8192 + v;
#define G3_LD(buf, d0) do { _Pragma("unroll") for (int k = 0; k < 4; ++k) { buf[k] = Sf[((d0) + k) * 128]; buf[4 + k] = Sb[((d0) + k) * 128]; } } while (0)
#define G3_FMA(buf, d0) do { _Pragma("unroll") for (int k = 0; k < 4; ++k) { const int d = (d0) + k; const float sf = buf[k], sb = buf[4 + k]; \
            _Pragma("unroll") for (int q = 0; q < 4; ++q) { \
                const f32x4 a = *(const LAS f32x4*)(QfT + d * 64 + tg * 16 + q * 4), bq = *(const LAS f32x4*)(QbT + d * 64 + tg * 16 + q * 4); \
                acc4[q] += a * sf + bq * sb; } } } while (0)
        {   float sA[8], sB[8];
            G3_LD(sA, 0);
            for (int d0 = 0; d0 < 64; d0 += 8) {
                G3_LD(sB, d0 + 4); asm volatile("" ::: "memory");
                G3_FMA(sA, d0);
                if (d0 + 8 < 64) G3_LD(sA, d0 + 8);
                asm volatile("" ::: "memory");
                G3_FMA(sB, d0 + 4);
            }
        }
#undef G3_LD
#undef G3_FMA
        for (int s = 0; s < 64; ++s) {
            const float vs = VR[s * 128 + v];
#pragma unroll
            for (int q = 0; q < 4; ++q) {
                const f32x4 a = *(const LAS f32x4*)(AT + s * 64 + tg * 16 + q * 4);
                acc4[q] += a * vs;
            }
        }
#pragma unroll
        for (int i = 0; i < 16; ++i) OL[(tg * 16 + i) * 128 + v] = acc4[i >> 2][i & 3];
    }
    __syncthreads();
    const float g0 = gn[lane], g1 = gn[64 + lane];
    for (int i = 0; i < 8; ++i) {
        const int t = wid * 8 + i;
        const float v0 = OL[t * 128 + lane], v1 = OL[t * 128 + 64 + lane];
        const float ss = wave_sum(v0 * v0 + v1 * v1);
        const float rs = rsqrtf(ss * (1.f / 128.f) + EPS);
        const size_t row = prow(b, c * 64 + t);
        const bf16_t* gp = P + row * INWP + GLA_OFF + 1024 + h * 128;
        const float ga = bf2f(gp[lane]), gb = bf2f(gp[64 + lane]);
        bf16_t* dst = MIX + row * D + 512 + h * 128;
        dst[lane] = (bf16_t)f2bf(v0 * rs * g0 * (ga / (1.f + __expf(-ga)))); dst[64 + lane] = (bf16_t)f2bf(v1 * rs * g1 * (gb / (1.f + __expf(-gb))));
    }
    __syncthreads();
}

#define XB_TMO      128
#define XB_XCNT(j)  (256  + 64 * (j))
#define XB_XSUB(j)  (1280 + 64 * (j))
#define XB_XGEN(j)  (2304 + 64 * (j))
#define XB_TOP      3328
#define XB_TOPGEN   3392
#define XCD_BAR_WORDS 3456
#define XB_SPIN_CAP (1u << 24)

__device__ __forceinline__ unsigned xb_ld(unsigned* p)              { return __hip_atomic_load(p, __ATOMIC_RELAXED, __HIP_MEMORY_SCOPE_AGENT); }
__device__ __forceinline__ unsigned xb_add(unsigned* p, unsigned v) { return __hip_atomic_fetch_add(p, v, __ATOMIC_RELAXED, __HIP_MEMORY_SCOPE_AGENT); }
__device__ __forceinline__ unsigned xb_xcc_id() { return (unsigned)__builtin_amdgcn_s_getreg((3 << 11) | 20) & 0xFu; }
#define XB_SPIN(cond, bar) do { unsigned _sp = 0; while (cond) { __builtin_amdgcn_s_sleep(1); \
    if ((++_sp & 255u) == 0u) { if (xb_ld(&(bar)[XB_TMO])) break; if (_sp > XB_SPIN_CAP) { atomicAdd(&(bar)[XB_TMO], 1u); break; } } } } while (0)

struct XcdBarrier {
    unsigned* bar; unsigned x;
    volatile LAS unsigned* st;
};

__device__ __forceinline__ XcdBarrier xcd_barrier_post(unsigned* bar, volatile LAS unsigned* st) {
    XcdBarrier b; b.bar = bar; b.x = xb_xcc_id(); b.st = st;
    if (threadIdx.x == 0) (void)xb_add(&bar[XB_XCNT(b.x)], 1u);
    return b;
}
__device__ __forceinline__ void xcd_barrier_complete(unsigned* bar, unsigned x, unsigned& nloc, unsigned& nx) {
    const unsigned G = gridDim.x * gridDim.y * gridDim.z;
    unsigned sum, cnt, mine, sp = 0u;
    for (;;) {
        sum = 0u; cnt = 0u; mine = 0u;
#pragma unroll
        for (unsigned j = 0; j < 16; ++j) { const unsigned c = xb_ld(&bar[XB_XCNT(j)]); sum += c; cnt += (c > 0u) ? 1u : 0u; mine = (j == x) ? c : mine; }
        if (sum == G) break;
        __builtin_amdgcn_s_sleep(1);
        if ((++sp & 255u) == 0u) { if (xb_ld(&bar[XB_TMO])) break; if (sp > XB_SPIN_CAP) { atomicAdd(&bar[XB_TMO], 1u); break; } }
    }
    nloc = mine > 0u ? mine : 1u; nx = cnt > 0u ? cnt : 1u;
}

__device__ __forceinline__ void xcd_barrier(const XcdBarrier& b) {
    asm volatile("s_waitcnt vmcnt(0)" ::: "memory");
    __syncthreads();
    if (threadIdx.x == 0) {
        unsigned* bar = b.bar;
        __builtin_amdgcn_s_waitcnt(0);
        unsigned nloc = b.st[0], nx = b.st[1];
        if (nloc == 0u) { xcd_barrier_complete(bar, b.x, nloc, nx); b.st[0] = nloc; b.st[1] = nx; }
        const unsigned old = xb_add(&bar[XB_XSUB(b.x)], 1u);
        const unsigned gen = old / nloc;
        if (old + 1u == (gen + 1u) * nloc) {
            __builtin_amdgcn_fence(__ATOMIC_RELEASE, "agent");
            asm volatile("s_waitcnt vmcnt(0)" ::: "memory");
            const unsigned og = xb_add(&bar[XB_TOP], 1u);
            const unsigned tg = og / nx;
            if (og + 1u == (tg + 1u) * nx) xb_add(&bar[XB_TOPGEN], 1u);
            else XB_SPIN(xb_ld(&bar[XB_TOPGEN]) == tg, bar);
            __builtin_amdgcn_fence(__ATOMIC_ACQUIRE, "agent");
            xb_add(&bar[XB_XGEN(b.x)], 1u);
            asm volatile("s_waitcnt vmcnt(0)" ::: "memory");
        } else {
            XB_SPIN(xb_ld(&bar[XB_XGEN(b.x)]) == gen, bar);
            __builtin_amdgcn_fence(__ATOMIC_ACQUIRE, "agent");
            asm volatile("s_waitcnt vmcnt(0)" ::: "memory");
        }
    }
    __syncthreads();
}

__global__ void __launch_bounds__(512) fwd_kernel(Params p) {
    extern __shared__ __attribute__((aligned(16))) unsigned char lds_raw[];
    LAS unsigned char* lds = (LAS unsigned char*)lds_raw;
    cg::grid_group grid = cg::this_grid();
    { const int t_ = otid(); if (t_ < 16) ((LAS unsigned*)(lds + LDS_BYTES - 64))[t_] = 0u; }
    __syncthreads();
    XcdBarrier xbar = xcd_barrier_post((unsigned*)p.ws, (volatile LAS unsigned*)(lds + LDS_BYTES - 64));
    const int G = gridDim.x, bx = obid();
    bf16_t* P = (bf16_t*)(p.ws + WS_P); bf16_t* MIX = (bf16_t*)(p.ws + WS_MIX); bf16_t* XN = (bf16_t*)(p.ws + WS_XN);
    bf16_t* YB = (bf16_t*)(p.ws + WS_YG); bf16_t* HB = (bf16_t*)(p.ws + WS_H);
    float* GS = (float*)(p.ws + WS_YG); float* GD = (float*)(p.ws + WS_GD);
    bf16_t* DQ = (bf16_t*)(p.ws + WS_DQ); bf16_t* DK = (bf16_t*)(p.ws + WS_DK); bf16_t* DVt = (bf16_t*)(p.ws + WS_DVT); bf16_t* NAVt = (bf16_t*)(p.ws + WS_NAVT);
    for (int ph = p.ph_lo; ph < p.ph_hi; ++ph) {
        bool is_gemm = false; pg8::Gemm g{nullptr, nullptr, 0, 0, 0}; pg8::EpiAct E{nullptr, 0, 0};
        if (ph == 0) { if (EN(0)) { ph_mod(p, lds); ph_wconv(p, lds, 0); } }
        else if (ph == 1) { if (EN(1)) row_pass(p, 0, 0); }
        else {
            const int l = (ph - 2) / 9, s = (ph - 2) % 9;
            const bool need_ctx = (l + 1 < DEPTH);
            const int Mpost = need_ctx ? MTOT : MLAT;
            if (s == 0) { is_gemm = true; g = pg8::Gemm{XN, (const bf16_t*)(p.ws + WS_WIN), MTOT, INWP, D}; E = pg8::EpiAct{P, INWP, 0}; }
            else if (s == 4) { is_gemm = true; g = pg8::Gemm{MIX, (const bf16_t*)(p.ws + WS_WOUT), Mpost, D, D}; E = pg8::EpiAct{YB, D, 0}; }
            else if (s == 6) { is_gemm = true; g = pg8::Gemm{XN, (const bf16_t*)(p.ws + WS_W1), Mpost, HID, D}; E = pg8::EpiAct{HB, HID, 1}; }
            else if (s == 7) { is_gemm = true; g = pg8::Gemm{HB, (const bf16_t*)(p.ws + WS_W2), Mpost, D, HID}; E = pg8::EpiAct{YB, D, 0}; }
            else if (s == 1 && EN(2)) {
                rope_rows(p);
                vtrans_loop<128>(lds, P, DIFF_OFF + 2048, DVt, bx, G);
                vtrans_loop<64>(lds, P, 1024, NAVt, bx, G);
                const float* wg = p.gla_w_gate + (size_t)l * 2 * 16 * 256; const float* bg = p.gla_b_gate + (size_t)l * 2 * 256;
                for (int it = bx; it < NB * NTILE * 4; it += G) { const int h = it & 3, c = (it >> 2) % NTILE, b = it / (4 * NTILE); gla_g1_item(lds, P, wg, bg, GS, GD, b, c, h); }
            }
            else if (s == 2 && EN(3)) {
                if (EN(11)) gla_scan(GS, GD);
                const float* relb = p.na_rel_bias + (size_t)l * 8 * 465;
                const int nq = need_ctx ? 260 : 256;
                if (EN(10)) for (int it = bx; it < NB * 2 * nq; it += G) { int hg, qblk, b;
                    if (it < NB * 2 * 256) { hg = it & 1; qblk = (it >> 1) & 255; b = it >> 9; }
                    else { const int r = it - NB * 2 * 256; hg = r & 1; qblk = 256 + ((r >> 1) & 3); b = r >> 3; }
                    na_unit(lds, P, NAVt, MIX, relb, b, hg, qblk); }
            }
            else if (s == 3 && EN(4)) {
                const float* wg = p.gla_w_gate + (size_t)l * 2 * 16 * 256; const float* bg = p.gla_b_gate + (size_t)l * 2 * 256;
                const int nc = need_ctx ? NTILE : 256;
                if (EN(8)) for (int it = bx; it < NB * nc * 4; it += G) { const int h = it & 3, c = (it >> 2) % nc, b = it / (4 * nc); gla_g3_item(lds, P, wg, bg, GS, p.gla_g_norm + l * 128, MIX, b, c, h); }
                const float* lp = p.diff_lambda + (size_t)l * 4 * 64;
                float d01 = 0.f, d23 = 0.f;
                for (int i = 0; i < 64; ++i) { d01 += lp[i] * lp[64 + i]; d23 += lp[128 + i] * lp[192 + i]; }
                const float lam_init = 0.8f - 0.6f * __expf(-0.3f * (float)l);
                const float lam = __expf(d01) - __expf(d23) + lam_init;
                const int nqb = need_ctx ? 130 : 128;
                if (EN(9)) for (int it = bx; it < NB * 8 * nqb; it += G) {
                    int qb, h, b;
                    if (it < NB * 8 * 128) { qb = it & 127; h = (it >> 7) & 7; b = it >> 10; }
                    else { const int r = it - NB * 8 * 128; qb = 128 + (r & 1); h = (r >> 1) & 7; b = r >> 4; }
                    const bool isctx = qb >= 128;
                    diff_unit(lds, DQ, DK, DVt, MIX, b, h, qb * 128, isctx ? 256 : 0, NTILE, lam, p.diff_g_norm + l * 128, 1.f - lam_init);
                }
            }
            else if (s == 5 && EN(5)) { row_pass(p, l, 1); }
            else if (s == 8 && EN(6)) { row_pass(p, l, 2); if (l + 1 < DEPTH) ph_wconv(p, lds, l + 1); }
        }
        if (is_gemm && EN(7)) { pg8::StaticOrder S; S.init(g.M, g.N, G, bx); pg8::gemm_phase<pg8::EpiAct, pg8::StaticOrder, true, true>(lds, g, S, E); }
        if (ph + 1 < p.ph_hi) { if (ph == 0) grid.sync(); else xcd_barrier(xbar); }
    }

}

extern "C" void kernel_launch(void* const* d_in, const int* in_sizes, int n_in, void* d_out, int out_size, void* d_ws, size_t ws_size, hipStream_t stream) {
    static int grid = 0;
    if (grid == 0) {
        if (n_in != 20 || in_sizes[0] != MLAT * D || out_size != MLAT * D || ws_size < WS_END) {
            fprintf(stderr, "kernel_launch: unexpected shapes (n_in %d, in0 %d, out %d, ws %zu); nothing launched\n", n_in, n_in > 0 ? in_sizes[0] : -1, out_size, ws_size); grid = -1; return; }
        int dev = 0, cus = 0, per_cu = 0;
        if (hipGetDevice(&dev) != hipSuccess || hipDeviceGetAttribute(&cus, hipDeviceAttributeMultiprocessorCount, dev) != hipSuccess) { grid = -1; return; }
        if (hipFuncSetAttribute((const void*)fwd_kernel, hipFuncAttributeMaxDynamicSharedMemorySize, LDS_BYTES) != hipSuccess) { fprintf(stderr, "kernel_launch: hipFuncSetAttribute failed\n"); grid = -1; return; }
        if (hipOccupancyMaxActiveBlocksPerMultiprocessor(&per_cu, (const void*)fwd_kernel, 512, LDS_BYTES) != hipSuccess || per_cu < 1) { fprintf(stderr, "kernel_launch: occupancy query gave %d\n", per_cu); per_cu = 1; }
        (void)hipGetLastError();
        grid = cus * per_cu;
    }
    if (grid < 0) return;
    (void)hipMemsetAsync(d_ws, 0, WS_ZERO_BYTES, stream);
    Params p{};
    const float** pp = (const float**)&p;
    for (int i = 0; i < 20; ++i) pp[i] = (const float*)d_in[i];
    p.out = (float*)d_out; p.ws = (unsigned char*)d_ws; p.ph_lo = 0; p.ph_hi = NPH;
    void* args[] = {&p};
    hipError_t e = hipLaunchCooperativeKernel((const void*)fwd_kernel, dim3(grid), dim3(512), args, LDS_BYTES, stream);
    if (e != hipSuccess) fprintf(stderr, "cooperative launch failed: %s (grid %d)\n", hipGetErrorString(e), grid);
}
```

```cpp
#include <hip/hip_runtime.h>
#include <hip/hip_cooperative_groups.h>
#include <cstdio>
#include <cstdint>
namespace cg = cooperative_groups;
__device__ __forceinline__ int otid() { int t = threadIdx.x; asm volatile("" : "+v"(t)); return t; }
__device__ __forceinline__ int obid() { int t = blockIdx.x; asm volatile("" : "+s"(t)); return t; }
namespace pg8 {
#define PG8_LAS __attribute__((address_space(3)))
typedef unsigned short bf16_t;
typedef short bf16x8 __attribute__((ext_vector_type(8)));
typedef float f32x4 __attribute__((ext_vector_type(4)));
typedef unsigned u32x4 __attribute__((ext_vector_type(4)));
constexpr int BM = 256, BK = 64, HALF = 128, HTB = HALF * BK * 2  , STAGE_BYTES = 8 * HTB, NXCD = 8, WGM = 4;

__host__ __device__ __forceinline__ int lds_byte(int r, int c) { const int st = (r >> 4) * 2 + (c >> 5), rr = r & 15, cc = c & 31, ob = rr * 64 + cc * 2; return st * 1024 + (ob ^ (((ob >> 9) & 1) << 5)); }
__host__ __device__ __forceinline__ void stage_rc(int b, int& R, int& C) { const int st = b / 1024, sb = b % 1024, swz = sb ^ (((sb >> 9) & 1) << 5); R = (st >> 1) * 16 + swz / 64; C = (st & 1) * 32 + (swz % 64) / 2; }
__host__ __device__ __forceinline__ int perm32(int rho) { const int n = rho >> 4, i = rho & 15; return 8 * (i >> 2) + 4 * n + (i & 3); }

struct Unit { int pm, pn; };
struct Gemm { const bf16_t* A; const bf16_t* Bt; int M, N, K; };

struct StaticOrder {
    int nM, nN, nwg, G, c;
    __host__ __device__ void init(int M, int N, int G_, int c_) { nM = M / BM; nN = N / BM; nwg = nM * nN; G = G_; c = c_; }
    __host__ __device__ bool next(int i, Unit& u) const {
        const long L = (long)i * G + c; if (L >= nwg) return false;
        int wgid = (int)L; { const int q = nwg / NXCD, r = nwg % NXCD, xcd = wgid % NXCD, off = wgid / NXCD; wgid = (xcd < r ? xcd * (q + 1) : r * (q + 1) + (xcd - r) * q) + off; }
        const int nig = WGM * nN, gid = wgid / nig, fm = gid * WGM, gsz = (nM - fm) < WGM ? (nM - fm) : WGM;
        u.pm = fm + ((wgid % nig) % gsz); u.pn = (wgid % nig) / gsz; return true;
    }
    __device__ __forceinline__ void a_ready(const Unit&) const {}
    __device__ __forceinline__ void done(const Unit&) const {}
};

__device__ __forceinline__ unsigned cvt_pk_bf16(float lo, float hi) { unsigned r; asm volatile("v_cvt_pk_bf16_f32 %0, %1, %2" : "=v"(r) : "v"(lo), "v"(hi)); return r; }
typedef float f32x2 __attribute__((ext_vector_type(2)));
struct EpiAct {
    static constexpr bool PERM = true, AFTER_DRAIN = false;
    bf16_t* O; int ldc; int act;
    __device__ __forceinline__ void operator()(const f32x4 (&acc)[2][2][4][2], const Unit& u, int wr, int wc, int fr, int fq) const {
        const int row0 = u.pm * BM + wr * 64 + fr; const int col0 = u.pn * BM + wc * 32 + 8 * fq;
#pragma unroll
        for (int ai = 0; ai < 2; ++ai)
#pragma unroll
            for (int m = 0; m < 4; ++m) { bf16_t* rowp = O + (size_t)(row0 + ai * HALF + m * 16) * ldc + col0;
#pragma unroll
                for (int bj = 0; bj < 2; ++bj) { f32x4 v0 = acc[ai][bj][m][0], v1 = acc[ai][bj][m][1];
                    if (act) {
#pragma unroll
                        for (int e = 0; e < 4; ++e) { float a = fmaxf(v0[e], 0.f), b = fmaxf(v1[e], 0.f); v0[e] = a * a; v1[e] = b * b; } }
                    u32x4 w; w.x = cvt_pk_bf16(v0[0], v0[1]); w.y = cvt_pk_bf16(v0[2], v0[3]); w.z = cvt_pk_bf16(v1[0], v1[1]); w.w = cvt_pk_bf16(v1[2], v1[3]);
                    *(u32x4*)(rowp + bj * HALF) = w; } }
    }
};
template <class Epi, class Sched, bool ALIGN_EPI = false, bool SP2 = false>
__device__ __forceinline__ void gemm_phase(PG8_LAS unsigned char* lds, const Gemm g, const Sched& S, const Epi& E) {
    const int tid = otid(), wid = __builtin_amdgcn_readfirstlane(tid >> 6), lane = tid & 63, wr = wid >> 2, wc = wid & 3, fr = lane & 15, fq = lane >> 4;
    const int K = g.K, nt = K / BK;
    unsigned voffA[2], voffB[2];
#pragma unroll
    for (int i = 0; i < 2; ++i) { int R, C; stage_rc(tid * 16 + i * 8192, R, C); const int Rb = Epi::PERM ? ((R & ~31) + perm32(R & 31)) : R;
        voffA[i] = (unsigned)(R * K + C) * 2u; voffB[i] = (unsigned)(Rb * K + C) * 2u; }
    const size_t kstep = (size_t)(BK * 2);
    const size_t hstep = (size_t)HALF * K * 2;
    const size_t tstep = 2 * hstep;
    const unsigned ldsw = (unsigned)wid * 1024u;
    const int aoff = lds_byte(wr * 64 + fr, fq * 8), boff = lds_byte(wc * 32 + fr, fq * 8);
#define PG8_SA(b, h) (((b) * 2 + (h)) * HTB)
#define PG8_SB(b, h) ((4 + (b) * 2 + (h)) * HTB)
#define PG8_STAGE(bufoff, gbase, voff) do { _Pragma("unroll") for (int _i = 0; _i < 2; ++_i) \
        __builtin_amdgcn_global_load_lds((const unsigned*)((const char*)(gbase) + (voff)[_i]), (PG8_LAS unsigned*)(lds + (bufoff) + ldsw + _i * 8192), 16, 0, 0); } while (0)
#define PG8_LDA(dst, b, h) do { _Pragma("unroll") for (int m = 0; m < 4; ++m) _Pragma("unroll") for (int k = 0; k < 2; ++k) dst[m][k] = *(const PG8_LAS bf16x8*)(lds + PG8_SA(b, h) + aoff + m * 2048 + k * 1024); } while (0)
#define PG8_LDB(dst, b, h) do { _Pragma("unroll") for (int n = 0; n < 2; ++n) _Pragma("unroll") for (int k = 0; k < 2; ++k) dst[n][k] = *(const PG8_LAS bf16x8*)(lds + PG8_SB(b, h) + boff + n * 2048 + k * 1024); } while (0)
#define PG8_MMA(ai, bj, At, Bt) do { __builtin_amdgcn_s_setprio(1); _Pragma("unroll") for (int m = 0; m < 4; ++m) _Pragma("unroll") for (int n = 0; n < 2; ++n) _Pragma("unroll") for (int k = 0; k < 2; ++k) \
        acc[ai][bj][m][n] = __builtin_amdgcn_mfma_f32_16x16x32_bf16(Bt[n][k], At[m][k], acc[ai][bj][m][n], 0, 0, 0); __builtin_amdgcn_s_setprio(0); } while (0)
#define PG8_WAIT_V(n) asm volatile("s_waitcnt vmcnt(" #n ")" ::: "memory")
#define PG8_WAIT_L(n) asm volatile("s_waitcnt lgkmcnt(" #n ")" ::: "memory")
#define PG8_BAR __builtin_amdgcn_s_barrier()
#define PG8_SCHED __builtin_amdgcn_sched_barrier(0)
    Unit cur, nxt; int ui = 0;
    if (!S.next(0, cur)) return;
    f32x4 acc[2][2][4][2];
#pragma unroll
    for (int a = 0; a < 2; ++a)
#pragma unroll
        for (int b = 0; b < 2; ++b)
#pragma unroll
            for (int m = 0; m < 4; ++m)
#pragma unroll
                for (int n = 0; n < 2; ++n) acc[a][b][m][n] = (f32x4){0.f, 0.f, 0.f, 0.f};
    bf16x8 At[4][2], B0[2][2], B1[2][2];
    const char* cA = (const char*)g.A + (size_t)cur.pm * tstep; const char* cB = (const char*)g.Bt + (size_t)cur.pn * tstep;
    S.a_ready(cur);
    if constexpr (SP2) {
        PG8_STAGE(PG8_SB(0, 0), cB, voffB); PG8_STAGE(PG8_SB(0, 1), cB + hstep, voffB); PG8_STAGE(PG8_SA(0, 0), cA, voffA); PG8_STAGE(PG8_SA(0, 1), cA + hstep, voffA);
        if (wr == 1) PG8_BAR;
        PG8_WAIT_V(2); PG8_BAR;
        PG8_STAGE(PG8_SB(1, 0), cB + kstep, voffB); PG8_STAGE(PG8_SA(1, 0), cA + kstep, voffA); PG8_STAGE(PG8_SB(1, 1), cB + hstep + kstep, voffB);
        PG8_WAIT_V(6); PG8_BAR;
    } else {
        PG8_STAGE(PG8_SB(0, 0), cB, voffB); PG8_STAGE(PG8_SA(0, 0), cA, voffA); PG8_STAGE(PG8_SB(0, 1), cB + hstep, voffB); PG8_STAGE(PG8_SA(0, 1), cA + hstep, voffA);
        if (wr == 1) PG8_BAR;
        PG8_WAIT_V(4); PG8_BAR;
        PG8_STAGE(PG8_SB(1, 0), cB + kstep, voffB); PG8_STAGE(PG8_SA(1, 0), cA + kstep, voffA); PG8_STAGE(PG8_SB(1, 1), cB + hstep + kstep, voffB);
        PG8_WAIT_V(6); PG8_BAR;
    }
    for (;;) {
        const bool has_next = S.next(ui + 1, nxt);
        const char* nA = has_next ? (const char*)g.A + (size_t)nxt.pm * tstep : cA; const char* nB = has_next ? (const char*)g.Bt + (size_t)nxt.pn * tstep : cB;
        for (int t = 0; t < nt; t += 2) {
            const bool last = (t == nt - 2);
            const char* a1 = cA + (size_t)(t + 1) * kstep;
            const char* a2 = last ? nA : cA + (size_t)(t + 2) * kstep; const char* b2 = last ? nB : cB + (size_t)(t + 2) * kstep;
            const char* a3 = a2 + kstep; const char* b3 = b2 + kstep;
            if (last && has_next) S.a_ready(nxt);
            if constexpr (SP2) {
            PG8_LDB(B0, 0, 0); PG8_LDB(B1, 0, 1); PG8_SCHED; PG8_LDA(At, 0, 0); PG8_STAGE(PG8_SA(1, 1), a1 + hstep, voffA);
            PG8_WAIT_V(8); PG8_WAIT_L(0); PG8_BAR; PG8_MMA(0, 0, At, B0); PG8_MMA(0, 1, At, B1); PG8_BAR; PG8_SCHED;
            PG8_LDA(At, 0, 1); PG8_STAGE(PG8_SB(0, 0), b2, voffB); PG8_STAGE(PG8_SB(0, 1), b2 + hstep, voffB); PG8_STAGE(PG8_SA(0, 0), a2, voffA);
            PG8_WAIT_V(8); PG8_WAIT_L(0); PG8_BAR; PG8_MMA(1, 0, At, B0); PG8_MMA(1, 1, At, B1); PG8_BAR; PG8_SCHED;
            PG8_LDB(B0, 1, 0); PG8_LDB(B1, 1, 1); PG8_SCHED; PG8_LDA(At, 1, 0); PG8_STAGE(PG8_SA(0, 1), a2 + hstep, voffA);
            PG8_WAIT_V(8); PG8_WAIT_L(0); PG8_BAR; PG8_MMA(0, 0, At, B0); PG8_MMA(0, 1, At, B1); PG8_BAR; PG8_SCHED;
            PG8_LDA(At, 1, 1); PG8_STAGE(PG8_SB(1, 0), b3, voffB); PG8_STAGE(PG8_SB(1, 1), b3 + hstep, voffB); PG8_STAGE(PG8_SA(1, 0), a3, voffA);
            PG8_WAIT_V(8); PG8_WAIT_L(0); PG8_BAR; PG8_MMA(1, 0, At, B0); PG8_MMA(1, 1, At, B1); PG8_BAR; PG8_SCHED;
            } else {
            PG8_LDB(B0, 0, 0); PG8_SCHED; PG8_LDA(At, 0, 0); PG8_STAGE(PG8_SA(1, 1), a1 + hstep, voffA);
            PG8_WAIT_L(8); PG8_BAR; PG8_WAIT_L(0); PG8_MMA(0, 0, At, B0); PG8_BAR; PG8_SCHED;
            PG8_LDB(B1, 0, 1); PG8_STAGE(PG8_SB(0, 0), b2, voffB);
            PG8_BAR; PG8_WAIT_L(0); PG8_MMA(0, 1, At, B1); PG8_BAR;
            PG8_LDA(At, 0, 1); PG8_STAGE(PG8_SA(0, 0), a2, voffA);
            PG8_BAR; PG8_WAIT_L(0); PG8_MMA(1, 0, At, B0); PG8_BAR; PG8_SCHED;
            PG8_STAGE(PG8_SB(0, 1), b2 + hstep, voffB);
            PG8_WAIT_V(6); PG8_BAR; PG8_MMA(1, 1, At, B1); PG8_BAR;
            PG8_LDB(B0, 1, 0); PG8_SCHED; PG8_LDA(At, 1, 0); PG8_STAGE(PG8_SA(0, 1), a2 + hstep, voffA);
            PG8_WAIT_L(8); PG8_BAR; PG8_WAIT_L(0); PG8_MMA(0, 0, At, B0); PG8_BAR; PG8_SCHED;
            PG8_LDB(B1, 1, 1); PG8_STAGE(PG8_SB(1, 0), b3, voffB);
            PG8_BAR; PG8_WAIT_L(0); PG8_MMA(0, 1, At, B1); PG8_BAR;
            PG8_LDA(At, 1, 1); PG8_STAGE(PG8_SA(1, 0), a3, voffA);
            PG8_BAR; PG8_WAIT_L(0); PG8_MMA(1, 0, At, B0); PG8_BAR; PG8_SCHED;
            PG8_STAGE(PG8_SB(1, 1), b3 + hstep, voffB);
            PG8_WAIT_V(6); PG8_BAR; PG8_MMA(1, 1, At, B1); PG8_BAR;
            }
        }
        if constexpr (ALIGN_EPI) { if (wr == 0) PG8_BAR; }
        if constexpr (!Epi::AFTER_DRAIN) { E(acc, cur, wr, wc, fr, fq); S.done(cur); }
        if (!has_next) break;
#pragma unroll
        for (int a = 0; a < 2; ++a)
#pragma unroll
            for (int b = 0; b < 2; ++b)
#pragma unroll
                for (int m = 0; m < 4; ++m)
#pragma unroll
                    for (int n = 0; n < 2; ++n) acc[a][b][m][n] = (f32x4){0.f, 0.f, 0.f, 0.f};
        cur = nxt; cA = nA; cB = nB; ++ui;
        if constexpr (ALIGN_EPI) { if (wr == 1) PG8_BAR; }
    }
    PG8_WAIT_V(0);
    if constexpr (!ALIGN_EPI) { if (wr == 0) PG8_BAR; }
    PG8_BAR;
    if constexpr (Epi::AFTER_DRAIN) { E.fused(acc, cur, wr, wc, fr, fq, lds, wid, lane); S.done(cur); }
#undef PG8_SA
#undef PG8_SB
#undef PG8_STAGE
#undef PG8_LDA
#undef PG8_LDB
#undef PG8_MMA
#undef PG8_WAIT_V
#undef PG8_WAIT_L
#undef PG8_BAR
#undef PG8_SCHED
}
}
constexpr int D = 2048, NB = 2, SEQ = 16384, NCTX = 256, DEPTH = 2;
constexpr int MLAT = NB * SEQ, MCTX = NB * NCTX, MTOT = MLAT + MCTX;
constexpr int INW = 6176, INWP = 6400, HID = 8192;
constexpr int NKEY = SEQ + NCTX;
constexpr int NTILE = NKEY / 64;
constexpr int GLA_OFF = 1536, DIFF_OFF = 3104;
constexpr float EPS = 1e-6f;
constexpr float LOG2E = 1.4426950408889634f;
constexpr float C2 = 0.125f * LOG2E;
constexpr int NPH = 2 + 9 * DEPTH;
constexpr int LDS_BYTES = 147456;
#ifndef PHMASK
#define PHMASK 0xFFFF
#endif
#define EN(x) (((PHMASK) >> (x)) & 1)

constexpr size_t MiB = 1u << 20;
constexpr size_t WS_MOD = 1 * MiB, WS_ZERO_BYTES = 2 * MiB;
constexpr size_t WS_WIN = 2 * MiB, WS_WOUT = 27 * MiB, WS_W1 = 35 * MiB, WS_W2 = 67 * MiB;
constexpr size_t WS_XN = 99 * MiB;
constexpr size_t WS_DQ = WS_XN, WS_DK = WS_XN + 65 * MiB;
constexpr size_t WS_P = 229 * MiB;
constexpr size_t WS_MIX = WS_P + (size_t)MTOT * INWP * 2;
constexpr size_t WS_H = WS_P;
constexpr size_t WS_YG = 766 * MiB;
constexpr size_t WS_HC = 896 * MiB;
constexpr size_t WS_DVT = 900 * MiB;
constexpr size_t WS_NAVT = 965 * MiB;
constexpr size_t WS_GD = 998 * MiB;
constexpr size_t WS_END = 1000 * MiB;
static_assert(WS_MIX + (size_t)MTOT * D * 2 <= WS_YG && WS_H + (size_t)MTOT * HID * 2 <= WS_MIX + (size_t)MTOT * D * 2, "ws map");
static_assert((size_t)NB * 16 * NKEY * 64 * 2 == 65 * MiB, "dq size");

typedef unsigned short bf16_t;
typedef float f32x2 __attribute__((ext_vector_type(2)));
typedef float f32x4 __attribute__((ext_vector_type(4)));
typedef float f32x16 __attribute__((ext_vector_type(16)));
typedef short bf16x8 __attribute__((ext_vector_type(8)));
typedef unsigned u32x4 __attribute__((ext_vector_type(4)));
typedef unsigned u32x2 __attribute__((ext_vector_type(2)));
#define LAS __attribute__((address_space(3)))
#define LDS_WAIT() asm volatile("s_waitcnt lgkmcnt(0)" ::: "memory")

struct Params {
    const float *x, *c, *ctx, *c_ctx, *w_ada, *b_ada, *g_pre_mix, *g_post_mix, *g_pre_mlp, *g_post_mlp,
                *w_in, *w_out, *na_rel_bias, *gla_w_gate, *gla_b_gate, *gla_g_norm, *diff_lambda, *diff_g_norm, *w_mlp_in, *w_mlp_out;
    float* out; unsigned char* ws; int ph_lo, ph_hi;
};

__device__ __forceinline__ float bf2f(unsigned u) { return __uint_as_float(u << 16); }
__device__ __forceinline__ unsigned f2bf(float f) { unsigned u = __float_as_uint(f); return (u + 0x7fffu + ((u >> 16) & 1u)) >> 16; }
__device__ __forceinline__ unsigned pk2(float lo, float hi) { return f2bf(lo) | (f2bf(hi) << 16); }
__device__ __forceinline__ float wave_sum(float v) {
#pragma unroll
    for (int o = 1; o < 64; o <<= 1) v += __shfl_xor(v, o);
    return v;
}
__device__ __forceinline__ int prow(int b, int n) { return n < SEQ ? b * SEQ + n : MLAT + b * NCTX + (n - SEQ); }

__device__ __forceinline__ void ph_mod(const Params& p, LAS unsigned char* lds) {
    LAS float* sc = (LAS float*)lds;
    const int tid = otid();
    for (int i = tid; i < 3 * D; i += 512) { const float v = i < 2 * D ? p.c[i] : p.c_ctx[i - 2 * D]; sc[i] = v / (1.f + __expf(-v)); }
    __syncthreads();
    float* MOD = (float*)(p.ws + WS_MOD);
    const int col_in = tid & 255, kh = tid >> 8;
    for (int it = obid(); it < 2 * 48 * 8; it += gridDim.x) {
        const int ks = it & 7, cb = (it >> 3) % 48, l = it / 384;
        const int col = cb * 256 + col_in;
        const float* W = p.w_ada + (size_t)l * D * 12288 + col;
        const int k0 = ks * 256 + kh * 128;
        float a0 = 0.f, a1 = 0.f, a2 = 0.f;
#pragma unroll 8
        for (int k = k0; k < k0 + 128; ++k) { const float w = W[(size_t)k * 12288]; a0 += sc[k] * w; a1 += sc[D + k] * w; a2 += sc[2 * D + k] * w; }
        if (ks == 0 && kh == 0) { const float bb = p.b_ada[l * 12288 + col]; a0 += bb; a1 += bb; a2 += bb; }
        float* m = MOD + (size_t)l * 3 * 12288 + col;
        atomicAdd(m, a0); atomicAdd(m + 12288, a1); atomicAdd(m + 2 * 12288, a2);
    }
    __syncthreads();
}

__device__ __forceinline__ void transpose_item(const float* W, int K, int N, bf16_t* WT, LAS float* scr, int item, int lane) {
    const int nblk = N / 32, kb = item / nblk, nb = item % nblk, k0 = 64 * kb, n0 = 32 * nb;
#pragma unroll 8
    for (int i = 0; i < 32; ++i) { const int kk = 2 * i + (lane >> 5); scr[kk * 33 + (lane & 31)] = W[(size_t)(k0 + kk) * N + n0 + (lane & 31)]; }
    LDS_WAIT();
    const int c = lane & 7;
#pragma unroll
    for (int j = 0; j < 4; ++j) { const int n = (lane >> 3) + 8 * j; const LAS float* s = scr + (8 * c) * 33 + n;
        u32x4 o; o.x = pk2(s[0 * 33], s[1 * 33]); o.y = pk2(s[2 * 33], s[3 * 33]); o.z = pk2(s[4 * 33], s[5 * 33]); o.w = pk2(s[6 * 33], s[7 * 33]);
        *(u32x4*)(WT + (size_t)(n0 + n) * K + k0 + 8 * c) = o; }
    LDS_WAIT();
}
__device__ __forceinline__ void ph_wconv(const Params& p, LAS unsigned char* lds, int l) {
    const int tid = otid(), lane = tid & 63, wave = tid >> 6;
    LAS float* scr = (LAS float*)(lds + wave * 16384);
    const int gw = obid() * 8 + wave, NGW = gridDim.x * 8;
    constexpr int I_IN = (D / 64) * (INW / 32), I_OUT = (D / 64) * (D / 32), I_1 = (D / 64) * (HID / 32), I_2 = (HID / 64) * (D / 32);
    const float* win = p.w_in + (size_t)l * D * INW; const float* wout = p.w_out + (size_t)l * D * D;
    const float* w1 = p.w_mlp_in + (size_t)l * D * HID; const float* w2 = p.w_mlp_out + (size_t)l * HID * D;
    for (int it = gw; it < I_IN + I_OUT + I_1 + I_2; it += NGW) {
        int r = it;
        if (r < I_IN) { transpose_item(win, D, INW, (bf16_t*)(p.ws + WS_WIN), scr, r, lane); continue; } r -= I_IN;
        if (r < I_OUT) { transpose_item(wout, D, D, (bf16_t*)(p.ws + WS_WOUT), scr, r, lane); continue; } r -= I_OUT;
        if (r < I_1) { transpose_item(w1, D, HID, (bf16_t*)(p.ws + WS_W1), scr, r, lane); continue; } r -= I_1;
        transpose_item(w2, HID, D, (bf16_t*)(p.ws + WS_W2), scr, r, lane);
    }
    __syncthreads();
}

__device__ __forceinline__ void row_pass(const Params& p, int l, int mode) {
    const int tid = otid(), lane = tid & 63, wave = tid >> 6;
    const int gw = obid() * 8 + wave, NGW = gridDim.x * 8;
    const float* MOD = (const float*)(p.ws + WS_MOD);
    float* HC = (float*)(p.ws + WS_HC);
    const bf16_t* Y = (const bf16_t*)(p.ws + WS_YG);
    bf16_t* XN = (bf16_t*)(p.ws + WS_XN);
    const int nrows = (l == 0) ? MTOT : MLAT;
    const float* xin_lat; const float* xin_ctx; const float* gpost = nullptr; const float* gn; int jg = 0, jsh, jsc, lnext; bool do_next = true;
    if (mode == 0) { xin_lat = p.x; xin_ctx = p.ctx; gn = p.g_pre_mix; jsh = 0; jsc = 1; lnext = 0; }
    else if (mode == 1) { xin_lat = (l == 0) ? p.x : p.out; xin_ctx = (l == 0) ? p.ctx : HC; gpost = p.g_post_mix + l * D; jg = 2; gn = p.g_pre_mlp + l * D; jsh = 3; jsc = 4; lnext = l; }
    else { xin_lat = p.out; xin_ctx = HC; gpost = p.g_post_mlp + l * D; jg = 5; lnext = l + 1; do_next = (l + 1 < DEPTH); gn = p.g_pre_mix + (do_next ? lnext : l) * D; jsh = 0; jsc = 1; }
    f32x4 nxv[8]; u32x2 nyr[8];
#define ROW_LOAD(mm) do { const int m_ = (mm); const float* xr_ = m_ < MLAT ? xin_lat + (size_t)m_ * D : xin_ctx + (size_t)(m_ - MLAT) * D; \
        _Pragma("unroll") for (int j = 0; j < 8; ++j) nxv[j] = *(const f32x4*)(xr_ + j * 256 + lane * 4); \
        if (mode != 0) { const bf16_t* yr_ = Y + (size_t)m_ * D; _Pragma("unroll") for (int j = 0; j < 8; ++j) nyr[j] = *(const u32x2*)(yr_ + j * 256 + lane * 4); } } while (0)
    if (gw < nrows) ROW_LOAD(gw);
    for (int m = gw; m < nrows; m += NGW) {
        const int s = m < MLAT ? (m >> 14) : 2;
        f32x4 xv[8]; u32x2 yraw[8];
#pragma unroll
        for (int j = 0; j < 8; ++j) { xv[j] = nxv[j]; yraw[j] = nyr[j]; }
        if (m + NGW < nrows) ROW_LOAD(m + NGW);
        if (mode != 0) {
            f32x4 yv[8]; float ss = 0.f;
#pragma unroll
            for (int j = 0; j < 8; ++j) { const u32x2 raw = yraw[j];
                yv[j] = (f32x4){bf2f(raw.x & 0xffffu), bf2f(raw.x >> 16), bf2f(raw.y & 0xffffu), bf2f(raw.y >> 16)};
                ss += (yv[j].x * yv[j].x + yv[j].y * yv[j].y) + (yv[j].z * yv[j].z + yv[j].w * yv[j].w); }
            ss = wave_sum(ss);
            const float r = rsqrtf(ss * (1.f / D) + EPS);
            const float* gate = MOD + ((size_t)(l * 3 + s) * 6 + jg) * D;
            float* xo = m < MLAT ? p.out + (size_t)m * D : HC + (size_t)(m - MLAT) * D;
#pragma unroll
            for (int j = 0; j < 8; ++j) { const int col = j * 256 + lane * 4;
                const f32x4 g4 = *(const f32x4*)(gpost + col), gt = *(const f32x4*)(gate + col);
                xv[j] = xv[j] + gt * (yv[j] * r * g4);
                *(f32x4*)(xo + col) = xv[j]; }
        }
        if (do_next) {
            float ss = 0.f;
#pragma unroll
            for (int j = 0; j < 8; ++j) ss += (xv[j].x * xv[j].x + xv[j].y * xv[j].y) + (xv[j].z * xv[j].z + xv[j].w * xv[j].w);
            ss = wave_sum(ss);
            const float r = rsqrtf(ss * (1.f / D) + EPS);
            const float* sh = MOD + ((size_t)(lnext * 3 + s) * 6 + jsh) * D; const float* scl = MOD + ((size_t)(lnext * 3 + s) * 6 + jsc) * D;
            bf16_t* xn = XN + (size_t)m * D;
#pragma unroll
            for (int j = 0; j < 8; ++j) { const int col = j * 256 + lane * 4;
                const f32x4 g4 = *(const f32x4*)(gn + col), s4 = *(const f32x4*)(sh + col), c4 = *(const f32x4*)(scl + col);
                const f32x4 h = (xv[j] * r * g4) * (c4 + 1.f) + s4;
                u32x2 w; w.x = pk2(h.x, h.y); w.y = pk2(h.z, h.w);
                *(u32x2*)(xn + col) = w; }
        }
    }
#undef ROW_LOAD
}

constexpr int TSB = 144;
constexpr int KTB = 64 * TSB;
__device__ __forceinline__ int crow(int r, int hi) { return (r & 3) + 8 * (r >> 2) + 4 * hi; }
__device__ __forceinline__ float xhalf_max(float m) { auto rr = __builtin_amdgcn_permlane32_swap(__float_as_uint(m), __float_as_uint(m), false, false); return fmaxf(__uint_as_float(rr[0]), __uint_as_float(rr[1])); }
__device__ __forceinline__ float xhalf_sum(float m) { auto rr = __builtin_amdgcn_permlane32_swap(__float_as_uint(m), __float_as_uint(m), false, false); return __uint_as_float(rr[0]) + __uint_as_float(rr[1]); }
__device__ __forceinline__ float max3f(float a, float b, float c) { float r; asm("v_max3_f32 %0, %1, %2, %3" : "=v"(r) : "v"(a), "v"(b), "v"(c)); return r; }
__device__ __forceinline__ float fadd_s(float a, float b) { float r; asm("v_add_f32_e32 %0, %1, %2" : "=v"(r) : "v"(a), "v"(b)); return r; }
__device__ __forceinline__ void glds16(const void* gsrc, unsigned lds_dst) { unsigned keep;
    asm volatile("s_mov_b32 %0, m0\n\ts_mov_b32 m0, %2\n\ts_nop 0\n\tglobal_load_lds_dwordx4 %1, off\n\ts_mov_b32 m0, %0" : "=&s"(keep) : "v"(gsrc), "s"(lds_dst) : "memory"); }
#define LBARV() asm volatile("s_waitcnt vmcnt(0) lgkmcnt(0)\n\ts_barrier" ::: "memory")
#define LBAR() asm volatile("s_waitcnt lgkmcnt(0)\n\ts_barrier" ::: "memory")
typedef __bf16 bf16x2_t __attribute__((ext_vector_type(2)));
__device__ __forceinline__ unsigned cvtpk(float lo, float hi) { f32x2 v = {lo, hi}; bf16x2_t b = __builtin_convertvector(v, bf16x2_t); return __builtin_bit_cast(unsigned, b); }

__device__ __forceinline__ void wave_qk(f32x16& s0, f32x16& s1, const LAS unsigned char* Kt, const bf16x8 (&qf)[4], int r32, int hi) {
    s0 = (f32x16){}; s1 = (f32x16){};
#pragma unroll
    for (int d0 = 0; d0 < 4; ++d0) {
        const bf16x8 k0 = *(const LAS bf16x8*)(Kt + r32 * TSB + d0 * 32 + hi * 16);
        const bf16x8 k1 = *(const LAS bf16x8*)(Kt + (32 + r32) * TSB + d0 * 32 + hi * 16);
        s0 = __builtin_amdgcn_mfma_f32_32x32x16_bf16(k0, qf[d0], s0, 0, 0, 0);
        s1 = __builtin_amdgcn_mfma_f32_32x32x16_bf16(k1, qf[d0], s1, 0, 0, 0);
    }
}
template <int NDB, bool MASKED>
__device__ __forceinline__ void wave_softmax_pv(f32x16& s0, f32x16& s1, f32x16 (&o)[NDB], float& m, float& l, const LAS unsigned char* Vt, LAS float* scr, int r32, int hi) {
    float mx = fmaxf(s0[0], s1[0]);
#pragma unroll
    for (int r = 1; r < 16; ++r) mx = fmaxf(mx, fmaxf(s0[r], s1[r]));
    mx = xhalf_max(mx);
    if (__any(mx > m + 8.f)) {
        const float mn = fmaxf(m, mx); const float alpha = __builtin_amdgcn_exp2f(m - mn); m = mn; l *= alpha;
        if (hi == 0) scr[r32] = alpha;
        LDS_WAIT();
#pragma unroll
        for (int r = 0; r < 16; ++r) { const float a = scr[crow(r, hi)];
#pragma unroll
            for (int db = 0; db < NDB; ++db) o[db][r] *= a; }
        LDS_WAIT();
    }
    float ls = 0.f;
#pragma unroll
    for (int r = 0; r < 16; ++r) {
        float p0 = __builtin_amdgcn_exp2f(s0[r] - m), p1 = __builtin_amdgcn_exp2f(s1[r] - m);
        if (MASKED) { p0 = s0[r] < -1e29f ? 0.f : p0; p1 = s1[r] < -1e29f ? 0.f : p1; }
        s0[r] = p0; s1[r] = p1; ls += p0 + p1;
    }
    l += ls;
    bf16x8 pa[2][2];
#pragma unroll
    for (int s2 = 0; s2 < 2; ++s2) {
        u32x4 w0, w1;
        w0.x = cvtpk(s0[8 * s2 + 0], s0[8 * s2 + 1]); w0.y = cvtpk(s0[8 * s2 + 2], s0[8 * s2 + 3]); w0.z = cvtpk(s0[8 * s2 + 4], s0[8 * s2 + 5]); w0.w = cvtpk(s0[8 * s2 + 6], s0[8 * s2 + 7]);
        w1.x = cvtpk(s1[8 * s2 + 0], s1[8 * s2 + 1]); w1.y = cvtpk(s1[8 * s2 + 2], s1[8 * s2 + 3]); w1.z = cvtpk(s1[8 * s2 + 4], s1[8 * s2 + 5]); w1.w = cvtpk(s1[8 * s2 + 6], s1[8 * s2 + 7]);
        pa[0][s2] = __builtin_bit_cast(bf16x8, w0); pa[1][s2] = __builtin_bit_cast(bf16x8, w1);
    }
#pragma unroll
    for (int db = 0; db < NDB; ++db)
#pragma unroll
        for (int pp = 0; pp < 2; ++pp)
#pragma unroll
            for (int s2 = 0; s2 < 2; ++s2) {
                const bf16x8 v = *(const LAS bf16x8*)(Vt + (db * 32 + r32) * TSB + (32 * pp + 16 * s2 + 8 * hi) * 2);
                o[db] = __builtin_amdgcn_mfma_f32_32x32x16_bf16(pa[pp][s2], v, o[db], 0, 0, 0);
            }
}

constexpr int DTILEB = 2 * KTB + 128 * TSB;
__device__ __forceinline__ void diff_unit(LAS unsigned char* lds, const bf16_t* DQ, const bf16_t* DK, const bf16_t* DVt, bf16_t* MIX,
                                          int b, int h, int q0, int t0, int t1, float lam, const float* gnorm, float oscale) {
    const int tid = otid(), lane = tid & 63, wid = __builtin_amdgcn_readfirstlane(tid >> 6), r32 = lane & 31, hi = lane >> 5;
    const int grp = wid >> 2, p = wid & 1, qg = grp * 2 + ((wid >> 1) & 1);
    const int T = t1 - t0;
    LAS float* scr = (LAS float*)(lds + 3 * DTILEB) + wid * 32;
    const bf16_t* k0src = DK + ((size_t)((b * 8 + h) * 2 + 0) * NKEY) * 64 + tid * 8;
    const bf16_t* k1src = DK + ((size_t)((b * 8 + h) * 2 + 1) * NKEY) * 64 + tid * 8;
    const bf16_t* v0src = DVt + ((size_t)((b * 8 + h) * 128 + (tid >> 3)) * NKEY) + (tid & 7) * 8;
    const bf16_t* v1src = v0src + (size_t)64 * NKEY;
    const int kdst = (tid >> 3) * TSB + (tid & 7) * 16;
    u32x4 rk0, rk1, rv0, rv1;
#define DLOADK(t) do { rk0 = *(const u32x4*)(k0src + (size_t)(t) * 4096); rk1 = *(const u32x4*)(k1src + (size_t)(t) * 4096); } while (0)
#define DLOADV(t) do { rv0 = *(const u32x4*)(v0src + (t) * 64); rv1 = *(const u32x4*)(v1src + (t) * 64); } while (0)
#define DSTOREK(buf) do { LAS unsigned char* bb_ = lds + (buf) * DTILEB; *(LAS u32x4*)(bb_ + kdst) = rk0; *(LAS u32x4*)(bb_ + KTB + kdst) = rk1; } while (0)
#define DSTOREV(buf) do { LAS unsigned char* bb_ = lds + (buf) * DTILEB; *(LAS u32x4*)(bb_ + 2 * KTB + kdst) = rv0; *(LAS u32x4*)(bb_ + 2 * KTB + 64 * TSB + kdst) = rv1; } while (0)
    const bf16_t* qsrc = DQ + ((size_t)((b * 8 + h) * 2 + p) * NKEY + q0 + qg * 32 + r32) * 64 + hi * 8;
    bf16x8 qf[4];
#pragma unroll
    for (int d0 = 0; d0 < 4; ++d0) qf[d0] = *(const bf16x8*)(qsrc + d0 * 16);
    LAS unsigned char* qlds = lds + 3 * DTILEB + 1024 + wid * 4096 + lane * 16;
#pragma unroll
    for (int d0 = 0; d0 < 4; ++d0) *(LAS bf16x8*)(qlds + d0 * 1024) = qf[d0];
    f32x16 o[4]; o[0] = (f32x16){}; o[1] = (f32x16){}; o[2] = (f32x16){}; o[3] = (f32x16){};
    float m = 0.f, l = 0.f;
    f32x16 negm = (f32x16){};
    bf16x8 pa[2][2];
    f32x16 s0, s1;
    DLOADK(t0); DSTOREK(2); DLOADK(t0 + 1); DLOADV(t0); DSTOREK(0); DSTOREV(0);
    __syncthreads();
    wave_qk(s0, s1, lds + 2 * DTILEB + p * KTB, qf, r32, hi);
    const int wsub = wid & 3;
    const char* dsrc[5];
#pragma unroll
    for (int k = 0; k < 5; ++k) {
        const int B = (wsub + 4 * k) * 1024 + lane * 16;
        if (grp == 0) { const int pp = B >= KTB ? 1 : 0, Bp = B - pp * KTB, row = Bp / TSB; int col = Bp % TSB; if (col >= 128) col = 0;
            dsrc[k] = (const char*)(DK + ((size_t)((b * 8 + h) * 2 + pp) * NKEY) * 64) + row * 128 + col + (size_t)(t0 + 2) * 8192; }
        else { const int row = B / TSB; int col = B % TSB; if (col >= 128) col = 0;
            dsrc[k] = (const char*)(DVt + ((size_t)((b * 8 + h) * 128 + row) * NKEY)) + col + (size_t)(t0 + 1) * 128; }
    }
    const int dstride = grp == 0 ? 8192 : 128, gahead = 2 - grp;
    const unsigned ldsb = (unsigned)(size_t)(lds + (grp ? 2 * KTB : 0)) + wsub * 1024;
    auto STG = [&](const int e) __attribute__((always_inline)) {
        if (e + gahead < T) {
            const unsigned dbase = ldsb + (unsigned)(((e + 1) % 3) * DTILEB);
            const size_t off = (size_t)e * dstride;
#pragma unroll
            for (int k = 0; k < 4; ++k) glds16(dsrc[k] + off, (unsigned)__builtin_amdgcn_readfirstlane(dbase + k * 4096));
            if (wsub < 2) glds16(dsrc[4] + off, (unsigned)__builtin_amdgcn_readfirstlane(dbase + 16384));
        }
    };
    auto XH = [&](const int j) __attribute__((always_inline)) {
            {
                if (!(j & 1)) {
                asm volatile("s_nop 15\n\ts_nop 7" : "+v"(s0), "+v"(s1));
                float mxa = max3f(s0[0], s0[1], s1[0]), mxb = max3f(s0[2], s0[3], s1[1]); mxa = max3f(mxa, s1[2], s1[3]);
#pragma unroll
                for (int r = 4; r < 16; r += 4) { mxa = max3f(mxa, s0[r], s0[r + 1]); mxb = max3f(mxb, s0[r + 2], s0[r + 3]); mxa = max3f(mxa, s1[r], s1[r + 1]); mxb = max3f(mxb, s1[r + 2], s1[r + 3]); }
                float mx = max3f(mxa, mxb, mxb);
                { auto rr = __builtin_amdgcn_permlane32_swap(__float_as_uint(mx), __float_as_uint(mx), false, false); mx = max3f(__uint_as_float(rr[0]), __uint_as_float(rr[1]), __uint_as_float(rr[1])); }
                if (j == 0) {
                    m = mx;
#pragma unroll
                    for (int r = 0; r < 16; ++r) { s0[r] -= mx; s1[r] -= mx; negm[r] = -mx; }
                } else if (__any(mx > 8.f)) {
                    const float delta = fmaxf(mx, 0.f); const float alpha = __builtin_amdgcn_exp2f(-delta); m += delta; l *= alpha;
#pragma unroll
                    for (int r = 0; r < 16; ++r) { s0[r] -= delta; s1[r] -= delta; negm[r] = -m; }
                    if (hi == 0) scr[r32] = alpha;
                    LDS_WAIT();
#pragma unroll
                    for (int r = 0; r < 16; ++r) { const float a = scr[crow(r, hi)];
#pragma unroll
                        for (int db = 0; db < 4; ++db) o[db][r] *= a; }
                    LDS_WAIT();
                }
                }
                float ls = 0.f;
#pragma unroll
                for (int r = 0; r < 16; ++r) { s0[r] = __builtin_amdgcn_exp2f(s0[r]); s1[r] = __builtin_amdgcn_exp2f(s1[r]); }
                __builtin_amdgcn_sched_barrier(0);
                f32x2 la2 = {0.f, 0.f}, lb2 = {0.f, 0.f};
#pragma unroll
                for (int r = 0; r < 16; r += 2) {
                    const f32x2 pa2 = {s0[r], s0[r + 1]}, pb2 = {s1[r], s1[r + 1]};
                    asm("v_pk_add_f32 %0, %1, %2" : "=v"(la2) : "v"(la2), "v"(pa2));
                    asm("v_pk_add_f32 %0, %1, %2" : "=v"(lb2) : "v"(lb2), "v"(pb2));
                }
                l += (la2.x + la2.y) + (lb2.x + lb2.y) + ls;
#pragma unroll
                for (int s2 = 0; s2 < 2; ++s2) {
                    u32x4 w0, w1;
                    w0.x = cvtpk(s0[8 * s2 + 0], s0[8 * s2 + 1]); w0.y = cvtpk(s0[8 * s2 + 2], s0[8 * s2 + 3]); w0.z = cvtpk(s0[8 * s2 + 4], s0[8 * s2 + 5]); w0.w = cvtpk(s0[8 * s2 + 6], s0[8 * s2 + 7]);
                    w1.x = cvtpk(s1[8 * s2 + 0], s1[8 * s2 + 1]); w1.y = cvtpk(s1[8 * s2 + 2], s1[8 * s2 + 3]); w1.z = cvtpk(s1[8 * s2 + 4], s1[8 * s2 + 5]); w1.w = cvtpk(s1[8 * s2 + 6], s1[8 * s2 + 7]);
                    pa[0][s2] = __builtin_bit_cast(bf16x8, w0); pa[1][s2] = __builtin_bit_cast(bf16x8, w1);
                }
            }
    };
    auto YH = [&](const int j) __attribute__((always_inline)) {
            {
                const LAS unsigned char* bb = lds + (j % 3) * DTILEB;
                const LAS unsigned char* Vt = bb + 2 * KTB + r32 * TSB + hi * 16;
                const LAS unsigned char* Kt = bb + p * KTB + r32 * TSB + hi * 16;
                const bool more = (j + 1 < T);
                bf16x8 fa[4], fb[4];
#define VLD(dst, db) do { _Pragma("unroll") for (int pp = 0; pp < 2; ++pp) _Pragma("unroll") for (int s2 = 0; s2 < 2; ++s2) \
                        dst[pp * 2 + s2] = *(const LAS bf16x8*)(Vt + (db) * 32 * TSB + (32 * pp + 16 * s2) * 2); } while (0)
#define KLD(dst, dh) do { _Pragma("unroll") for (int dd = 0; dd < 2; ++dd) { dst[dd * 2] = *(const LAS bf16x8*)(Kt + ((dh) * 2 + dd) * 32); \
                        dst[dd * 2 + 1] = *(const LAS bf16x8*)(Kt + 32 * TSB + ((dh) * 2 + dd) * 32); } } while (0)
#define PVM(src, db) do { _Pragma("unroll") for (int pp = 0; pp < 2; ++pp) _Pragma("unroll") for (int s2 = 0; s2 < 2; ++s2) \
                        o[db] = __builtin_amdgcn_mfma_f32_32x32x16_bf16(pa[pp][s2], src[pp * 2 + s2], o[db], 0, 0, 0); } while (0)
#define QKM(src, dh) do { _Pragma("unroll") for (int dd = 0; dd < 2; ++dd) { s0 = __builtin_amdgcn_mfma_f32_32x32x16_bf16(src[dd * 2], qf[(dh) * 2 + dd], s0, 0, 0, 0); \
                        s1 = __builtin_amdgcn_mfma_f32_32x32x16_bf16(src[dd * 2 + 1], qf[(dh) * 2 + dd], s1, 0, 0, 0); } } while (0)
#define FENCE() do { asm volatile("" ::: "memory"); __builtin_amdgcn_sched_barrier(0); } while (0)
                VLD(fa, 0); FENCE();
                __builtin_amdgcn_s_setprio(1);
                VLD(fb, 1); FENCE(); PVM(fa, 0); FENCE();
                VLD(fa, 2); FENCE(); PVM(fb, 1); FENCE();
                VLD(fb, 3); FENCE(); PVM(fa, 2); FENCE();
                if (more) {
                    bf16x8 q0 = qf[0], q1 = qf[1];
                    KLD(fa, 0); FENCE(); PVM(fb, 3); FENCE();
                    KLD(fb, 1); FENCE();
                    s0 = __builtin_amdgcn_mfma_f32_32x32x16_bf16(fa[0], q0, negm, 0, 0, 0); s1 = __builtin_amdgcn_mfma_f32_32x32x16_bf16(fa[1], q0, negm, 0, 0, 0);
                    s0 = __builtin_amdgcn_mfma_f32_32x32x16_bf16(fa[2], q1, s0, 0, 0, 0);   s1 = __builtin_amdgcn_mfma_f32_32x32x16_bf16(fa[3], q1, s1, 0, 0, 0);
                    q0 = qf[2]; q1 = qf[3];
                    FENCE();
                    s0 = __builtin_amdgcn_mfma_f32_32x32x16_bf16(fb[0], q0, s0, 0, 0, 0); s1 = __builtin_amdgcn_mfma_f32_32x32x16_bf16(fb[1], q0, s1, 0, 0, 0);
                    s0 = __builtin_amdgcn_mfma_f32_32x32x16_bf16(fb[2], q1, s0, 0, 0, 0); s1 = __builtin_amdgcn_mfma_f32_32x32x16_bf16(fb[3], q1, s1, 0, 0, 0);
                } else { PVM(fb, 3); }
                __builtin_amdgcn_s_setprio(0);
#undef VLD
#undef KLD
#undef PVM
#undef QKM
#undef FENCE
            }
    };
    if (grp == 0) {
        for (int j = 0; j < T; ++j) { STG(j); XH(j); __builtin_amdgcn_sched_barrier(0); YH(j); LBARV(); __builtin_amdgcn_sched_barrier(0); }
        LBARV();
    } else {
        STG(0); XH(0); LBARV(); __builtin_amdgcn_sched_barrier(0);
        for (int j = 1; j < T; ++j) { STG(j); YH(j - 1); __builtin_amdgcn_sched_barrier(0); XH(j); LBARV(); __builtin_amdgcn_sched_barrier(0); }
        YH(T - 1); LBARV();
    }
#undef DLOADK
#undef DLOADV
#undef DSTOREK
#undef DSTOREV
    {
        const float lt = xhalf_sum(l); const float inv = 1.f / lt; const float coef = p ? -lam * inv : inv;
        if (hi == 0) scr[r32] = coef;
        LDS_WAIT();
#pragma unroll
        for (int r = 0; r < 16; ++r) { const float a = scr[crow(r, hi)];
#pragma unroll
            for (int db = 0; db < 4; ++db) o[db][r] *= a; }
        LDS_WAIT();
    }
    LAS float* stage = (LAS float*)lds;
    if (p == 1) {
#pragma unroll
        for (int r = 0; r < 16; ++r)
#pragma unroll
            for (int db = 0; db < 4; ++db) stage[(qg * 32 + crow(r, hi)) * 128 + db * 32 + r32] = o[db][r];
    }
    __syncthreads();
    if (p == 0) {
#pragma unroll
        for (int r = 0; r < 16; ++r)
#pragma unroll
            for (int db = 0; db < 4; ++db) { const int idx = (qg * 32 + crow(r, hi)) * 128 + db * 32 + r32; stage[idx] = stage[idx] + o[db][r]; }
    }
    __syncthreads();
    const float g0 = gnorm[lane], g1 = gnorm[64 + lane];
    for (int i = 0; i < 16; ++i) {
        const int row = wid * 16 + i;
        const float v0 = stage[row * 128 + lane], v1 = stage[row * 128 + 64 + lane];
        const float ss = wave_sum(v0 * v0 + v1 * v1);
        const float rs = rsqrtf(ss * (1.f / 128.f) + EPS) * oscale;
        bf16_t* dst = MIX + (size_t)prow(b, q0 + row) * D + 1024 + h * 128;
        dst[lane] = (bf16_t)f2bf(v0 * rs * g0); dst[64 + lane] = (bf16_t)f2bf(v1 * rs * g1);
    }
    __syncthreads();
}

constexpr int NHB = 2 * KTB;
__device__ __forceinline__ void na_unit(LAS unsigned char* lds, const bf16_t* P, const bf16_t* NAVt, bf16_t* MIX, const float* relb, int b, int hg, int qblk) {
    const int tid = otid(), lane = tid & 63, wid = __builtin_amdgcn_readfirstlane(tid >> 6), r32 = lane & 31, hi = lane >> 5;
    const int hh = wid >> 1, qg = wid & 1, head = hg * 4 + hh;
    const bool isctx = qblk >= 256;
    const int n0q = isctx ? SEQ + (qblk - 256) * 64 : qblk * 64;
    const int kr0 = isctx ? 0 : min(max(qblk - 4, 0), 248);
    const int NT = isctx ? 4 : 12;
#define NTILE_OF(i) (isctx ? 256 + (i) : ((i) < 4 ? 256 + (i) : kr0 + (i) - 4))
    LAS float* biasL = (LAS float*)(lds + 4 * NHB);
    LAS float* scr = (LAS float*)(lds + 4 * NHB + 7680) + wid * 32;
    for (int i = tid; i < 4 * 15 * 32; i += 512) { const int hh_ = i / 480, rem = i % 480, dr_ = rem >> 5, dc_ = rem & 31;
        biasL[i] = dc_ < 31 ? relb[(hg * 4 + hh_) * 465 + dr_ * 31 + dc_] * LOG2E : -1e30f; }
    unsigned boff0[4] = {0u, 0u, 0u, 0u}, boff1[4] = {0u, 0u, 0u, 0u};
    { const int qc = qg * 32 + r32, c0 = min(max(qc - 8, 0), 48);
#pragma unroll
      for (int r = 0; r < 16; ++r) { const int kc0 = crow(r, hi), kc1 = kc0 + 32;
          boff0[r >> 2] |= (unsigned)(((kc0 >= c0 && kc0 < c0 + 16) ? (kc0 - qc + 15) : 31) * 4) << (8 * (r & 3));
          boff1[r >> 2] |= (unsigned)(((kc1 >= c0 && kc1 < c0 + 16) ? (kc1 - qc + 15) : 31) * 4) << (8 * (r & 3)); } }
    const bf16_t* qsrc = P + (size_t)prow(b, n0q + qg * 32 + r32) * INWP + head * 64 + hi * 8;
    bf16x8 qf[4];
#pragma unroll
    for (int d0 = 0; d0 < 4; ++d0) qf[d0] = *(const bf16x8*)(qsrc + d0 * 16);
    const int kdst = (tid >> 3) * TSB + (tid & 7) * 16;
    u32x4 rk[4], rv[4];
#define NLOAD(tile) do { const int n0_ = (tile) * 64; const bf16_t* kp_ = P + (size_t)prow(b, n0_ + (tid >> 3)) * INWP + 512 + hg * 256 + (tid & 7) * 8; \
        const bf16_t* vp_ = NAVt + ((size_t)((b * 8 + hg * 4) * 64 + (tid >> 3)) * NKEY) + n0_ + (tid & 7) * 8; \
        _Pragma("unroll") for (int j = 0; j < 4; ++j) { rk[j] = *(const u32x4*)(kp_ + j * 64); rv[j] = *(const u32x4*)(vp_ + (size_t)j * 64 * NKEY); } } while (0)
#define NSTORE() do { _Pragma("unroll") for (int j = 0; j < 4; ++j) { *(LAS u32x4*)(lds + j * NHB + kdst) = rk[j]; *(LAS u32x4*)(lds + j * NHB + KTB + kdst) = rv[j]; } } while (0)
    f32x16 o[2]; o[0] = (f32x16){}; o[1] = (f32x16){};
    float m = -1e30f, l = 0.f;
    NLOAD(NTILE_OF(0));
    for (int i = 0; i < NT; ++i) {
        NSTORE(); __syncthreads();
        const int tl = NTILE_OF(i);
        if (i + 1 < NT) NLOAD(NTILE_OF(i + 1));
        f32x16 s0, s1;
        wave_qk(s0, s1, lds + hh * NHB, qf, r32, hi);
        if (tl < 256) {
            const LAS unsigned char* bl = (const LAS unsigned char*)biasL + hh * 1920 + (tl - qblk + 7) * 128;
#pragma unroll
            for (int r = 0; r < 16; ++r) {
                s0[r] = s0[r] * C2 + *(const LAS float*)(bl + ((boff0[r >> 2] >> (8 * (r & 3))) & 0xffu));
                s1[r] = s1[r] * C2 + *(const LAS float*)(bl + ((boff1[r >> 2] >> (8 * (r & 3))) & 0xffu));
            }
        } else {
#pragma unroll
            for (int r = 0; r < 16; ++r) { s0[r] *= C2; s1[r] *= C2; }
        }
        wave_softmax_pv<2, false>(s0, s1, o, m, l, lds + hh * NHB + KTB, scr, r32, hi);
        __syncthreads();
    }
#undef NLOAD
#undef NSTORE
#undef NTILE_OF
    {
        const float lt = xhalf_sum(l); const float inv = 1.f / lt;
        if (hi == 0) scr[r32] = inv;
        LDS_WAIT();
#pragma unroll
        for (int r = 0; r < 16; ++r) { const float a = scr[crow(r, hi)];
            bf16_t* dst = MIX + (size_t)prow(b, n0q + qg * 32 + crow(r, hi)) * D + head * 64 + r32;
            dst[0] = (bf16_t)f2bf(o[0][r] * a); dst[32] = (bf16_t)f2bf(o[1][r] * a); }
        LDS_WAIT();
    }
    __syncthreads();
}

__device__ __forceinline__ void rope_rows(const Params& p) {
    const bf16_t* P = (const bf16_t*)(p.ws + WS_P); bf16_t* DQ = (bf16_t*)(p.ws + WS_DQ); bf16_t* DK = (bf16_t*)(p.ws + WS_DK);
    const int tid = otid(), rsel = tid >> 8, hp = (tid >> 4) & 15, i2 = (tid & 15) * 2;
    const float inv0 = __builtin_amdgcn_exp2f(-(float)(i2 & 15) * (13.287712379549449f / 16.f));
    const float inv1 = __builtin_amdgcn_exp2f(-(float)((i2 + 1) & 15) * (13.287712379549449f / 16.f));
    for (int m0 = obid() * 8; m0 < MTOT; m0 += gridDim.x * 8) {
        unsigned q1[4], q2[4], k1[4], k2[4];
#pragma unroll
        for (int r = 0; r < 4; ++r) { const bf16_t* src = P + (size_t)(m0 + 2 * r + rsel) * INWP + DIFF_OFF + hp * 64 + i2;
            q1[r] = *(const unsigned*)src; q2[r] = *(const unsigned*)(src + 32); k1[r] = *(const unsigned*)(src + 1024); k2[r] = *(const unsigned*)(src + 1024 + 32); }
#pragma unroll
        for (int r = 0; r < 4; ++r) {
            const int m = m0 + 2 * r + rsel; int b, n; float cs0 = 1.f, sn0 = 0.f, cs1 = 1.f, sn1 = 0.f;
            if (m < MLAT) { b = m >> 14; const int t = m & (SEQ - 1); n = t; const float pos = (float)((i2 < 16) ? (t >> 6) : (t & 63));
                float rev0 = pos * inv0 * 0.15915494309189535f; rev0 -= rintf(rev0); sn0 = __builtin_amdgcn_sinf(rev0); cs0 = __builtin_amdgcn_cosf(rev0);
                float rev1 = pos * inv1 * 0.15915494309189535f; rev1 -= rintf(rev1); sn1 = __builtin_amdgcn_sinf(rev1); cs1 = __builtin_amdgcn_cosf(rev1); }
            else { b = (m - MLAT) >> 8; n = SEQ + ((m - MLAT) & 255); }
            const float qa0 = bf2f(q1[r] & 0xffffu), qa1 = bf2f(q1[r] >> 16), qb0 = bf2f(q2[r] & 0xffffu), qb1 = bf2f(q2[r] >> 16);
            const float ka0 = bf2f(k1[r] & 0xffffu), ka1 = bf2f(k1[r] >> 16), kb0 = bf2f(k2[r] & 0xffffu), kb1 = bf2f(k2[r] >> 16);
            const size_t dst = ((size_t)(b * 16 + hp) * NKEY + n) * 64 + i2;
            *(unsigned*)(DQ + dst) = pk2((qa0 * cs0 - qb0 * sn0) * C2, (qa1 * cs1 - qb1 * sn1) * C2);
            *(unsigned*)(DQ + dst + 32) = pk2((qa0 * sn0 + qb0 * cs0) * C2, (qa1 * sn1 + qb1 * cs1) * C2);
            *(unsigned*)(DK + dst) = pk2(ka0 * cs0 - kb0 * sn0, ka1 * cs1 - kb1 * sn1);
            *(unsigned*)(DK + dst + 32) = pk2(ka0 * sn0 + kb0 * cs0, ka1 * sn1 + kb1 * cs1);
        }
    }
}
template <int DV>
__device__ __forceinline__ void vtrans_item(LAS unsigned char* lds, const bf16_t* P, int colbase, bf16_t* Vt, int b, int hh, int tile) {
    constexpr int ST = DV + 2;
    LAS bf16_t* L = (LAS bf16_t*)lds;
    const int tid = otid();
    constexpr int CPR = DV / 8;
#pragma unroll
    for (int j = 0; j < (64 * CPR) / 512; ++j) {
        const int c = tid + 512 * j, key = c / CPR, ch = c % CPR;
        const u32x4 raw = *(const u32x4*)(P + (size_t)prow(b, tile * 64 + key) * INWP + colbase + hh * DV + ch * 8);
        LAS unsigned* d = (LAS unsigned*)(L + key * ST + ch * 8);
        d[0] = raw.x; d[1] = raw.y; d[2] = raw.z; d[3] = raw.w;
    }
    __syncthreads();
    if (tid < DV * 4) {
        const int d = tid >> 2, pg = tid & 3;
        unsigned w[8];
#pragma unroll
        for (int j2 = 0; j2 < 8; ++j2) {
            const int ja = 2 * j2, jb = 2 * j2 + 1;
            const int ka = 16 * pg + ((ja & 3) | ((ja & 4) << 1) | ((ja & 8) >> 1)), kb = 16 * pg + ((jb & 3) | ((jb & 4) << 1) | ((jb & 8) >> 1));
            w[j2] = (unsigned)L[ka * ST + d] | ((unsigned)L[kb * ST + d] << 16);
        }
        bf16_t* dst = Vt + ((size_t)((b * 8 + hh) * DV + d) * NKEY) + tile * 64 + 16 * pg;
        *(u32x4*)dst = (u32x4){w[0], w[1], w[2], w[3]}; *(u32x4*)(dst + 8) = (u32x4){w[4], w[5], w[6], w[7]};
    }
    __syncthreads();
}

template <int DV>
__device__ __forceinline__ void vtrans_loop(LAS unsigned char* lds, const bf16_t* P, int colbase, bf16_t* Vt, int bx, int G) {
    constexpr int ST = DV + 2, CPR = DV / 8, NCH = (64 * CPR) / 512, NITEMS = NB * 8 * NTILE;
    LAS bf16_t* L = (LAS bf16_t*)lds;
    const int tid = otid();
    u32x4 nx[NCH];
#define VT_LOAD(it_) do { const int b_ = (it_) / (8 * NTILE), hh_ = ((it_) / NTILE) % 8, tile_ = (it_) % NTILE; \
        _Pragma("unroll") for (int j = 0; j < NCH; ++j) { const int c = tid + 512 * j, key = c / CPR, ch = c % CPR; \
            nx[j] = *(const u32x4*)(P + (size_t)prow(b_, tile_ * 64 + key) * INWP + colbase + hh_ * DV + ch * 8); } } while (0)
    int it = bx;
    if (it < NITEMS) VT_LOAD(it);
    for (; it < NITEMS; it += G) {
        const int b = it / (8 * NTILE), hh = (it / NTILE) % 8, tile = it % NTILE;
#pragma unroll
        for (int j = 0; j < NCH; ++j) { const int c = tid + 512 * j, key = c / CPR, ch = c % CPR;
            LAS unsigned* d = (LAS unsigned*)(L + key * ST + ch * 8);
            d[0] = nx[j].x; d[1] = nx[j].y; d[2] = nx[j].z; d[3] = nx[j].w; }
        if (it + G < NITEMS) VT_LOAD(it + G);
        __syncthreads();
        if (tid < DV * 4) {
            const int d = tid >> 2, pg = tid & 3;
            unsigned w[8];
#pragma unroll
            for (int j2 = 0; j2 < 8; ++j2) {
                const int ja = 2 * j2, jb = 2 * j2 + 1;
                const int ka = 16 * pg + ((ja & 3) | ((ja & 4) << 1) | ((ja & 8) >> 1)), kb = 16 * pg + ((jb & 3) | ((jb & 4) << 1) | ((jb & 8) >> 1));
                w[j2] = (unsigned)L[ka * ST + d] | ((unsigned)L[kb * ST + d] << 16);
            }
            bf16_t* dst = Vt + ((size_t)((b * 8 + hh) * DV + d) * NKEY) + tile * 64 + 16 * pg;
            *(u32x4*)dst = (u32x4){w[0], w[1], w[2], w[3]}; *(u32x4*)(dst + 8) = (u32x4){w[4], w[5], w[6], w[7]};
        }
        __syncthreads();
    }
#undef VT_LOAD
}

__device__ __forceinline__ float logsig16(float x) { return (fminf(x, 0.f) - __logf(1.f + __expf(-fabsf(x)))) * (1.f / 16.f); }
__device__ __forceinline__ void gla_gates(LAS unsigned char* lds, const bf16_t* P, const float* wg, const float* bg, int b, int c, int h) {
    LAS float* la = (LAS float*)lds; LAS float* aL = (LAS float*)(lds + 33280);
    const int tid = otid();
    {
        const int t = tid >> 3, q4 = (tid & 7) * 4;
        const u32x2 raw = *(const u32x2*)(P + (size_t)prow(b, c * 64 + t) * INWP + GLA_OFF + 1536 + q4);
        LAS float* dst = aL + ((q4 >> 4) * 64 + t) * 16 + (q4 & 15);
        dst[0] = bf2f(raw.x & 0xffffu); dst[1] = bf2f(raw.x >> 16); dst[2] = bf2f(raw.y & 0xffffu); dst[3] = bf2f(raw.y >> 16);
    }
    const int d = tid & 63, tq = tid >> 6;
    float w0[16], w1[16];
#pragma unroll
    for (int r = 0; r < 16; ++r) { w0[r] = wg[r * 256 + h * 64 + d]; w1[r] = wg[(16 + r) * 256 + h * 64 + d]; }
    const float b0 = bg[h * 64 + d], b1 = bg[256 + h * 64 + d];
    __syncthreads();
#pragma unroll
    for (int tt = 0; tt < 8; ++tt) {
        const int t = tq * 8 + tt;
        float p0 = b0, p1 = b1;
#pragma unroll
        for (int r4 = 0; r4 < 4; ++r4) {
            const f32x4 a0 = *(const LAS f32x4*)(aL + t * 16 + r4 * 4), a1 = *(const LAS f32x4*)(aL + (64 + t) * 16 + r4 * 4);
            p0 += a0.x * w0[r4 * 4] + a0.y * w0[r4 * 4 + 1] + a0.z * w0[r4 * 4 + 2] + a0.w * w0[r4 * 4 + 3];
            p1 += a1.x * w1[r4 * 4] + a1.y * w1[r4 * 4 + 1] + a1.z * w1[r4 * 4 + 2] + a1.w * w1[r4 * 4 + 3];
        }
        la[t * 65 + d] = logsig16(p0); la[4160 + t * 65 + d] = logsig16(p1);
    }
    __syncthreads();
    {
        const int cz = (tid >> 6) & 1, seg = tid >> 7; LAS float* col = la + cz * 4160 + (tid & 63);
        float v[16];
#pragma unroll
        for (int i = 0; i < 16; ++i) v[i] = col[(seg * 16 + i) * 65];
        if (cz == 0) {
#pragma unroll
            for (int i = 1; i < 16; ++i) v[i] += v[i - 1];
        } else {
#pragma unroll
            for (int i = 14; i >= 0; --i) v[i] += v[i + 1];
        }
        LAS float* tot = aL + (tid & 127);
        tot[seg * 128] = cz == 0 ? v[15] : v[0];
        __syncthreads();
        float off = 0.f;
#pragma unroll
        for (int q = 0; q < 4; ++q) { const float tq_ = tot[q * 128]; off += ((cz == 0) ? (q < seg) : (q > seg)) ? tq_ : 0.f; }
#pragma unroll
        for (int i = 0; i < 16; ++i) col[(seg * 16 + i) * 65] = v[i] + off;
    }
    __syncthreads();
}
__device__ __forceinline__ void gla_g1_item(LAS unsigned char* lds, const bf16_t* P, const float* wg, const float* bg, float* GS, float* GD, int b, int c, int h) {
    gla_gates(lds, P, wg, bg, b, c, h);
    const LAS float* la = (const LAS float*)lds; LAS float* kd = (LAS float*)(lds + 41472); LAS float* vL = (LAS float*)(lds + 74240);
    const int tid = otid();
    {   const int t = tid >> 3, ch = tid & 7;
        const u32x4 rk = *(const u32x4*)(P + (size_t)prow(b, c * 64 + t) * INWP + GLA_OFF + 256 + h * 64 + ch * 8);
        u32x4 rv[2];
#pragma unroll
        for (int jj = 0; jj < 2; ++jj) { const int cc_ = tid + 512 * jj; rv[jj] = *(const u32x4*)(P + (size_t)prow(b, c * 64 + (cc_ >> 4)) * INWP + GLA_OFF + 512 + h * 128 + (cc_ & 15) * 8); }
        const unsigned kw[4] = {rk.x, rk.y, rk.z, rk.w};
#pragma unroll
        for (int e = 0; e < 8; ++e) { const int d = ch * 8 + e; const float k = bf2f((e & 1) ? (kw[e >> 1] >> 16) : (kw[e >> 1] & 0xffffu));
            kd[t * 64 + d] = k * __expf(la[63 * 65 + d] - la[t * 65 + d]);
            kd[4096 + t * 64 + d] = k * __expf(la[4160 + d] - la[4160 + t * 65 + d]); }
#pragma unroll
        for (int jj = 0; jj < 2; ++jj) { const int cc_ = tid + 512 * jj; LAS float* dv = vL + (cc_ >> 4) * 128 + (cc_ & 15) * 8;
            *(LAS f32x4*)dv = (f32x4){bf2f(rv[jj].x & 0xffffu), bf2f(rv[jj].x >> 16), bf2f(rv[jj].y & 0xffffu), bf2f(rv[jj].y >> 16)};
            *(LAS f32x4*)(dv + 4) = (f32x4){bf2f(rv[jj].z & 0xffffu), bf2f(rv[jj].z >> 16), bf2f(rv[jj].w & 0xffffu), bf2f(rv[jj].w >> 16)}; }
    }
    __syncthreads();
    const int v = tid & 127, dg = tid >> 7;
    f32x4 af4[4], ab4[4];
#pragma unroll
    for (int i = 0; i < 4; ++i) { af4[i] = (f32x4){0.f, 0.f, 0.f, 0.f}; ab4[i] = (f32x4){0.f, 0.f, 0.f, 0.f}; }
    for (int t = 0; t < 64; ++t) {
        const float vs = vL[t * 128 + v];
#pragma unroll
        for (int q = 0; q < 4; ++q) {
            const f32x4 kf = *(const LAS f32x4*)(kd + t * 64 + dg * 16 + q * 4), kb = *(const LAS f32x4*)(kd + 4096 + t * 64 + dg * 16 + q * 4);
            af4[q] += kf * vs; ab4[q] += kb * vs;
        }
    }
    float* gf = GS + ((size_t)((b * 2 + 0) * 4 + h) * NTILE + c) * 8192 + (dg * 16) * 128 + v;
    float* gb = GS + ((size_t)((b * 2 + 1) * 4 + h) * NTILE + c) * 8192 + (dg * 16) * 128 + v;
#pragma unroll
    for (int i = 0; i < 16; ++i) { gf[i * 128] = af4[i >> 2][i & 3]; gb[i * 128] = ab4[i >> 2][i & 3]; }
    if (tid < 128) { const int z = tid >> 6, d = tid & 63;
        GD[((size_t)((b * 2 + z) * 4 + h) * NTILE + c) * 64 + d] = __expf(z == 0 ? la[63 * 65 + d] : la[4160 + d]); }
    __syncthreads();
}
__device__ __forceinline__ void gla_scan(float* GS, const float* GD) {
    for (int gid = obid() * 512 + otid(); gid < 16 * 8192; gid += gridDim.x * 512) {
        const int v = gid & 127, d = (gid >> 7) & 63, chain = gid >> 13, z = (chain >> 2) & 1;
        float* gs = GS + (size_t)chain * NTILE * 8192 + d * 128 + v; const float* gd = GD + (size_t)chain * NTILE * 64 + d;
        float S = 0.f;
        for (int k0 = 0; k0 < NTILE; k0 += 10) {
            float L[10], Dc[10]; int cc[10];
#pragma unroll
            for (int j = 0; j < 10; ++j) { const int k = k0 + j; const int c = z ? (NTILE - 1 - k) : (k < 4 ? 256 + k : k - 4); cc[j] = c; L[j] = gs[(size_t)c * 8192]; Dc[j] = gd[c * 64]; }
#pragma unroll
            for (int j = 0; j < 10; ++j) { gs[(size_t)cc[j] * 8192] = S; S = Dc[j] * S + L[j]; }
        }
    }
}
__device__ __forceinline__ void gla_g3_item(LAS unsigned char* lds, const bf16_t* P, const float* wg, const float* bg, const float* GS, const float* gn, bf16_t* MIX, int b, int c, int h) {
    gla_gates(lds, P, wg, bg, b, c, h);
    const LAS float* la = (const LAS float*)lds;
    LAS float* QfT = (LAS float*)(lds + 41472); LAS float* QbT = (LAS float*)(lds + 57856);
    LAS float* KfT = (LAS float*)(lds + 74240); LAS float* KbT = (LAS float*)(lds + 90624);
    LAS float* VR = (LAS float*)(lds + 107008);
    LAS float* AT = (LAS float*)lds;
    LAS float* OL = KfT;
    const int tid = otid(), lane = tid & 63, wid = tid >> 6;
    {   const int t = tid >> 3, ch = tid & 7;
        const bf16_t* src = P + (size_t)prow(b, c * 64 + t) * INWP + GLA_OFF + h * 64 + ch * 8;
        const u32x4 rq = *(const u32x4*)src, rk = *(const u32x4*)(src + 256);
        LAS float* dq = VR + t * 65 + ch * 8; LAS float* dk = VR + 4160 + t * 65 + ch * 8;
        dq[0] = bf2f(rq.x & 0xffffu) * 0.125f; dq[1] = bf2f(rq.x >> 16) * 0.125f; dq[2] = bf2f(rq.y & 0xffffu) * 0.125f; dq[3] = bf2f(rq.y >> 16) * 0.125f;
        dq[4] = bf2f(rq.z & 0xffffu) * 0.125f; dq[5] = bf2f(rq.z >> 16) * 0.125f; dq[6] = bf2f(rq.w & 0xffffu) * 0.125f; dq[7] = bf2f(rq.w >> 16) * 0.125f;
        dk[0] = bf2f(rk.x & 0xffffu); dk[1] = bf2f(rk.x >> 16); dk[2] = bf2f(rk.y & 0xffffu); dk[3] = bf2f(rk.y >> 16);
        dk[4] = bf2f(rk.z & 0xffffu); dk[5] = bf2f(rk.z >> 16); dk[6] = bf2f(rk.w & 0xffffu); dk[7] = bf2f(rk.w >> 16); }
    __syncthreads();
    for (int idx = tid; idx < 4096; idx += 512) { const int t = idx & 63, d = idx >> 6;
        const float q = VR[t * 65 + d], k = VR[4160 + t * 65 + d], bp = la[t * 65 + d], bs = la[4160 + t * 65 + d];
        QfT[d * 64 + t] = q * __expf(bp); QbT[d * 64 + t] = q * __expf(bs); KfT[d * 64 + t] = k * __expf(-bp); KbT[d * 64 + t] = k * __expf(-bs); }
    __syncthreads();
#pragma unroll
    for (int jj = 0; jj < 2; ++jj) { const int cc_ = tid + 512 * jj, t = cc_ >> 4, ch = cc_ & 15;
        const u32x4 rv = *(const u32x4*)(P + (size_t)prow(b, c * 64 + t) * INWP + GLA_OFF + 512 + h * 128 + ch * 8);
        LAS float* dv = VR + t * 128 + ch * 8;
        *(LAS f32x4*)dv = (f32x4){bf2f(rv.x & 0xffffu), bf2f(rv.x >> 16), bf2f(rv.y & 0xffffu), bf2f(rv.y >> 16)};
        *(LAS f32x4*)(dv + 4) = (f32x4){bf2f(rv.z & 0xffffu), bf2f(rv.z >> 16), bf2f(rv.w & 0xffffu), bf2f(rv.w >> 16)}; }
    {
        const int t0 = 2 * (tid >> 4), s0 = 4 * (tid & 15);
        f32x4 af[2], ab[2];
#pragma unroll
        for (int i = 0; i < 2; ++i) { af[i] = (f32x4){0.f, 0.f, 0.f, 0.f}; ab[i] = (f32x4){0.f, 0.f, 0.f, 0.f}; }
        for (int d = 0; d < 64; ++d) {
            const f32x2 qf = *(const LAS f32x2*)(QfT + d * 64 + t0), qb = *(const LAS f32x2*)(QbT + d * 64 + t0);
            const f32x4 kf = *(const LAS f32x4*)(KfT + d * 64 + s0), kb = *(const LAS f32x4*)(KbT + d * 64 + s0);
#pragma unroll
            for (int i = 0; i < 2; ++i) { af[i] += kf * qf[i]; ab[i] += kb * qb[i]; }
        }
#pragma unroll
        for (int i = 0; i < 2; ++i)
#pragma unroll
            for (int j = 0; j < 4; ++j) { const int t = t0 + i, s = s0 + j; AT[s * 64 + t] = (s <= t) ? af[i][j] : ab[i][j]; }
    }
    __syncthreads();
    {
        const int v = tid & 127, tg = tid >> 7;
        f32x4 acc4[4];
#pragma unroll
        for (int i = 0; i < 4; ++i) acc4[i] = (f32x4){0.f, 0.f, 0.f, 0.f};
        const float* Sf = GS + ((size_t)((b * 2 + 0) * 4 + h) * NTILE + c) * 8192 + v; const float* Sb = GS + ((size_t)((b * 2 + 1) * 4 + h) * NTILE + c) * 8192 + v;
#define G3_LD(buf, d0) do { _Pragma("unroll") for (int k = 0; k < 4; ++k) { buf[k] = Sf[((d0) + k) * 128]; buf[4 + k] = Sb[((d0) + k) * 128]; } } while (0)
#define G3_FMA(buf, d0) do { _Pragma("unroll") for (int k = 0; k < 4; ++k) { const int d = (d0) + k; const float sf = buf[k], sb = buf[4 + k]; \
            _Pragma("unroll") for (int q = 0; q < 4; ++q) { \
                const f32x4 a = *(const LAS f32x4*)(QfT + d * 64 + tg * 16 + q * 4), bq = *(const LAS f32x4*)(QbT + d * 64 + tg * 16 + q * 4); \
                acc4[q] += a * sf + bq * sb; } } } while (0)
        {   float sA[8], sB[8];
            G3_LD(sA, 0);
            for (int d0 = 0; d0 < 64; d0 += 8) {
                G3_LD(sB, d0 + 4); asm volatile("" ::: "memory");
                G3_FMA(sA, d0);
                if (d0 + 8 < 64) G3_LD(sA, d0 + 8);
                asm volatile("" ::: "memory");
                G3_FMA(sB, d0 + 4);
            }
        }
#undef G3_LD
#undef G3_FMA
        for (int s = 0; s < 64; ++s) {
            const float vs = VR[s * 128 + v];
#pragma unroll
            for (int q = 0; q < 4; ++q) {
                const f32x4 a = *(const LAS f32x4*)(AT + s * 64 + tg * 16 + q * 4);
                acc4[q] += a * vs;
            }
        }
#pragma unroll
        for (int i = 0; i < 16; ++i) OL[(tg * 16 + i) * 128 + v] = acc4[i >> 2][i & 3];
    }
    __syncthreads();
    const float g0 = gn[lane], g1 = gn[64 + lane];
    for (int i = 0; i < 8; ++i) {
        const int t = wid * 8 + i;
        const float v0 = OL[t * 128 + lane], v1 = OL[t * 128 + 64 + lane];
        const float ss = wave_sum(v0 * v0 + v1 * v1);
        const float rs = rsqrtf(ss * (1.f / 128.f) + EPS);
        const size_t row = prow(b, c * 64 + t);
        const bf16_t* gp = P + row * INWP + GLA_OFF + 1024 + h * 128;
        const float ga = bf2f(gp[lane]), gb = bf2f(gp[64 + lane]);
        bf16_t* dst = MIX + row * D + 512 + h * 128;
        dst[lane] = (bf16_t)f2bf(v0 * rs * g0 * (ga / (1.f + __expf(-ga)))); dst[64 + lane] = (bf16_t)f2bf(v1 * rs * g1 * (gb / (1.f + __expf(-gb))));
    }
    __syncthreads();
}

#define XB_TMO      128
#define XB_XCNT(j)  (256  + 64 * (j))
#define XB_XSUB(j)  (1280 + 64 * (j))
#define XB_XGEN(j)  (2304 + 64 * (j))
#define XB_TOP      3328
#define XB_TOPGEN   3392
#define XCD_BAR_WORDS 3456
#define XB_SPIN_CAP (1u << 24)

__device__ __forceinline__ unsigned xb_ld(unsigned* p)              { return __hip_atomic_load(p, __ATOMIC_RELAXED, __HIP_MEMORY_SCOPE_AGENT); }
__device__ __forceinline__ unsigned xb_add(unsigned* p, unsigned v) { return __hip_atomic_fetch_add(p, v, __ATOMIC_RELAXED, __HIP_MEMORY_SCOPE_AGENT); }
__device__ __forceinline__ unsigned xb_xcc_id() { return (unsigned)__builtin_amdgcn_s_getreg((3 << 11) | 20) & 0xFu; }
#define XB_SPIN(cond, bar) do { unsigned _sp = 0; while (cond) { __builtin_amdgcn_s_sleep(1); \
    if ((++_sp & 255u) == 0u) { if (xb_ld(&(bar)[XB_TMO])) break; if (_sp > XB_SPIN_CAP) { atomicAdd(&(bar)[XB_TMO], 1u); break; } } } } while (0)

struct XcdBarrier {
    unsigned* bar; unsigned x;
    volatile LAS unsigned* st;
};

__device__ __forceinline__ XcdBarrier xcd_barrier_post(unsigned* bar, volatile LAS unsigned* st) {
    XcdBarrier b; b.bar = bar; b.x = xb_xcc_id(); b.st = st;
    if (threadIdx.x == 0) (void)xb_add(&bar[XB_XCNT(b.x)], 1u);
    return b;
}
__device__ __forceinline__ void xcd_barrier_complete(unsigned* bar, unsigned x, unsigned& nloc, unsigned& nx) {
    const unsigned G = gridDim.x * gridDim.y * gridDim.z;
    unsigned sum, cnt, mine, sp = 0u;
    for (;;) {
        sum = 0u; cnt = 0u; mine = 0u;
#pragma unroll
        for (unsigned j = 0; j < 16; ++j) { const unsigned c = xb_ld(&bar[XB_XCNT(j)]); sum += c; cnt += (c > 0u) ? 1u : 0u; mine = (j == x) ? c : mine; }
        if (sum == G) break;
        __builtin_amdgcn_s_sleep(1);
        if ((++sp & 255u) == 0u) { if (xb_ld(&bar[XB_TMO])) break; if (sp > XB_SPIN_CAP) { atomicAdd(&bar[XB_TMO], 1u); break; } }
    }
    nloc = mine > 0u ? mine : 1u; nx = cnt > 0u ? cnt : 1u;
}

__device__ __forceinline__ void xcd_barrier(const XcdBarrier& b) {
    asm volatile("s_waitcnt vmcnt(0)" ::: "memory");
    __syncthreads();
    if (threadIdx.x == 0) {
        unsigned* bar = b.bar;
        __builtin_amdgcn_s_waitcnt(0);
        unsigned nloc = b.st[0], nx = b.st[1];
        if (nloc == 0u) { xcd_barrier_complete(bar, b.x, nloc, nx); b.st[0] = nloc; b.st[1] = nx; }
        const unsigned old = xb_add(&bar[XB_XSUB(b.x)], 1u);
        const unsigned gen = old / nloc;
        if (old + 1u == (gen + 1u) * nloc) {
            __builtin_amdgcn_fence(__ATOMIC_RELEASE, "agent");
            asm volatile("s_waitcnt vmcnt(0)" ::: "memory");
            const unsigned og = xb_add(&bar[XB_TOP], 1u);
            const unsigned tg = og / nx;
            if (og + 1u == (tg + 1u) * nx) xb_add(&bar[XB_TOPGEN], 1u);
            else XB_SPIN(xb_ld(&bar[XB_TOPGEN]) == tg, bar);
            __builtin_amdgcn_fence(__ATOMIC_ACQUIRE, "agent");
            xb_add(&bar[XB_XGEN(b.x)], 1u);
            asm volatile("s_waitcnt vmcnt(0)" ::: "memory");
        } else {
            XB_SPIN(xb_ld(&bar[XB_XGEN(b.x)]) == gen, bar);
            __builtin_amdgcn_fence(__ATOMIC_ACQUIRE, "agent");
            asm volatile("s_waitcnt vmcnt(0)" ::: "memory");
        }
    }
    __syncthreads();
}

__global__ void __launch_bounds__(512) fwd_kernel(Params p) {
    extern __shared__ __attribute__((aligned(16))) unsigned char lds_raw[];
    LAS unsigned char* lds = (LAS unsigned char*)lds_raw;
    cg::grid_group grid = cg::this_grid();
    { const int t_ = otid(); if (t_ < 16) ((LAS unsigned*)(lds + LDS_BYTES - 64))[t_] = 0u; }
    __syncthreads();
    XcdBarrier xbar = xcd_barrier_post((unsigned*)p.ws, (volatile LAS unsigned*)(lds + LDS_BYTES - 64));
    const int G = gridDim.x, bx = obid();
    bf16_t* P = (bf16_t*)(p.ws + WS_P); bf16_t* MIX = (bf16_t*)(p.ws + WS_MIX); bf16_t* XN = (bf16_t*)(p.ws + WS_XN);
    bf16_t* YB = (bf16_t*)(p.ws + WS_YG); bf16_t* HB = (bf16_t*)(p.ws + WS_H);
    float* GS = (float*)(p.ws + WS_YG); float* GD = (float*)(p.ws + WS_GD);
    bf16_t* DQ = (bf16_t*)(p.ws + WS_DQ); bf16_t* DK = (bf16_t*)(p.ws + WS_DK); bf16_t* DVt = (bf16_t*)(p.ws + WS_DVT); bf16_t* NAVt = (bf16_t*)(p.ws + WS_NAVT);
    for (int ph = p.ph_lo; ph < p.ph_hi; ++ph) {
        bool is_gemm = false; pg8::Gemm g{nullptr, nullptr, 0, 0, 0}; pg8::EpiAct E{nullptr, 0, 0};
        if (ph == 0) { if (EN(0)) { ph_mod(p, lds); ph_wconv(p, lds, 0); } }
        else if (ph == 1) { if (EN(1)) row_pass(p, 0, 0); }
        else {
            const int l = (ph - 2) / 9, s = (ph - 2) % 9;
            const bool need_ctx = (l + 1 < DEPTH);
            const int Mpost = need_ctx ? MTOT : MLAT;
            if (s == 0) { is_gemm = true; g = pg8::Gemm{XN, (const bf16_t*)(p.ws + WS_WIN), MTOT, INWP, D}; E = pg8::EpiAct{P, INWP, 0}; }
            else if (s == 4) { is_gemm = true; g = pg8::Gemm{MIX, (const bf16_t*)(p.ws + WS_WOUT), Mpost, D, D}; E = pg8::EpiAct{YB, D, 0}; }
            else if (s == 6) { is_gemm = true; g = pg8::Gemm{XN, (const bf16_t*)(p.ws + WS_W1), Mpost, HID, D}; E = pg8::EpiAct{HB, HID, 1}; }
            else if (s == 7) { is_gemm = true; g = pg8::Gemm{HB, (const bf16_t*)(p.ws + WS_W2), Mpost, D, HID}; E = pg8::EpiAct{YB, D, 0}; }
            else if (s == 1 && EN(2)) {
                rope_rows(p);
                vtrans_loop<128>(lds, P, DIFF_OFF + 2048, DVt, bx, G);
                vtrans_loop<64>(lds, P, 1024, NAVt, bx, G);
                const float* wg = p.gla_w_gate + (size_t)l * 2 * 16 * 256; const float* bg = p.gla_b_gate + (size_t)l * 2 * 256;
                for (int it = bx; it < NB * NTILE * 4; it += G) { const int h = it & 3, c = (it >> 2) % NTILE, b = it / (4 * NTILE); gla_g1_item(lds, P, wg, bg, GS, GD, b, c, h); }
            }
            else if (s == 2 && EN(3)) {
                if (EN(11)) gla_scan(GS, GD);
                const float* relb = p.na_rel_bias + (size_t)l * 8 * 465;
                const int nq = need_ctx ? 260 : 256;
                if (EN(10)) for (int it = bx; it < NB * 2 * nq; it += G) { int hg, qblk, b;
                    if (it < NB * 2 * 256) { hg = it & 1; qblk = (it >> 1) & 255; b = it >> 9; }
                    else { const int r = it - NB * 2 * 256; hg = r & 1; qblk = 256 + ((r >> 1) & 3); b = r >> 3; }
                    na_unit(lds, P, NAVt, MIX, relb, b, hg, qblk); }
            }
            else if (s == 3 && EN(4)) {
                const float* wg = p.gla_w_gate + (size_t)l * 2 * 16 * 256; const float* bg = p.gla_b_gate + (size_t)l * 2 * 256;
                const int nc = need_ctx ? NTILE : 256;
                if (EN(8)) for (int it = bx; it < NB * nc * 4; it += G) { const int h = it & 3, c = (it >> 2) % nc, b = it / (4 * nc); gla_g3_item(lds, P, wg, bg, GS, p.gla_g_norm + l * 128, MIX, b, c, h); }
                const float* lp = p.diff_lambda + (size_t)l * 4 * 64;
                float d01 = 0.f, d23 = 0.f;
                for (int i = 0; i < 64; ++i) { d01 += lp[i] * lp[64 + i]; d23 += lp[128 + i] * lp[192 + i]; }
                const float lam_init = 0.8f - 0.6f * __expf(-0.3f * (float)l);
                const float lam = __expf(d01) - __expf(d23) + lam_init;
                const int nqb = need_ctx ? 130 : 128;
                if (EN(9)) for (int it = bx; it < NB * 8 * nqb; it += G) {
                    int qb, h, b;
                    if (it < NB * 8 * 128) { qb = it & 127; h = (it >> 7) & 7; b = it >> 10; }
                    else { const int r = it - NB * 8 * 128; qb = 128 + (r & 1); h = (r >> 1) & 7; b = r >> 4; }
                    const bool isctx = qb >= 128;
                    diff_unit(lds, DQ, DK, DVt, MIX, b, h, qb * 128, isctx ? 256 : 0, NTILE, lam, p.diff_g_norm + l * 128, 1.f - lam_init);
                }
            }
            else if (s == 5 && EN(5)) { row_pass(p, l, 1); }
            else if (s == 8 && EN(6)) { row_pass(p, l, 2); if (l + 1 < DEPTH) ph_wconv(p, lds, l + 1); }
        }
        if (is_gemm && EN(7)) { pg8::StaticOrder S; S.init(g.M, g.N, G, bx); pg8::gemm_phase<pg8::EpiAct, pg8::StaticOrder, true, true>(lds, g, S, E); }
        if (ph + 1 < p.ph_hi) { if (ph == 0) grid.sync(); else xcd_barrier(xbar); }
    }

}

extern "C" void kernel_launch(void* const* d_in, const int* in_sizes, int n_in, void* d_out, int out_size, void* d_ws, size_t ws_size, hipStream_t stream) {
    static int grid = 0;
    if (grid == 0) {
        if (n_in != 20 || in_sizes[0] != MLAT * D || out_size != MLAT * D || ws_size < WS_END) {
            fprintf(stderr, "kernel_launch: unexpected shapes (n_in %d, in0 %d, out %d, ws %zu); nothing launched\n", n_in, n_in > 0 ? in_sizes[0] : -1, out_size, ws_size); grid = -1; return; }
        int dev = 0, cus = 0, per_cu = 0;
        if (hipGetDevice(&dev) != hipSuccess || hipDeviceGetAttribute(&cus, hipDeviceAttributeMultiprocessorCount, dev) != hipSuccess) { grid = -1; return; }
        if (hipFuncSetAttribute((const void*)fwd_kernel, hipFuncAttributeMaxDynamicSharedMemorySize, LDS_BYTES) != hipSuccess) { fprintf(stderr, "kernel_launch: hipFuncSetAttribute failed\n"); grid = -1; return; }
        if (hipOccupancyMaxActiveBlocksPerMultiprocessor(&per_cu, (const void*)fwd_kernel, 512, LDS_BYTES) != hipSuccess || per_cu < 1) { fprintf(stderr, "kernel_launch: occupancy query gave %d\n", per_cu); per_cu = 1; }
        (void)hipGetLastError();
        grid = cus * per_cu;
    }
    if (grid < 0) return;
    (void)hipMemsetAsync(d_ws, 0, WS_ZERO_BYTES, stream);
    Params p{};
    const float** pp = (const float**)&p;
    for (int i = 0; i < 20; ++i) pp[i] = (const float*)d_in[i];
    p.out = (float*)d_out; p.ws = (unsigned char*)d_ws; p.ph_lo = 0; p.ph_hi = NPH;
    void* args[] = {&p};
    hipError_t e = hipLaunchCooperativeKernel((const void*)fwd_kernel, dim3(grid), dim3(512), args, LDS_BYTES, stream);
    if (e != hipSuccess) fprintf(stderr, "cooperative launch failed: %s (grid %d)\n", hipGetErrorString(e), grid);
}
```

```cpp
#include <hip/hip_runtime.h>
#include <hip/hip_cooperative_groups.h>
#include <cstdio>
#include <cstdint>
namespace cg = cooperative_groups;
__device__ __forceinline__ int otid() { int t = threadIdx.x; asm volatile("" : "+v"(t)); return t; }
__device__ __forceinline__ int obid() { int t = blockIdx.x; asm volatile("" : "+s"(t)); return t; }
namespace pg8 {
#define PG8_LAS __attribute__((address_space(3)))
typedef unsigned short bf16_t;
typedef short bf16x8 __attribute__((ext_vector_type(8)));
typedef float f32x4 __attribute__((ext_vector_type(4)));
typedef unsigned u32x4 __attribute__((ext_vector_type(4)));
constexpr int BM = 256, BK = 64, HALF = 128, HTB = HALF * BK * 2  , STAGE_BYTES = 8 * HTB, NXCD = 8, WGM = 4;

__host__ __device__ __forceinline__ int lds_byte(int r, int c) { const int st = (r >> 4) * 2 + (c >> 5), rr = r & 15, cc = c & 31, ob = rr * 64 + cc * 2; return st * 1024 + (ob ^ (((ob >> 9) & 1) << 5)); }
__host__ __device__ __forceinline__ void stage_rc(int b, int& R, int& C) { const int st = b / 1024, sb = b % 1024, swz = sb ^ (((sb >> 9) & 1) << 5); R = (st >> 1) * 16 + swz / 64; C = (st & 1) * 32 + (swz % 64) / 2; }
__host__ __device__ __forceinline__ int perm32(int rho) { const int n = rho >> 4, i = rho & 15; return 8 * (i >> 2) + 4 * n + (i & 3); }

struct Unit { int pm, pn; };
struct Gemm { const bf16_t* A; const bf16_t* Bt; int M, N, K; };

struct StaticOrder {
    int nM, nN, nwg, G, c;
    __host__ __device__ void init(int M, int N, int G_, int c_) { nM = M / BM; nN = N / BM; nwg = nM * nN; G = G_; c = c_; }
    __host__ __device__ bool next(int i, Unit& u) const {
        const long L = (long)i * G + c; if (L >= nwg) return false;
        int wgid = (int)L; { const int q = nwg / NXCD, r = nwg % NXCD, xcd = wgid % NXCD, off = wgid / NXCD; wgid = (xcd < r ? xcd * (q + 1) : r * (q + 1) + (xcd - r) * q) + off; }
        const int nig = WGM * nN, gid = wgid / nig, fm = gid * WGM, gsz = (nM - fm) < WGM ? (nM - fm) : WGM;
        u.pm = fm + ((wgid % nig) % gsz); u.pn = (wgid % nig) / gsz; return true;
    }
    __device__ __forceinline__ void a_ready(const Unit&) const {}
    __device__ __forceinline__ void done(const Unit&) const {}
};

__device__ __forceinline__ unsigned cvt_pk_bf16(float lo, float hi) { unsigned r; asm volatile("v_cvt_pk_bf16_f32 %0, %1, %2" : "=v"(r) : "v"(lo), "v"(hi)); return r; }
typedef float f32x2 __attribute__((ext_vector_type(2)));
struct EpiAct {
    static constexpr bool PERM = true, AFTER_DRAIN = false;
    bf16_t* O; int ldc; int act;
    __device__ __forceinline__ void operator()(const f32x4 (&acc)[2][2][4][2], const Unit& u, int wr, int wc, int fr, int fq) const {
        const int row0 = u.pm * BM + wr * 64 + fr; const int col0 = u.pn * BM + wc * 32 + 8 * fq;
#pragma unroll
        for (int ai = 0; ai < 2; ++ai)
#pragma unroll
            for (int m = 0; m < 4; ++m) { bf16_t* rowp = O + (size_t)(row0 + ai * HALF + m * 16) * ldc + col0;
#pragma unroll
                for (int bj = 0; bj < 2; ++bj) { f32x4 v0 = acc[ai][bj][m][0], v1 = acc[ai][bj][m][1];
                    if (act) {
#pragma unroll
                        for (int e = 0; e < 4; ++e) { float a = fmaxf(v0[e], 0.f), b = fmaxf(v1[e], 0.f); v0[e] = a * a; v1[e] = b * b; } }
                    u32x4 w; w.x = cvt_pk_bf16(v0[0], v0[1]); w.y = cvt_pk_bf16(v0[2], v0[3]); w.z = cvt_pk_bf16(v1[0], v1[1]); w.w = cvt_pk_bf16(v1[2], v1[3]);
                    *(u32x4*)(rowp + bj * HALF) = w; } }
    }
};
template <class Epi, class Sched, bool ALIGN_EPI = false, bool SP2 = false>
__device__ __forceinline__ void gemm_phase(PG8_LAS unsigned char* lds, const Gemm g, const Sched& S, const Epi& E) {
    const int tid = otid(), wid = __builtin_amdgcn_readfirstlane(tid >> 6), lane = tid & 63, wr = wid >> 2, wc = wid & 3, fr = lane & 15, fq = lane >> 4;
    const int K = g.K, nt = K / BK;
    unsigned voffA[2], voffB[2];
#pragma unroll
    for (int i = 0; i < 2; ++i) { int R, C; stage_rc(tid * 16 + i * 8192, R, C); const int Rb = Epi::PERM ? ((R & ~31) + perm32(R & 31)) : R;
        voffA[i] = (unsigned)(R * K + C) * 2u; voffB[i] = (unsigned)(Rb * K + C) * 2u; }
    const size_t kstep = (size_t)(BK * 2);
    const size_t hstep = (size_t)HALF * K * 2;
    const size_t tstep = 2 * hstep;
    const unsigned ldsw = (unsigned)wid * 1024u;
    const int aoff = lds_byte(wr * 64 + fr, fq * 8), boff = lds_byte(wc * 32 + fr, fq * 8);
#define PG8_SA(b, h) (((b) * 2 + (h)) * HTB)
#define PG8_SB(b, h) ((4 + (b) * 2 + (h)) * HTB)
#define PG8_STAGE(bufoff, gbase, voff) do { _Pragma("unroll") for (int _i = 0; _i < 2; ++_i) \
        __builtin_amdgcn_global_load_lds((const unsigned*)((const char*)(gbase) + (voff)[_i]), (PG8_LAS unsigned*)(lds + (bufoff) + ldsw + _i * 8192), 16, 0, 0); } while (0)
#define PG8_LDA(dst, b, h) do { _Pragma("unroll") for (int m = 0; m < 4; ++m) _Pragma("unroll") for (int k = 0; k < 2; ++k) dst[m][k] = *(const PG8_LAS bf16x8*)(lds + PG8_SA(b, h) + aoff + m * 2048 + k * 1024); } while (0)
#define PG8_LDB(dst, b, h) do { _Pragma("unroll") for (int n = 0; n < 2; ++n) _Pragma("unroll") for (int k = 0; k < 2; ++k) dst[n][k] = *(const PG8_LAS bf16x8*)(lds + PG8_SB(b, h) + boff + n * 2048 + k * 1024); } while (0)
#define PG8_MMA(ai, bj, At, Bt) do { __builtin_amdgcn_s_setprio(1); _Pragma("unroll") for (int m = 0; m < 4; ++m) _Pragma("unroll") for (int n = 0; n < 2; ++n) _Pragma("unroll") for (int k = 0; k < 2; ++k) \
        acc[ai][bj][m][n] = __builtin_amdgcn_mfma_f32_16x16x32_bf16(Bt[n][k], At[m][k], acc[ai][bj][m][n], 0, 0, 0); __builtin_amdgcn_s_setprio(0); } while (0)
#define PG8_WAIT_V(n) asm volatile("s_waitcnt vmcnt(" #n ")" ::: "memory")
#define PG8_WAIT_L(n) asm volatile("s_waitcnt lgkmcnt(" #n ")" ::: "memory")
#define PG8_BAR __builtin_amdgcn_s_barrier()
#define PG8_SCHED __builtin_amdgcn_sched_barrier(0)
    Unit cur, nxt; int ui = 0;
    if (!S.next(0, cur)) return;
    f32x4 acc[2][2][4][2];
#pragma unroll
    for (int a = 0; a < 2; ++a)
#pragma unroll
        for (int b = 0; b < 2; ++b)
#pragma unroll
            for (int m = 0; m < 4; ++m)
#pragma unroll
                for (int n = 0; n < 2; ++n) acc[a][b][m][n] = (f32x4){0.f, 0.f, 0.f, 0.f};
    bf16x8 At[4][2], B0[2][2], B1[2][2];
    const char* cA = (const char*)g.A + (size_t)cur.pm * tstep; const char* cB = (const char*)g.Bt + (size_t)cur.pn * tstep;
    S.a_ready(cur);
    if constexpr (SP2) {
        PG8_STAGE(PG8_SB(0, 0), cB, voffB); PG8_STAGE(PG8_SB(0, 1), cB + hstep, voffB); PG8_STAGE(PG8_SA(0, 0), cA, voffA); PG8_STAGE(PG8_SA(0, 1), cA + hstep, voffA);
        if (wr == 1) PG8_BAR;
        PG8_WAIT_V(2); PG8_BAR;
        PG8_STAGE(PG8_SB(1, 0), cB + kstep, voffB); PG8_STAGE(PG8_SA(1, 0), cA + kstep, voffA); PG8_STAGE(PG8_SB(1, 1), cB + hstep + kstep, voffB);
        PG8_WAIT_V(6); PG8_BAR;
    } else {
        PG8_STAGE(PG8_SB(0, 0), cB, voffB); PG8_STAGE(PG8_SA(0, 0), cA, voffA); PG8_STAGE(PG8_SB(0, 1), cB + hstep, voffB); PG8_STAGE(PG8_SA(0, 1), cA + hstep, voffA);
        if (wr == 1) PG8_BAR;
        PG8_WAIT_V(4); PG8_BAR;
        PG8_STAGE(PG8_SB(1, 0), cB + kstep, voffB); PG8_STAGE(PG8_SA(1, 0), cA + kstep, voffA); PG8_STAGE(PG8_SB(1, 1), cB + hstep + kstep, voffB);
        PG8_WAIT_V(6); PG8_BAR;
    }
    for (;;) {
        const bool has_next = S.next(ui + 1, nxt);
        const char* nA = has_next ? (const char*)g.A + (size_t)nxt.pm * tstep : cA; const char* nB = has_next ? (const char*)g.Bt + (size_t)nxt.pn * tstep : cB;
        for (int t = 0; t < nt; t += 2) {
            const bool last = (t == nt - 2);
            const char* a1 = cA + (size_t)(t + 1) * kstep;
            const char* a2 = last ? nA : cA + (size_t)(t + 2) * kstep; const char* b2 = last ? nB : cB + (size_t)(t + 2) * kstep;
            const char* a3 = a2 + kstep; const char* b3 = b2 + kstep;
            if (last && has_next) S.a_ready(nxt);
            if constexpr (SP2) {
            PG8_LDB(B0, 0, 0); PG8_LDB(B1, 0, 1); PG8_SCHED; PG8_LDA(At, 0, 0); PG8_STAGE(PG8_SA(1, 1), a1 + hstep, voffA);
            PG8_WAIT_V(8); PG8_WAIT_L(0); PG8_BAR; PG8_MMA(0, 0, At, B0); PG8_MMA(0, 1, At, B1); PG8_BAR; PG8_SCHED;
            PG8_LDA(At, 0, 1); PG8_STAGE(PG8_SB(0, 0), b2, voffB); PG8_STAGE(PG8_SB(0, 1), b2 + hstep, voffB); PG8_STAGE(PG8_SA(0, 0), a2, voffA);
            PG8_WAIT_V(8); PG8_WAIT_L(0); PG8_BAR; PG8_MMA(1, 0, At, B0); PG8_MMA(1, 1, At, B1); PG8_BAR; PG8_SCHED;
            PG8_LDB(B0, 1, 0); PG8_LDB(B1, 1, 1); PG8_SCHED; PG8_LDA(At, 1, 0); PG8_STAGE(PG8_SA(0, 1), a2 + hstep, voffA);
            PG8_WAIT_V(8); PG8_WAIT_L(0); PG8_BAR; PG8_MMA(0, 0, At, B0); PG8_MMA(0, 1, At, B1); PG8_BAR; PG8_SCHED;
            PG8_LDA(At, 1, 1); PG8_STAGE(PG8_SB(1, 0), b3, voffB); PG8_STAGE(PG8_SB(1, 1), b3 + hstep, voffB); PG8_STAGE(PG8_SA(1, 0), a3, voffA);
            PG8_WAIT_V(8); PG8_WAIT_L(0); PG8_BAR; PG8_MMA(1, 0, At, B0); PG8_MMA(1, 1, At, B1); PG8_BAR; PG8_SCHED;
            } else {
            PG8_LDB(B0, 0, 0); PG8_SCHED; PG8_LDA(At, 0, 0); PG8_STAGE(PG8_SA(1, 1), a1 + hstep, voffA);
            PG8_WAIT_L(8); PG8_BAR; PG8_WAIT_L(0); PG8_MMA(0, 0, At, B0); PG8_BAR; PG8_SCHED;
            PG8_LDB(B1, 0, 1); PG8_STAGE(PG8_SB(0, 0), b2, voffB);
            PG8_BAR; PG8_WAIT_L(0); PG8_MMA(0, 1, At, B1); PG8_BAR;
            PG8_LDA(At, 0, 1); PG8_STAGE(PG8_SA(0, 0), a2, voffA);
            PG8_BAR; PG8_WAIT_L(0); PG8_MMA(1, 0, At, B0); PG8_BAR; PG8_SCHED;
            PG8_STAGE(PG8_SB(0, 1), b2 + hstep, voffB);
            PG8_WAIT_V(6); PG8_BAR; PG8_MMA(1, 1, At, B1); PG8_BAR;
            PG8_LDB(B0, 1, 0); PG8_SCHED; PG8_LDA(At, 1, 0); PG8_STAGE(PG8_SA(0, 1), a2 + hstep, voffA);
            PG8_WAIT_L(8); PG8_BAR; PG8_WAIT_L(0); PG8_MMA(0, 0, At, B0); PG8_BAR; PG8_SCHED;
            PG8_LDB(B1, 1, 1); PG8_STAGE(PG8_SB(1, 0), b3, voffB);
            PG8_BAR; PG8_WAIT_L(0); PG8_MMA(0, 1, At, B1); PG8_BAR;
            PG8_LDA(At, 1, 1); PG8_STAGE(PG8_SA(1, 0), a3, voffA);
            PG8_BAR; PG8_WAIT_L(0); PG8_MMA(1, 0, At, B0); PG8_BAR; PG8_SCHED;
            PG8_STAGE(PG8_SB(1, 1), b3 + hstep, voffB);
            PG8_WAIT_V(6); PG8_BAR; PG8_MMA(1, 1, At, B1); PG8_BAR;
            }
        }
        if constexpr (ALIGN_EPI) { if (wr == 0) PG8_BAR; }
        if constexpr (!Epi::AFTER_DRAIN) { E(acc, cur, wr, wc, fr, fq); S.done(cur); }
        if (!has_next) break;
#pragma unroll
        for (int a = 0; a < 2; ++a)
#pragma unroll
            for (int b = 0; b < 2; ++b)
#pragma unroll
                for (int m = 0; m < 4; ++m)
#pragma unroll
                    for (int n = 0; n < 2; ++n) acc[a][b][m][n] = (f32x4){0.f, 0.f, 0.f, 0.f};
        cur = nxt; cA = nA; cB = nB; ++ui;
        if constexpr (ALIGN_EPI) { if (wr == 1) PG8_BAR; }
    }
    PG8_WAIT_V(0);
    if constexpr (!ALIGN_EPI) { if (wr == 0) PG8_BAR; }
    PG8_BAR;
    if constexpr (Epi::AFTER_DRAIN) { E.fused(acc, cur, wr, wc, fr, fq, lds, wid, lane); S.done(cur); }
#undef PG8_SA
#undef PG8_SB
#undef PG8_STAGE
#undef PG8_LDA
#undef PG8_LDB
#undef PG8_MMA
#undef PG8_WAIT_V
#undef PG8_WAIT_L
#undef PG8_BAR
#undef PG8_SCHED
}
}
constexpr int D = 2048, NB = 2, SEQ = 16384, NCTX = 256, DEPTH = 2;
constexpr int MLAT = NB * SEQ, MCTX = NB * NCTX, MTOT = MLAT + MCTX;
constexpr int INW = 6176, INWP = 6400, HID = 8192;
constexpr int NKEY = SEQ + NCTX;
constexpr int NTILE = NKEY / 64;
constexpr int GLA_OFF = 1536, DIFF_OFF = 3104;
constexpr float EPS = 1e-6f;
constexpr float LOG2E = 1.4426950408889634f;
constexpr float C2 = 0.125f * LOG2E;
constexpr int NPH = 2 + 9 * DEPTH;
constexpr int LDS_BYTES = 147456;
#ifndef PHMASK
#define PHMASK 0xFFFF
#endif
#define EN(x) (((PHMASK) >> (x)) & 1)

constexpr size_t MiB = 1u << 20;
constexpr size_t WS_MOD = 1 * MiB, WS_ZERO_BYTES = 2 * MiB;
constexpr size_t WS_WIN = 2 * MiB, WS_WOUT = 27 * MiB, WS_W1 = 35 * MiB, WS_W2 = 67 * MiB;
constexpr size_t WS_XN = 99 * MiB;
constexpr size_t WS_DQ = WS_XN, WS_DK = WS_XN + 65 * MiB;
constexpr size_t WS_P = 229 * MiB;
constexpr size_t WS_MIX = WS_P + (size_t)MTOT * INWP * 2;
constexpr size_t WS_H = WS_P;
constexpr size_t WS_YG = 766 * MiB;
constexpr size_t WS_HC = 896 * MiB;
constexpr size_t WS_DVT = 900 * MiB;
constexpr size_t WS_NAVT = 965 * MiB;
constexpr size_t WS_GD = 998 * MiB;
constexpr size_t WS_END = 1000 * MiB;
static_assert(WS_MIX + (size_t)MTOT * D * 2 <= WS_YG && WS_H + (size_t)MTOT * HID * 2 <= WS_MIX + (size_t)MTOT * D * 2, "ws map");
static_assert((size_t)NB * 16 * NKEY * 64 * 2 == 65 * MiB, "dq size");

typedef unsigned short bf16_t;
typedef float f32x2 __attribute__((ext_vector_type(2)));
typedef float f32x4 __attribute__((ext_vector_type(4)));
typedef float f32x16 __attribute__((ext_vector_type(16)));
typedef short bf16x8 __attribute__((ext_vector_type(8)));
typedef unsigned u32x4 __attribute__((ext_vector_type(4)));
typedef unsigned u32x2 __attribute__((ext_vector_type(2)));
#define LAS __attribute__((address_space(3)))
#define LDS_WAIT() asm volatile("s_waitcnt lgkmcnt(0)" ::: "memory")

struct Params {
    const float *x, *c, *ctx, *c_ctx, *w_ada, *b_ada, *g_pre_mix, *g_post_mix, *g_pre_mlp, *g_post_mlp,
                *w_in, *w_out, *na_rel_bias, *gla_w_gate, *gla_b_gate, *gla_g_norm, *diff_lambda, *diff_g_norm, *w_mlp_in, *w_mlp_out;
    float* out; unsigned char* ws; int ph_lo, ph_hi;
};

__device__ __forceinline__ float bf2f(unsigned u) { return __uint_as_float(u << 16); }
__device__ __forceinline__ unsigned f2bf(float f) { unsigned u = __float_as_uint(f); return (u + 0x7fffu + ((u >> 16) & 1u)) >> 16; }
__device__ __forceinline__ unsigned pk2(float lo, float hi) { return f2bf(lo) | (f2bf(hi) << 16); }
__device__ __forceinline__ float wave_sum(float v) {
#pragma unroll
    for (int o = 1; o < 64; o <<= 1) v += __shfl_xor(v, o);
    return v;
}
__device__ __forceinline__ int prow(int b, int n) { return n < SEQ ? b * SEQ + n : MLAT + b * NCTX + (n - SEQ); }

__device__ __forceinline__ void ph_mod(const Params& p, LAS unsigned char* lds) {
    LAS float* sc = (LAS float*)lds;
    const int tid = otid();
    for (int i = tid; i < 3 * D; i += 512) { const float v = i < 2 * D ? p.c[i] : p.c_ctx[i - 2 * D]; sc[i] = v / (1.f + __expf(-v)); }
    __syncthreads();
    float* MOD = (float*)(p.ws + WS_MOD);
    const int col_in = tid & 255, kh = tid >> 8;
    for (int it = obid(); it < 2 * 48 * 8; it += gridDim.x) {
        const int ks = it & 7, cb = (it >> 3) % 48, l = it / 384;
        const int col = cb * 256 + col_in;
        const float* W = p.w_ada + (size_t)l * D * 12288 + col;
        const int k0 = ks * 256 + kh * 128;
        float a0 = 0.f, a1 = 0.f, a2 = 0.f;
#pragma unroll 8
        for (int k = k0; k < k0 + 128; ++k) { const float w = W[(size_t)k * 12288]; a0 += sc[k] * w; a1 += sc[D + k] * w; a2 += sc[2 * D + k] * w; }
        if (ks == 0 && kh == 0) { const float bb = p.b_ada[l * 12288 + col]; a0 += bb; a1 += bb; a2 += bb; }
        float* m = MOD + (size_t)l * 3 * 12288 + col;
        atomicAdd(m, a0); atomicAdd(m + 12288, a1); atomicAdd(m + 2 * 12288, a2);
    }
    __syncthreads();
}

__device__ __forceinline__ void transpose_item(const float* W, int K, int N, bf16_t* WT, LAS float* scr, int item, int lane) {
    const int nblk = N / 32, kb = item / nblk, nb = item % nblk, k0 = 64 * kb, n0 = 32 * nb;
#pragma unroll 8
    for (int i = 0; i < 32; ++i) { const int kk = 2 * i + (lane >> 5); scr[kk * 33 + (lane & 31)] = W[(size_t)(k0 + kk) * N + n0 + (lane & 31)]; }
    LDS_WAIT();
    const int c = lane & 7;
#pragma unroll
    for (int j = 0; j < 4; ++j) { const int n = (lane >> 3) + 8 * j; const LAS float* s = scr + (8 * c) * 33 + n;
        u32x4 o; o.x = pk2(s[0 * 33], s[1 * 33]); o.y = pk2(s[2 * 33], s[3 * 33]); o.z = pk2(s[4 * 33], s[5 * 33]); o.w = pk2(s[6 * 33], s[7 * 33]);
        *(u32x4*)(WT + (size_t)(n0 + n) * K + k0 + 8 * c) = o; }
    LDS_WAIT();
}
__device__ __forceinline__ void ph_wconv(const Params& p, LAS unsigned char* lds, int l) {
    const int tid = otid(), lane = tid & 63, wave = tid >> 6;
    LAS float* scr = (LAS float*)(lds + wave * 16384);
    const int gw = obid() * 8 + wave, NGW = gridDim.x * 8;
    constexpr int I_IN = (D / 64) * (INW / 32), I_OUT = (D / 64) * (D / 32), I_1 = (D / 64) * (HID / 32), I_2 = (HID / 64) * (D / 32);
    const float* win = p.w_in + (size_t)l * D * INW; const float* wout = p.w_out + (size_t)l * D * D;
    const float* w1 = p.w_mlp_in + (size_t)l * D * HID; const float* w2 = p.w_mlp_out + (size_t)l * HID * D;
    for (int it = gw; it < I_IN + I_OUT + I_1 + I_2; it += NGW) {
        int r = it;
        if (r < I_IN) { transpose_item(win, D, INW, (bf16_t*)(p.ws + WS_WIN), scr, r, lane); continue; } r -= I_IN;
        if (r < I_OUT) { transpose_item(wout, D, D, (bf16_t*)(p.ws + WS_WOUT), scr, r, lane); continue; } r -= I_OUT;
        if (r < I_1) { transpose_item(w1, D, HID, (bf16_t*)(p.ws + WS_W1), scr, r, lane); continue; } r -= I_1;
        transpose_item(w2, HID, D, (bf16_t*)(p.ws + WS_W2), scr, r, lane);
    }
    __syncthreads();
}

__device__ __forceinline__ void row_pass(const Params& p, int l, int mode) {
    const int tid = otid(), lane = tid & 63, wave = tid >> 6;
    const int gw = obid() * 8 + wave, NGW = gridDim.x * 8;
    const float* MOD = (const float*)(p.ws + WS_MOD);
    float* HC = (float*)(p.ws + WS_HC);
    const bf16_t* Y = (const bf16_t*)(p.ws + WS_YG);
    bf16_t* XN = (bf16_t*)(p.ws + WS_XN);
    const int nrows = (l == 0) ? MTOT : MLAT;
    const float* xin_lat; const float* xin_ctx; const float* gpost = nullptr; const float* gn; int jg = 0, jsh, jsc, lnext; bool do_next = true;
    if (mode == 0) { xin_lat = p.x; xin_ctx = p.ctx; gn = p.g_pre_mix; jsh = 0; jsc = 1; lnext = 0; }
    else if (mode == 1) { xin_lat = (l == 0) ? p.x : p.out; xin_ctx = (l == 0) ? p.ctx : HC; gpost = p.g_post_mix + l * D; jg = 2; gn = p.g_pre_mlp + l * D; jsh = 3; jsc = 4; lnext = l; }
    else { xin_lat = p.out; xin_ctx = HC; gpost = p.g_post_mlp + l * D; jg = 5; lnext = l + 1; do_next = (l + 1 < DEPTH); gn = p.g_pre_mix + (do_next ? lnext : l) * D; jsh = 0; jsc = 1; }
    f32x4 nxv[8]; u32x2 nyr[8];
#define ROW_LOAD(mm) do { const int m_ = (mm); const float* xr_ = m_ < MLAT ? xin_lat + (size_t)m_ * D : xin_ctx + (size_t)(m_ - MLAT) * D; \
        _Pragma("unroll") for (int j = 0; j < 8; ++j) nxv[j] = *(const f32x4*)(xr_ + j * 256 + lane * 4); \
        if (mode != 0) { const bf16_t* yr_ = Y + (size_t)m_ * D; _Pragma("unroll") for (int j = 0; j < 8; ++j) nyr[j] = *(const u32x2*)(yr_ + j * 256 + lane * 4); } } while (0)
    if (gw < nrows) ROW_LOAD(gw);
    for (int m = gw; m < nrows; m += NGW) {
        const int s = m < MLAT ? (m >> 14) : 2;
        f32x4 xv[8]; u32x2 yraw[8];
#pragma unroll
        for (int j = 0; j < 8; ++j) { xv[j] = nxv[j]; yraw[j] = nyr[j]; }
        if (m + NGW < nrows) ROW_LOAD(m + NGW);
        if (mode != 0) {
            f32x4 yv[8]; float ss = 0.f;
#pragma unroll
            for (int j = 0; j < 8; ++j) { const u32x2 raw = yraw[j];
                yv[j] = (f32x4){bf2f(raw.x & 0xffffu), bf2f(raw.x >> 16), bf2f(raw.y & 0xffffu), bf2f(raw.y >> 16)};
                ss += (yv[j].x * yv[j].x + yv[j].y * yv[j].y) + (yv[j].z * yv[j].z + yv[j].w * yv[j].w); }
            ss = wave_sum(ss);
            const float r = rsqrtf(ss * (1.f / D) + EPS);
            const float* gate = MOD + ((size_t)(l * 3 + s) * 6 + jg) * D;
            float* xo = m < MLAT ? p.out + (size_t)m * D : HC + (size_t)(m - MLAT) * D;
#pragma unroll
            for (int j = 0; j < 8; ++j) { const int col = j * 256 + lane * 4;
                const f32x4 g4 = *(const f32x4*)(gpost + col), gt = *(const f32x4*)(gate + col);
                xv[j] = xv[j] + gt * (yv[j] * r * g4);
                *(f32x4*)(xo + col) = xv[j]; }
        }
        if (do_next) {
            float ss = 0.f;
#pragma unroll
            for (int j = 0; j < 8; ++j) ss += (xv[j].x * xv[j].x + xv[j].y * xv[j].y) + (xv[j].z * xv[j].z + xv[j].w * xv[j].w);
            ss = wave_sum(ss);
            const float r = rsqrtf(ss * (1.f / D) + EPS);
            const float* sh = MOD + ((size_t)(lnext * 3 + s) * 6 + jsh) * D; const float* scl = MOD + ((size_t)(lnext * 3 + s) * 6 + jsc) * D;
            bf16_t* xn = XN + (size_t)m * D;
#pragma unroll
            for (int j = 0; j < 8; ++j) { const int col = j * 256 + lane * 4;
                const f32x4 g4 = *(const f32x4*)(gn + col), s4 = *(const f32x4*)(sh + col), c4 = *(const f32x4*)(scl + col);
                const f32x4 h = (xv[j] * r * g4) * (c4 + 1.f) + s4;
                u32x2 w; w.x = pk2(h.x, h.y); w.y = pk2(h.z, h.w);
                *(u32x2*)(xn + col) = w; }
        }
    }
#undef ROW_LOAD
}

constexpr int TSB = 144;
constexpr int KTB = 64 * TSB;
__device__ __forceinline__ int crow(int r, int hi) { return (r & 3) + 8 * (r >> 2) + 4 * hi; }
__device__ __forceinline__ float xhalf_max(float m) { auto rr = __builtin_amdgcn_permlane32_swap(__float_as_uint(m), __float_as_uint(m), false, false); return fmaxf(__uint_as_float(rr[0]), __uint_as_float(rr[1])); }
__device__ __forceinline__ float xhalf_sum(float m) { auto rr = __builtin_amdgcn_permlane32_swap(__float_as_uint(m), __float_as_uint(m), false, false); return __uint_as_float(rr[0]) + __uint_as_float(rr[1]); }
__device__ __forceinline__ float max3f(float a, float b, float c) { float r; asm("v_max3_f32 %0, %1, %2, %3" : "=v"(r) : "v"(a), "v"(b), "v"(c)); return r; }
__device__ __forceinline__ float fadd_s(float a, float b) { float r; asm("v_add_f32_e32 %0, %1, %2" : "=v"(r) : "v"(a), "v"(b)); return r; }
__device__ __forceinline__ void glds16(const void* gsrc, unsigned lds_dst) { unsigned keep;
    asm volatile("s_mov_b32 %0, m0\n\ts_mov_b32 m0, %2\n\ts_nop 0\n\tglobal_load_lds_dwordx4 %1, off\n\ts_mov_b32 m0, %0" : "=&s"(keep) : "v"(gsrc), "s"(lds_dst) : "memory"); }
#define LBARV() asm volatile("s_waitcnt vmcnt(0) lgkmcnt(0)\n\ts_barrier" ::: "memory")
#define LBAR() asm volatile("s_waitcnt lgkmcnt(0)\n\ts_barrier" ::: "memory")
typedef __bf16 bf16x2_t __attribute__((ext_vector_type(2)));
__device__ __forceinline__ unsigned cvtpk(float lo, float hi) { f32x2 v = {lo, hi}; bf16x2_t b = __builtin_convertvector(v, bf16x2_t); return __builtin_bit_cast(unsigned, b); }

__device__ __forceinline__ void wave_qk(f32x16& s0, f32x16& s1, const LAS unsigned char* Kt, const bf16x8 (&qf)[4], int r32, int hi) {
    s0 = (f32x16){}; s1 = (f32x16){};
#pragma unroll
    for (int d0 = 0; d0 < 4; ++d0) {
        const bf16x8 k0 = *(const LAS bf16x8*)(Kt + r32 * TSB + d0 * 32 + hi * 16);
        const bf16x8 k1 = *(const LAS bf16x8*)(Kt + (32 + r32) * TSB + d0 * 32 + hi * 16);
        s0 = __builtin_amdgcn_mfma_f32_32x32x16_bf16(k0, qf[d0], s0, 0, 0, 0);
        s1 = __builtin_amdgcn_mfma_f32_32x32x16_bf16(k1, qf[d0], s1, 0, 0, 0);
    }
}
template <int NDB, bool MASKED>
__device__ __forceinline__ void wave_softmax_pv(f32x16& s0, f32x16& s1, f32x16 (&o)[NDB], float& m, float& l, const LAS unsigned char* Vt, LAS float* scr, int r32, int hi) {
    float mx = fmaxf(s0[0], s1[0]);
#pragma unroll
    for (int r = 1; r < 16; ++r) mx = fmaxf(mx, fmaxf(s0[r], s1[r]));
    mx = xhalf_max(mx);
    if (__any(mx > m + 8.f)) {
        const float mn = fmaxf(m, mx); const float alpha = __builtin_amdgcn_exp2f(m - mn); m = mn; l *= alpha;
        if (hi == 0) scr[r32] = alpha;
        LDS_WAIT();
#pragma unroll
        for (int r = 0; r < 16; ++r) { const float a = scr[crow(r, hi)];
#pragma unroll
            for (int db = 0; db < NDB; ++db) o[db][r] *= a; }
        LDS_WAIT();
    }
    float ls = 0.f;
#pragma unroll
    for (int r = 0; r < 16; ++r) {
        float p0 = __builtin_amdgcn_exp2f(s0[r] - m), p1 = __builtin_amdgcn_exp2f(s1[r] - m);
        if (MASKED) { p0 = s0[r] < -1e29f ? 0.f : p0; p1 = s1[r] < -1e29f ? 0.f : p1; }
        s0[r] = p0; s1[r] = p1; ls += p0 + p1;
    }
    l += ls;
    bf16x8 pa[2][2];
#pragma unroll
    for (int s2 = 0; s2 < 2; ++s2) {
        u32x4 w0, w1;
        w0.x = cvtpk(s0[8 * s2 + 0], s0[8 * s2 + 1]); w0.y = cvtpk(s0[8 * s2 + 2], s0[8 * s2 + 3]); w0.z = cvtpk(s0[8 * s2 + 4], s0[8 * s2 + 5]); w0.w = cvtpk(s0[8 * s2 + 6], s0[8 * s2 + 7]);
        w1.x = cvtpk(s1[8 * s2 + 0], s1[8 * s2 + 1]); w1.y = cvtpk(s1[8 * s2 + 2], s1[8 * s2 + 3]); w1.z = cvtpk(s1[8 * s2 + 4], s1[8 * s2 + 5]); w1.w = cvtpk(s1[8 * s2 + 6], s1[8 * s2 + 7]);
        pa[0][s2] = __builtin_bit_cast(bf16x8, w0); pa[1][s2] = __builtin_bit_cast(bf16x8, w1);
    }
#pragma unroll
    for (int db = 0; db < NDB; ++db)
#pragma unroll
        for (int pp = 0; pp < 2; ++pp)
#pragma unroll
            for (int s2 = 0; s2 < 2; ++s2) {
                const bf16x8 v = *(const LAS bf16x8*)(Vt + (db * 32 + r32) * TSB + (32 * pp + 16 * s2 + 8 * hi) * 2);
                o[db] = __builtin_amdgcn_mfma_f32_32x32x16_bf16(pa[pp][s2], v, o[db], 0, 0, 0);
            }
}

constexpr int DTILEB = 2 * KTB + 128 * TSB;
__device__ __forceinline__ void diff_unit(LAS unsigned char* lds, const bf16_t* DQ, const bf16_t* DK, const bf16_t* DVt, bf16_t* MIX,
                                          int b, int h, int q0, int t0, int t1, float lam, const float* gnorm, float oscale) {
    const int tid = otid(), lane = tid & 63, wid = __builtin_amdgcn_readfirstlane(tid >> 6), r32 = lane & 31, hi = lane >> 5;
    const int grp = wid >> 2, p = wid & 1, qg = grp * 2 + ((wid >> 1) & 1);
    const int T = t1 - t0;
    LAS float* scr = (LAS float*)(lds + 3 * DTILEB) + wid * 32;
    const bf16_t* k0src = DK + ((size_t)((b * 8 + h) * 2 + 0) * NKEY) * 64 + tid * 8;
    const bf16_t* k1src = DK + ((size_t)((b * 8 + h) * 2 + 1) * NKEY) * 64 + tid * 8;
    const bf16_t* v0src = DVt + ((size_t)((b * 8 + h) * 128 + (tid >> 3)) * NKEY) + (tid & 7) * 8;
    const bf16_t* v1src = v0src + (size_t)64 * NKEY;
    const int kdst = (tid >> 3) * TSB + (tid & 7) * 16;
    u32x4 rk0, rk1, rv0, rv1;
#define DLOADK(t) do { rk0 = *(const u32x4*)(k0src + (size_t)(t) * 4096); rk1 = *(const u32x4*)(k1src + (size_t)(t) * 4096); } while (0)
#define DLOADV(t) do { rv0 = *(const u32x4*)(v0src + (t) * 64); rv1 = *(const u32x4*)(v1src + (t) * 64); } while (0)
#define DSTOREK(buf) do { LAS unsigned char* bb_ = lds + (buf) * DTILEB; *(LAS u32x4*)(bb_ + kdst) = rk0; *(LAS u32x4*)(bb_ + KTB + kdst) = rk1; } while (0)
#define DSTOREV(buf) do { LAS unsigned char* bb_ = lds + (buf) * DTILEB; *(LAS u32x4*)(bb_ + 2 * KTB + kdst) = rv0; *(LAS u32x4*)(bb_ + 2 * KTB + 64 * TSB + kdst) = rv1; } while (0)
    const bf16_t* qsrc = DQ + ((size_t)((b * 8 + h) * 2 + p) * NKEY + q0 + qg * 32 + r32) * 64 + hi * 8;
    bf16x8 qf[4];
#pragma unroll
    for (int d0 = 0; d0 < 4; ++d0) qf[d0] = *(const bf16x8*)(qsrc + d0 * 16);
    LAS unsigned char* qlds = lds + 3 * DTILEB + 1024 + wid * 4096 + lane * 16;
#pragma unroll
    for (int d0 = 0; d0 < 4; ++d0) *(LAS bf16x8*)(qlds + d0 * 1024) = qf[d0];
    f32x16 o[4]; o[0] = (f32x16){}; o[1] = (f32x16){}; o[2] = (f32x16){}; o[3] = (f32x16){};
    float m = 0.f, l = 0.f;
    f32x16 negm = (f32x16){};
    bf16x8 pa[2][2];
    f32x16 s0, s1;
    DLOADK(t0); DSTOREK(2); DLOADK(t0 + 1); DLOADV(t0); DSTOREK(0); DSTOREV(0);
    __syncthreads();
    wave_qk(s0, s1, lds + 2 * DTILEB + p * KTB, qf, r32, hi);
    const int wsub = wid & 3;
    const char* dsrc[5];
#pragma unroll
    for (int k = 0; k < 5; ++k) {
        const int B = (wsub + 4 * k) * 1024 + lane * 16;
        if (grp == 0) { const int pp = B >= KTB ? 1 : 0, Bp = B - pp * KTB, row = Bp / TSB; int col = Bp % TSB; if (col >= 128) col = 0;
            dsrc[k] = (const char*)(DK + ((size_t)((b * 8 + h) * 2 + pp) * NKEY) * 64) + row * 128 + col + (size_t)(t0 + 2) * 8192; }
        else { const int row = B / TSB; int col = B % TSB; if (col >= 128) col = 0;
            dsrc[k] = (const char*)(DVt + ((size_t)((b * 8 + h) * 128 + row) * NKEY)) + col + (size_t)(t0 + 1) * 128; }
    }
    const int dstride = grp == 0 ? 8192 : 128, gahead = 2 - grp;
    const unsigned ldsb = (unsigned)(size_t)(lds + (grp ? 2 * KTB : 0)) + wsub * 1024;
    auto STG = [&](const int e) __attribute__((always_inline)) {
        if (e + gahead < T) {
            const unsigned dbase = ldsb + (unsigned)(((e + 1) % 3) * DTILEB);
            const size_t off = (size_t)e * dstride;
#pragma unroll
            for (int k = 0; k < 4; ++k) glds16(dsrc[k] + off, (unsigned)__builtin_amdgcn_readfirstlane(dbase + k * 4096));
            if (wsub < 2) glds16(dsrc[4] + off, (unsigned)__builtin_amdgcn_readfirstlane(dbase + 16384));
        }
    };
    auto XH = [&](const int j) __attribute__((always_inline)) {
            {
                if (!(j & 1)) {
                asm volatile("s_nop 15\n\ts_nop 7" : "+v"(s0), "+v"(s1));
                float mxa = max3f(s0[0], s0[1], s1[0]), mxb = max3f(s0[2], s0[3], s1[1]); mxa = max3f(mxa, s1[2], s1[3]);
#pragma unroll
                for (int r = 4; r < 16; r += 4) { mxa = max3f(mxa, s0[r], s0[r + 1]); mxb = max3f(mxb, s0[r + 2], s0[r + 3]); mxa = max3f(mxa, s1[r], s1[r + 1]); mxb = max3f(mxb, s1[r + 2], s1[r + 3]); }
                float mx = max3f(mxa, mxb, mxb);
                { auto rr = __builtin_amdgcn_permlane32_swap(__float_as_uint(mx), __float_as_uint(mx), false, false); mx = max3f(__uint_as_float(rr[0]), __uint_as_float(rr[1]), __uint_as_float(rr[1])); }
                if (j == 0) {
                    m = mx;
#pragma unroll
                    for (int r = 0; r < 16; ++r) { s0[r] -= mx; s1[r] -= mx; negm[r] = -mx; }
                } else if (__any(mx > 8.f)) {
                    const float delta = fmaxf(mx, 0.f); const float alpha = __builtin_amdgcn_exp2f(-delta); m += delta; l *= alpha;
#pragma unroll
                    for (int r = 0; r < 16; ++r) { s0[r] -= delta; s1[r] -= delta; negm[r] = -m; }
                    if (hi == 0) scr[r32] = alpha;
                    LDS_WAIT();
#pragma unroll
                    for (int r = 0; r < 16; ++r) { const float a = scr[crow(r, hi)];
#pragma unroll
                        for (int db = 0; db < 4; ++db) o[db][r] *= a; }
                    LDS_WAIT();
                }
                }
                float ls = 0.f;
#pragma unroll
                for (int r = 0; r < 16; ++r) { s0[r] = __builtin_amdgcn_exp2f(s0[r]); s1[r] = __builtin_amdgcn_exp2f(s1[r]); }
                __builtin_amdgcn_sched_barrier(0);
                f32x2 la2 = {0.f, 0.f}, lb2 = {0.f, 0.f};
#pragma unroll
                for (int r = 0; r < 16; r += 2) {
                    const f32x2 pa2 = {s0[r], s0[r + 1]}, pb2 = {s1[r], s1[r + 1]};
                    asm("v_pk_add_f32 %0, %1, %2" : "=v"(la2) : "v"(la2), "v"(pa2));
                    asm("v_pk_add_f32 %0, %1, %2" : "=v"(lb2) : "v"(lb2), "v"(pb2));
                }
                l += (la2.x + la2.y) + (lb2.x + lb2.y) + ls;
#pragma unroll
                for (int s2 = 0; s2 < 2; ++s2) {
                    u32x4 w0, w1;
                    w0.x = cvtpk(s0[8 * s2 + 0], s0[8 * s2 + 1]); w0.y = cvtpk(s0[8 * s2 + 2], s0[8 * s2 + 3]); w0.z = cvtpk(s0[8 * s2 + 4], s0[8 * s2 + 5]); w0.w = cvtpk(s0[8 * s2 + 6], s0[8 * s2 + 7]);
                    w1.x = cvtpk(s1[8 * s2 + 0], s1[8 * s2 + 1]); w1.y = cvtpk(s1[8 * s2 + 2], s1[8 * s2 + 3]); w1.z = cvtpk(s1[8 * s2 + 4], s1[8 * s2 + 5]); w1.w = cvtpk(s1[8 * s2 + 6], s1[8 * s2 + 7]);
                    pa[0][s2] = __builtin_bit_cast(bf16x8, w0); pa[1][s2] = __builtin_bit_cast(bf16x8, w1);
                }
            }
    };
    auto YH = [&](const int j) __attribute__((always_inline)) {
            {
                const LAS unsigned char* bb = lds + (j % 3) * DTILEB;
                const LAS unsigned char* Vt = bb + 2 * KTB + r32 * TSB + hi * 16;
                const LAS unsigned char* Kt = bb + p * KTB + r32 * TSB + hi * 16;
                const bool more = (j + 1 < T);
                bf16x8 fa[4], fb[4];
#define VLD(dst, db) do { _Pragma("unroll") for (int pp = 0; pp < 2; ++pp) _Pragma("unroll") for (int s2 = 0; s2 < 2; ++s2) \
                        dst[pp * 2 + s2] = *(const LAS bf16x8*)(Vt + (db) * 32 * TSB + (32 * pp + 16 * s2) * 2); } while (0)
#define KLD(dst, dh) do { _Pragma("unroll") for (int dd = 0; dd < 2; ++dd) { dst[dd * 2] = *(const LAS bf16x8*)(Kt + ((dh) * 2 + dd) * 32); \
                        dst[dd * 2 + 1] = *(const LAS bf16x8*)(Kt + 32 * TSB + ((dh) * 2 + dd) * 32); } } while (0)
#define PVM(src, db) do { _Pragma("unroll") for (int pp = 0; pp < 2; ++pp) _Pragma("unroll") for (int s2 = 0; s2 < 2; ++s2) \
                        o[db] = __builtin_amdgcn_mfma_f32_32x32x16_bf16(pa[pp][s2], src[pp * 2 + s2], o[db], 0, 0, 0); } while (0)
#define QKM(src, dh) do { _Pragma("unroll") for (int dd = 0; dd < 2; ++dd) { s0 = __builtin_amdgcn_mfma_f32_32x32x16_bf16(src[dd * 2], qf[(dh) * 2 + dd], s0, 0, 0, 0); \
                        s1 = __builtin_amdgcn_mfma_f32_32x32x16_bf16(src[dd * 2 + 1], qf[(dh) * 2 + dd], s1, 0, 0, 0); } } while (0)
#define FENCE() do { asm volatile("" ::: "memory"); __builtin_amdgcn_sched_barrier(0); } while (0)
                VLD(fa, 0); FENCE();
                __builtin_amdgcn_s_setprio(1);
                VLD(fb, 1); FENCE(); PVM(fa, 0); FENCE();
                VLD(fa, 2); FENCE(); PVM(fb, 1); FENCE();
                VLD(fb, 3); FENCE(); PVM(fa, 2); FENCE();
                if (more) {
                    bf16x8 q0 = qf[0], q1 = qf[1];
                    KLD(fa, 0); FENCE(); PVM(fb, 3); FENCE();
                    KLD(fb, 1); FENCE();
                    s0 = __builtin_amdgcn_mfma_f32_32x32x16_bf16(fa[0], q0, negm, 0, 0, 0); s1 = __builtin_amdgcn_mfma_f32_32x32x16_bf16(fa[1], q0, negm, 0, 0, 0);
                    s0 = __builtin_amdgcn_mfma_f32_32x32x16_bf16(fa[2], q1, s0, 0, 0, 0);   s1 = __builtin_amdgcn_mfma_f32_32x32x16_bf16(fa[3], q1, s1, 0, 0, 0);
                    q0 = qf[2]; q1 = qf[3];
                    FENCE();
                    s0 = __builtin_amdgcn_mfma_f32_32x32x16_bf16(fb[0], q0, s0, 0, 0, 0); s1 = __builtin_amdgcn_mfma_f32_32x32x16_bf16(fb[1], q0, s1, 0, 0, 0);
                    s0 = __builtin_amdgcn_mfma_f32_32x32x16_bf16(fb[2], q1, s0, 0, 0, 0); s1 = __builtin_amdgcn_mfma_f32_32x32x16_bf16(fb[3], q1, s1, 0, 0, 0);
                } else { PVM(fb, 3); }
                __builtin_amdgcn_s_setprio(0);
#undef VLD
#undef KLD
#undef PVM
#undef QKM
#undef FENCE
            }
    };
    if (grp == 0) {
        for (int j = 0; j < T; ++j) { STG(j); XH(j); __builtin_amdgcn_sched_barrier(0); YH(j); LBARV(); __builtin_amdgcn_sched_barrier(0); }
        LBARV();
    } else {
        STG(0); XH(0); LBARV(); __builtin_amdgcn_sched_barrier(0);
        for (int j = 1; j < T; ++j) { STG(j); YH(j - 1); __builtin_amdgcn_sched_barrier(0); XH(j); LBARV(); __builtin_amdgcn_sched_barrier(0); }
        YH(T - 1); LBARV();
    }
#undef DLOADK
#undef DLOADV
#undef DSTOREK
#undef DSTOREV
    {
        const float lt = xhalf_sum(l); const float inv = 1.f / lt; const float coef = p ? -lam * inv : inv;
        if (hi == 0) scr[r32] = coef;
        LDS_WAIT();
#pragma unroll
        for (int r = 0; r < 16; ++r) { const float a = scr[crow(r, hi)];
#pragma unroll
            for (int db = 0; db < 4; ++db) o[db][r] *= a; }
        LDS_WAIT();
    }
    LAS float* stage = (LAS float*)lds;
    if (p == 1) {
#pragma unroll
        for (int r = 0; r < 16; ++r)
#pragma unroll
            for (int db = 0; db < 4; ++db) stage[(qg * 32 + crow(r, hi)) * 128 + db * 32 + r32] = o[db][r];
    }
    __syncthreads();
    if (p == 0) {
#pragma unroll
        for (int r = 0; r < 16; ++r)
#pragma unroll
            for (int db = 0; db < 4; ++db) { const int idx = (qg * 32 + crow(r, hi)) * 128 + db * 32 + r32; stage[idx] = stage[idx] + o[db][r]; }
    }
    __syncthreads();
    const float g0 = gnorm[lane], g1 = gnorm[64 + lane];
    for (int i = 0; i < 16; ++i) {
        const int row = wid * 16 + i;
        const float v0 = stage[row * 128 + lane], v1 = stage[row * 128 + 64 + lane];
        const float ss = wave_sum(v0 * v0 + v1 * v1);
        const float rs = rsqrtf(ss * (1.f / 128.f) + EPS) * oscale;
        bf16_t* dst = MIX + (size_t)prow(b, q0 + row) * D + 1024 + h * 128;
        dst[lane] = (bf16_t)f2bf(v0 * rs * g0); dst[64 + lane] = (bf16_t)f2bf(v1 * rs * g1);
    }
    __syncthreads();
}

constexpr int NHB = 2 * KTB;
__device__ __forceinline__ void na_unit(LAS unsigned char* lds, const bf16_t* P, const bf16_t* NAVt, bf16_t* MIX, const float* relb, int b, int hg, int qblk) {
    const int tid = otid(), lane = tid & 63, wid = __builtin_amdgcn_readfirstlane(tid >> 6), r32 = lane & 31, hi = lane >> 5;
    const int hh = wid >> 1, qg = wid & 1, head = hg * 4 + hh;
    const bool isctx = qblk >= 256;
    const int n0q = isctx ? SEQ + (qblk - 256) * 64 : qblk * 64;
    const int kr0 = isctx ? 0 : min(max(qblk - 4, 0), 248);
    const int NT = isctx ? 4 : 12;
#define NTILE_OF(i) (isctx ? 256 + (i) : ((i) < 4 ? 256 + (i) : kr0 + (i) - 4))
    LAS float* biasL = (LAS float*)(lds + 4 * NHB);
    LAS float* scr = (LAS float*)(lds + 4 * NHB + 7680) + wid * 32;
    for (int i = tid; i < 4 * 15 * 32; i += 512) { const int hh_ = i / 480, rem = i % 480, dr_ = rem >> 5, dc_ = rem & 31;
        biasL[i] = dc_ < 31 ? relb[(hg * 4 + hh_) * 465 + dr_ * 31 + dc_] * LOG2E : -1e30f; }
    unsigned boff0[4] = {0u, 0u, 0u, 0u}, boff1[4] = {0u, 0u, 0u, 0u};
    { const int qc = qg * 32 + r32, c0 = min(max(qc - 8, 0), 48);
#pragma unroll
      for (int r = 0; r < 16; ++r) { const int kc0 = crow(r, hi), kc1 = kc0 + 32;
          boff0[r >> 2] |= (unsigned)(((kc0 >= c0 && kc0 < c0 + 16) ? (kc0 - qc + 15) : 31) * 4) << (8 * (r & 3));
          boff1[r >> 2] |= (unsigned)(((kc1 >= c0 && kc1 < c0 + 16) ? (kc1 - qc + 15) : 31) * 4) << (8 * (r & 3)); } }
    const bf16_t* qsrc = P + (size_t)prow(b, n0q + qg * 32 + r32) * INWP + head * 64 + hi * 8;
    bf16x8 qf[4];
#pragma unroll
    for (int d0 = 0; d0 < 4; ++d0) qf[d0] = *(const bf16x8*)(qsrc + d0 * 16);
    const int kdst = (tid >> 3) * TSB + (tid & 7) * 16;
    u32x4 rk[4], rv[4];
#define NLOAD(tile) do { const int n0_ = (tile) * 64; const bf16_t* kp_ = P + (size_t)prow(b, n0_ + (tid >> 3)) * INWP + 512 + hg * 256 + (tid & 7) * 8; \
        const bf16_t* vp_ = NAVt + ((size_t)((b * 8 + hg * 4) * 64 + (tid >> 3)) * NKEY) + n0_ + (tid & 7) * 8; \
        _Pragma("unroll") for (int j = 0; j < 4; ++j) { rk[j] = *(const u32x4*)(kp_ + j * 64); rv[j] = *(const u32x4*)(vp_ + (size_t)j * 64 * NKEY); } } while (0)
#define NSTORE() do { _Pragma("unroll") for (int j = 0; j < 4; ++j) { *(LAS u32x4*)(lds + j * NHB + kdst) = rk[j]; *(LAS u32x4*)(lds + j * NHB + KTB + kdst) = rv[j]; } } while (0)
    f32x16 o[2]; o[0] = (f32x16){}; o[1] = (f32x16){};
    float m = -1e30f, l = 0.f;
    NLOAD(NTILE_OF(0));
    for (int i = 0; i < NT; ++i) {
        NSTORE(); __syncthreads();
        const int tl = NTILE_OF(i);
        if (i + 1 < NT) NLOAD(NTILE_OF(i + 1));
        f32x16 s0, s1;
        wave_qk(s0, s1, lds + hh * NHB, qf, r32, hi);
        if (tl < 256) {
            const LAS unsigned char* bl = (const LAS unsigned char*)biasL + hh * 1920 + (tl - qblk + 7) * 128;
#pragma unroll
            for (int r = 0; r < 16; ++r) {
                s0[r] = s0[r] * C2 + *(const LAS float*)(bl + ((boff0[r >> 2] >> (8 * (r & 3))) & 0xffu));
                s1[r] = s1[r] * C2 + *(const LAS float*)(bl + ((boff1[r >> 2] >> (8 * (r & 3))) & 0xffu));
            }
        } else {
#pragma unroll
            for (int r = 0; r < 16; ++r) { s0[r] *= C2; s1[r] *= C2; }
        }
        wave_softmax_pv<2, false>(s0, s1, o, m, l, lds + hh * NHB + KTB, scr, r32, hi);
        __syncthreads();
    }
#undef NLOAD
#undef NSTORE
#undef NTILE_OF
    {
        const float lt = xhalf_sum(l); const float inv = 1.f / lt;
        if (hi == 0) scr[r32] = inv;
        LDS_WAIT();
#pragma unroll
        for (int r = 0; r < 16; ++r) { const float a = scr[crow(r, hi)];
            bf16_t* dst = MIX + (size_t)prow(b, n0q + qg * 32 + crow(r, hi)) * D + head * 64 + r32;
            dst[0] = (bf16_t)f2bf(o[0][r] * a); dst[32] = (bf16_t)f2bf(o[1][r] * a); }
        LDS_WAIT();
    }
    __syncthreads();
}

__device__ __forceinline__ void rope_rows(const Params& p) {
    const bf16_t* P = (const bf16_t*)(p.ws + WS_P); bf16_t* DQ = (bf16_t*)(p.ws + WS_DQ); bf16_t* DK = (bf16_t*)(p.ws + WS_DK);
    const int tid = otid(), rsel = tid >> 8, hp = (tid >> 4) & 15, i2 = (tid & 15) * 2;
    const float inv0 = __builtin_amdgcn_exp2f(-(float)(i2 & 15) * (13.287712379549449f / 16.f));
    const float inv1 = __builtin_amdgcn_exp2f(-(float)((i2 + 1) & 15) * (13.287712379549449f / 16.f));
    for (int m0 = obid() * 8; m0 < MTOT; m0 += gridDim.x * 8) {
        unsigned q1[4], q2[4], k1[4], k2[4];
#pragma unroll
        for (int r = 0; r < 4; ++r) { const bf16_t* src = P + (size_t)(m0 + 2 * r + rsel) * INWP + DIFF_OFF + hp * 64 + i2;
            q1[r] = *(const unsigned*)src; q2[r] = *(const unsigned*)(src + 32); k1[r] = *(const unsigned*)(src + 1024); k2[r] = *(const unsigned*)(src + 1024 + 32); }
#pragma unroll
        for (int r = 0; r < 4; ++r) {
            const int m = m0 + 2 * r + rsel; int b, n; float cs0 = 1.f, sn0 = 0.f, cs1 = 1.f, sn1 = 0.f;
            if (m < MLAT) { b = m >> 14; const int t = m & (SEQ - 1); n = t; const float pos = (float)((i2 < 16) ? (t >> 6) : (t & 63));
                float rev0 = pos * inv0 * 0.15915494309189535f; rev0 -= rintf(rev0); sn0 = __builtin_amdgcn_sinf(rev0); cs0 = __builtin_amdgcn_cosf(rev0);
                float rev1 = pos * inv1 * 0.15915494309189535f; rev1 -= rintf(rev1); sn1 = __builtin_amdgcn_sinf(rev1); cs1 = __builtin_amdgcn_cosf(rev1); }
            else { b = (m - MLAT) >> 8; n = SEQ + ((m - MLAT) & 255); }
            const float qa0 = bf2f(q1[r] & 0xffffu), qa1 = bf2f(q1[r] >> 16), qb0 = bf2f(q2[r] & 0xffffu), qb1 = bf2f(q2[r] >> 16);
            const float ka0 = bf2f(k1[r] & 0xffffu), ka1 = bf2f(k1[r] >> 16), kb0 = bf2f(k2[r] & 0xffffu), kb1 = bf2f(k2[r] >> 16);
            const size_t dst = ((size_t)(b * 16 + hp) * NKEY + n) * 64 + i2;
            *(unsigned*)(DQ + dst) = pk2((qa0 * cs0 - qb0 * sn0) * C2, (qa1 * cs1 - qb1 * sn1) * C2);
            *(unsigned*)(DQ + dst + 32) = pk2((qa0 * sn0 + qb0 * cs0) * C2, (qa1 * sn1 + qb1 * cs1) * C2);
            *(unsigned*)(DK + dst) = pk2(ka0 * cs0 - kb0 * sn0, ka1 * cs1 - kb1 * sn1);
            *(unsigned*)(DK + dst + 32) = pk2(ka0 * sn0 + kb0 * cs0, ka1 * sn1 + kb1 * cs1);
        }
    }
}
template <int DV>
__device__ __forceinline__ void vtrans_item(LAS unsigned char* lds, const bf16_t* P, int colbase, bf16_t* Vt, int b, int hh, int tile) {
    constexpr int ST = DV + 2;
    LAS bf16_t* L = (LAS bf16_t*)lds;
    const int tid = otid();
    constexpr int CPR = DV / 8;
#pragma unroll
    for (int j = 0; j < (64 * CPR) / 512; ++j) {
        const int c = tid + 512 * j, key = c / CPR, ch = c % CPR;
        const u32x4 raw = *(const u32x4*)(P + (size_t)prow(b, tile * 64 + key) * INWP + colbase + hh * DV + ch * 8);
        LAS unsigned* d = (LAS unsigned*)(L + key * ST + ch * 8);
        d[0] = raw.x; d[1] = raw.y; d[2] = raw.z; d[3] = raw.w;
    }
    __syncthreads();
    if (tid < DV * 4) {
        const int d = tid >> 2, pg = tid & 3;
        unsigned w[8];
#pragma unroll
        for (int j2 = 0; j2 < 8; ++j2) {
            const int ja = 2 * j2, jb = 2 * j2 + 1;
            const int ka = 16 * pg + ((ja & 3) | ((ja & 4) << 1) | ((ja & 8) >> 1)), kb = 16 * pg + ((jb & 3) | ((jb & 4) << 1) | ((jb & 8) >> 1));
            w[j2] = (unsigned)L[ka * ST + d] | ((unsigned)L[kb * ST + d] << 16);
        }
        bf16_t* dst = Vt + ((size_t)((b * 8 + hh) * DV + d) * NKEY) + tile * 64 + 16 * pg;
        *(u32x4*)dst = (u32x4){w[0], w[1], w[2], w[3]}; *(u32x4*)(dst + 8) = (u32x4){w[4], w[5], w[6], w[7]};
    }
    __syncthreads();
}

template <int DV>
__device__ __forceinline__ void vtrans_loop(LAS unsigned char* lds, const bf16_t* P, int colbase, bf16_t* Vt, int bx, int G) {
    constexpr int ST = DV + 2, CPR = DV / 8, NCH = (64 * CPR) / 512, NITEMS = NB * 8 * NTILE;
    LAS bf16_t* L = (LAS bf16_t*)lds;
    const int tid = otid();
    u32x4 nx[NCH];
#define VT_LOAD(it_) do { const int b_ = (it_) / (8 * NTILE), hh_ = ((it_) / NTILE) % 8, tile_ = (it_) % NTILE; \
        _Pragma("unroll") for (int j = 0; j < NCH; ++j) { const int c = tid + 512 * j, key = c / CPR, ch = c % CPR; \
            nx[j] = *(const u32x4*)(P + (size_t)prow(b_, tile_ * 64 + key) * INWP + colbase + hh_ * DV + ch * 8); } } while (0)
    int it = bx;
    if (it < NITEMS) VT_LOAD(it);
    for (; it < NITEMS; it += G) {
        const int b = it / (8 * NTILE), hh = (it / NTILE) % 8, tile = it % NTILE;
#pragma unroll
        for (int j = 0; j < NCH; ++j) { const int c = tid + 512 * j, key = c / CPR, ch = c % CPR;
            LAS unsigned* d = (LAS unsigned*)(L + key * ST + ch * 8);
            d[0] = nx[j].x; d[1] = nx[j].y; d[2] = nx[j].z; d[3] = nx[j].w; }
        if (it + G < NITEMS) VT_LOAD(it + G);
        __syncthreads();
        if (tid < DV * 4) {
            const int d = tid >> 2, pg = tid & 3;
            unsigned w[8];
#pragma unroll
            for (int j2 = 0; j2 < 8; ++j2) {
                const int ja = 2 * j2, jb = 2 * j2 + 1;
                const int ka = 16 * pg + ((ja & 3) | ((ja & 4) << 1) | ((ja & 8) >> 1)), kb = 16 * pg + ((jb & 3) | ((jb & 4) << 1) | ((jb & 8) >> 1));
                w[j2] = (unsigned)L[ka * ST + d] | ((unsigned)L[kb * ST + d] << 16);
            }
            bf16_t* dst = Vt + ((size_t)((b * 8 + hh) * DV + d) * NKEY) + tile * 64 + 16 * pg;
            *(u32x4*)dst = (u32x4){w[0], w[1], w[2], w[3]}; *(u32x4*)(dst + 8) = (u32x4){w[4], w[5], w[6], w[7]};
        }
        __syncthreads();
    }
#undef VT_LOAD
}

__device__ __forceinline__ float logsig16(float x) { return (fminf(x, 0.f) - __logf(1.f + __expf(-fabsf(x)))) * (1.f / 16.f); }
__device__ __forceinline__ void gla_gates(LAS unsigned char* lds, const bf16_t* P, const float* wg, const float* bg, int b, int c, int h) {
    LAS float* la = (LAS float*)lds; LAS float* aL = (LAS float*)(lds + 33280);
    const int tid = otid();
    {
        const int t = tid >> 3, q4 = (tid & 7) * 4;
        const u32x2 raw = *(const u32x2*)(P + (size_t)prow(b, c * 64 + t) * INWP + GLA_OFF + 1536 + q4);
        LAS float* dst = aL + ((q4 >> 4) * 64 + t) * 16 + (q4 & 15);
        dst[0] = bf2f(raw.x & 0xffffu); dst[1] = bf2f(raw.x >> 16); dst[2] = bf2f(raw.y & 0xffffu); dst[3] = bf2f(raw.y >> 16);
    }
    const int d = tid & 63, tq = tid >> 6;
    float w0[16], w1[16];
#pragma unroll
    for (int r = 0; r < 16; ++r) { w0[r] = wg[r * 256 + h * 64 + d]; w1[r] = wg[(16 + r) * 256 + h * 64 + d]; }
    const float b0 = bg[h * 64 + d], b1 = bg[256 + h * 64 + d];
    __syncthreads();
#pragma unroll
    for (int tt = 0; tt < 8; ++tt) {
        const int t = tq * 8 + tt;
        float p0 = b0, p1 = b1;
#pragma unroll
        for (int r4 = 0; r4 < 4; ++r4) {
            const f32x4 a0 = *(const LAS f32x4*)(aL + t * 16 + r4 * 4), a1 = *(const LAS f32x4*)(aL + (64 + t) * 16 + r4 * 4);
            p0 += a0.x * w0[r4 * 4] + a0.y * w0[r4 * 4 + 1] + a0.z * w0[r4 * 4 + 2] + a0.w * w0[r4 * 4 + 3];
            p1 += a1.x * w1[r4 * 4] + a1.y * w1[r4 * 4 + 1] + a1.z * w1[r4 * 4 + 2] + a1.w * w1[r4 * 4 + 3];
        }
        la[t * 65 + d] = logsig16(p0); la[4160 + t * 65 + d] = logsig16(p1);
    }
    __syncthreads();
    {
        const int cz = (tid >> 6) & 1, seg = tid >> 7; LAS float* col = la + cz * 4160 + (tid & 63);
        float v[16];
#pragma unroll
        for (int i = 0; i < 16; ++i) v[i] = col[(seg * 16 + i) * 65];
        if (cz == 0) {
#pragma unroll
            for (int i = 1; i < 16; ++i) v[i] += v[i - 1];
        } else {
#pragma unroll
            for (int i = 14; i >= 0; --i) v[i] += v[i + 1];
        }
        LAS float* tot = aL + (tid & 127);
        tot[seg * 128] = cz == 0 ? v[15] : v[0];
        __syncthreads();
        float off = 0.f;
#pragma unroll
        for (int q = 0; q < 4; ++q) { const float tq_ = tot[q * 128]; off += ((cz == 0) ? (q < seg) : (q > seg)) ? tq_ : 0.f; }
#pragma unroll
        for (int i = 0; i < 16; ++i) col[(seg * 16 + i) * 65] = v[i] + off;
    }
    __syncthreads();
}
__device__ __forceinline__ void gla_g1_item(LAS unsigned char* lds, const bf16_t* P, const float* wg, const float* bg, float* GS, float* GD, int b, int c, int h) {
    gla_gates(lds, P, wg, bg, b, c, h);
    const LAS float* la = (const LAS float*)lds; LAS float* kd = (LAS float*)(lds + 41472); LAS float* vL = (LAS float*)(lds + 74240);
    const int tid = otid();
    {   const int t = tid >> 3, ch = tid & 7;
        const u32x4 rk = *(const u32x4*)(P + (size_t)prow(b, c * 64 + t) * INWP + GLA_OFF + 256 + h * 64 + ch * 8);
        u32x4 rv[2];
#pragma unroll
        for (int jj = 0; jj < 2; ++jj) { const int cc_ = tid + 512 * jj; rv[jj] = *(const u32x4*)(P + (size_t)prow(b, c * 64 + (cc_ >> 4)) * INWP + GLA_OFF + 512 + h * 128 + (cc_ & 15) * 8); }
        const unsigned kw[4] = {rk.x, rk.y, rk.z, rk.w};
#pragma unroll
        for (int e = 0; e < 8; ++e) { const int d = ch * 8 + e; const float k = bf2f((e & 1) ? (kw[e >> 1] >> 16) : (kw[e >> 1] & 0xffffu));
            kd[t * 64 + d] = k * __expf(la[63 * 65 + d] - la[t * 65 + d]);
            kd[4096 + t * 64 + d] = k * __expf(la[4160 + d] - la[4160 + t * 65 + d]); }
#pragma unroll
        for (int jj = 0; jj < 2; ++jj) { const int cc_ = tid + 512 * jj; LAS float* dv = vL + (cc_ >> 4) * 128 + (cc_ & 15) * 8;
            *(LAS f32x4*)dv = (f32x4){bf2f(rv[jj].x & 0xffffu), bf2f(rv[jj].x >> 16), bf2f(rv[jj].y & 0xffffu), bf2f(rv[jj].y >> 16)};
            *(LAS f32x4*)(dv + 4) = (f32x4){bf2f(rv[jj].z & 0xffffu), bf2f(rv[jj].z >> 16), bf2f(rv[jj].w & 0xffffu), bf2f(rv[jj].w >> 16)}; }
    }
    __syncthreads();
    const int v = tid & 127, dg = tid >> 7;
    f32x4 af4[4], ab4[4];
#pragma unroll
    for (int i = 0; i < 4; ++i) { af4[i] = (f32x4){0.f, 0.f, 0.f, 0.f}; ab4[i] = (f32x4){0.f, 0.f, 0.f, 0.f}; }
    for (int t = 0; t < 64; ++t) {
        const float vs = vL[t * 128 + v];
#pragma unroll
        for (int q = 0; q < 4; ++q) {
            const f32x4 kf = *(const LAS f32x4*)(kd + t * 64 + dg * 16 + q * 4), kb = *(const LAS f32x4*)(kd + 4096 + t * 64 + dg * 16 + q * 4);
            af4[q] += kf * vs; ab4[q] += kb * vs;
        }
    }
    float* gf = GS + ((size_t)((b * 2 + 0) * 4 + h) * NTILE + c) * 8192 + (dg * 16) * 128 + v;
    float* gb = GS + ((size_t)((b * 2 + 1) * 4 + h) * NTILE + c) * 8192 + (dg * 16) * 128 + v;
#pragma unroll
    for (int i = 0; i < 16; ++i) { gf[i * 128] = af4[i >> 2][i & 3]; gb[i * 128] = ab4[i >> 2][i & 3]; }
    if (tid < 128) { const int z = tid >> 6, d = tid & 63;
        GD[((size_t)((b * 2 + z) * 4 + h) * NTILE + c) * 64 + d] = __expf(z == 0 ? la[63 * 65 + d] : la[4160 + d]); }
    __syncthreads();
}
__device__ __forceinline__ void gla_scan(float* GS, const float* GD) {
    for (int gid = obid() * 512 + otid(); gid < 16 * 8192; gid += gridDim.x * 512) {
        const int v = gid & 127, d = (gid >> 7) & 63, chain = gid >> 13, z = (chain >> 2) & 1;
        float* gs = GS + (size_t)chain * NTILE * 8192 + d * 128 + v; const float* gd = GD + (size_t)chain * NTILE * 64 + d;
        float S = 0.f;
        for (int k0 = 0; k0 < NTILE; k0 += 10) {
            float L[10], Dc[10]; int cc[10];
#pragma unroll
            for (int j = 0; j < 10; ++j) { const int k = k0 + j; const int c = z ? (NTILE - 1 - k) : (k < 4 ? 256 + k : k - 4); cc[j] = c; L[j] = gs[(size_t)c * 8192]; Dc[j] = gd[c * 64]; }
#pragma unroll
            for (int j = 0; j < 10; ++j) { gs[(size_t)cc[j] * 8192] = S; S = Dc[j] * S + L[j]; }
        }
    }
}
__device__ __forceinline__ void gla_g3_item(LAS unsigned char* lds, const bf16_t* P, const float* wg, const float* bg, const float* GS, const float* gn, bf16_t* MIX, int b, int c, int h) {
    gla_gates(lds, P, wg, bg, b, c, h);
    const LAS float* la = (const LAS float*)lds;
    LAS float* QfT = (LAS float*)(lds + 41472); LAS float* QbT = (LAS float*)(lds + 57856);
    LAS float* KfT = (LAS float*)(lds + 74240); LAS float* KbT = (LAS float*)(lds + 90624);
    LAS float* VR = (LAS float*)(lds + 107008);
    LAS float* AT = (LAS float*)lds;
    LAS float* OL = KfT;
    const int tid = otid(), lane = tid & 63, wid = tid >> 6;
    {   const int t = tid >> 3, ch = tid & 7;
        const bf16_t* src = P + (size_t)prow(b, c * 64 + t) * INWP + GLA_OFF + h * 64 + ch * 8;
        const u32x4 rq = *(const u32x4*)src, rk = *(const u32x4*)(src + 256);
        LAS float* dq = VR + t * 65 + ch * 8; LAS float* dk = VR + 4160 + t * 65 + ch * 8;
        dq[0] = bf2f(rq.x & 0xffffu) * 0.125f; dq[1] = bf2f(rq.x >> 16) * 0.125f; dq[2] = bf2f(rq.y & 0xffffu) * 0.125f; dq[3] = bf2f(rq.y >> 16) * 0.125f;
        dq[4] = bf2f(rq.z & 0xffffu) * 0.125f; dq[5] = bf2f(rq.z >> 16) * 0.125f; dq[6] = bf2f(rq.w & 0xffffu) * 0.125f; dq[7] = bf2f(rq.w >> 16) * 0.125f;
        dk[0] = bf2f(rk.x & 0xffffu); dk[1] = bf2f(rk.x >> 16); dk[2] = bf2f(rk.y & 0xffffu); dk[3] = bf2f(rk.y >> 16);
        dk[4] = bf2f(rk.z & 0xffffu); dk[5] = bf2f(rk.z >> 16); dk[6] = bf2f(rk.w & 0xffffu); dk[7] = bf2f(rk.w >> 16); }
    __syncthreads();
    for (int idx = tid; idx < 4096; idx += 512) { const int t = idx & 63, d = idx >> 6;
        const float q = VR[t * 65 + d], k = VR[4160 + t * 65 + d], bp = la[t * 65 + d], bs = la[4160 + t * 65 + d];
        QfT[d * 64 + t] = q * __expf(bp); QbT[d * 64 + t] = q * __expf(bs); KfT[d * 64 + t] = k * __expf(-bp); KbT[d * 64 + t] = k * __expf(-bs); }
    __syncthreads();
#pragma unroll
    for (int jj = 0; jj < 2; ++jj) { const int cc_ = tid + 512 * jj, t = cc_ >> 4, ch = cc_ & 15;
        const u32x4 rv = *(const u32x4*)(P + (size_t)prow(b, c * 64 + t) * INWP + GLA_OFF + 512 + h * 128 + ch * 8);
        LAS float* dv = VR + t * 128 + ch * 8;
        *(LAS f32x4*)dv = (f32x4){bf2f(rv.x & 0xffffu), bf2f(rv.x >> 16), bf2f(rv.y & 0xffffu), bf2f(rv.y >> 16)};
        *(LAS f32x4*)(dv + 4) = (f32x4){bf2f(rv.z & 0xffffu), bf2f(rv.z >> 16), bf2f(rv.w & 0xffffu), bf2f(rv.w >> 16)}; }
    {
        const int t0 = 2 * (tid >> 4), s0 = 4 * (tid & 15);
        f32x4 af[2], ab[2];
#pragma unroll
        for (int i = 0; i < 2; ++i) { af[i] = (f32x4){0.f, 0.f, 0.f, 0.f}; ab[i] = (f32x4){0.f, 0.f, 0.f, 0.f}; }
        for (int d = 0; d < 64; ++d) {
            const f32x2 qf = *(const LAS f32x2*)(QfT + d * 64 + t0), qb = *(const LAS f32x2*)(QbT + d * 64 + t0);
            const f32x4 kf = *(const LAS f32x4*)(KfT + d * 64 + s0), kb = *(const LAS f32x4*)(KbT + d * 64 + s0);
#pragma unroll
            for (int i = 0; i < 2; ++i) { af[i] += kf * qf[i]; ab[i] += kb * qb[i]; }
        }
#pragma unroll
        for (int i = 0; i < 2; ++i)
#pragma unroll
            for (int j = 0; j < 4; ++j) { const int t = t0 + i, s = s0 + j; AT[s * 64 + t] = (s <= t) ? af[i][j] : ab[i][j]; }
    }
    __syncthreads();
    {
        const int v = tid & 127, tg = tid >> 7;
        f32x4 acc4[4];
#pragma unroll
        for (int i = 0; i < 4; ++i) acc4[i] = (f32x4){0.f, 0.f, 0.f, 0.f};
        const float* Sf = GS + ((size_t)((b * 2 + 0) * 4 + h) * NTILE + c) * 8192 + v; const float* Sb = GS + ((size_t)((b * 2 + 1) * 4 + h) * NTILE + c) * 8192 + v;
#define G3_LD(buf, d0) do { _Pragma("unroll") for (int k = 0; k < 4; ++k) { buf[k] = Sf[((d0) + k) * 128]; buf[4 + k] = Sb[((d0) + k) * 128]; } } while (0)
#define G3_FMA(buf, d0) do { _Pragma("unroll") for (int k = 0; k < 4; ++k) { const int d = (d0) + k; const float sf = buf[k], sb = buf[4 + k]; \
            _Pragma("unroll") for (int q = 0; q < 4; ++q) { \
                const f32x4 a = *(const LAS f32x4*)(QfT + d * 64 + tg * 16 + q * 4), bq = *(const LAS f32x4*)(QbT + d * 64 + tg * 16 + q * 4); \
                acc4[q] += a * sf + bq * sb; } } } while (0)
        {   float sA[8], sB[8];
            G3_LD(sA, 0);
            for (int d0 = 0; d0 < 64; d0 += 8) {
                G3_LD(sB, d0 + 4); asm volatile("" ::: "memory");
                G3_FMA(sA, d0);
                if (d0 + 8 < 64) G3_LD(sA, d0 + 8);
                asm volatile("" ::: "memory");
                G3_FMA(sB, d0 + 4);
            }
        }
#undef G3_LD
#undef G3_FMA
        for (int s = 0; s < 64; ++s) {
            const float vs = VR[s * 128 + v];
#pragma unroll
            for (int q = 0; q < 4; ++q) {
                const f32x4 a = *(const LAS f32x4*)(AT + s * 64 + tg * 16 + q * 4);
                acc4[q] += a * vs;
            }
        }
#pragma unroll
        for (int i = 0; i < 16; ++i) OL[(tg * 16 + i) * 128 + v] = acc4[i >> 2][i & 3];
    }
    __syncthreads();
    const float g0 = gn[lane], g1 = gn[64 + lane];
    for (int i = 0; i < 8; ++i) {
        const int t = wid * 8 + i;
        const float v0 = OL[t * 128 + lane], v1 = OL[t * 128 + 64 + lane];
        const float ss = wave_sum(v0 * v0 + v1 * v1);
        const float rs = rsqrtf(ss * (1.f / 128.f) + EPS);
        const size_t row = prow(b, c * 64 + t);
        const bf16_t* gp = P + row * INWP + GLA_OFF + 1024 + h * 128;
        const float ga = bf2f(gp[lane]), gb = bf2f(gp[64 + lane]);
        bf16_t* dst = MIX + row * D + 512 + h * 128;
        dst[lane] = (bf16_t)f2bf(v0 * rs * g0 * (ga / (1.f + __expf(-ga)))); dst[64 + lane] = (bf16_t)f2bf(v1 * rs * g1 * (gb / (1.f + __expf(-gb))));
    }
    __syncthreads();
}

#define XB_TMO      128
#define XB_XCNT(j)  (256  + 64 * (j))
#define XB_XSUB(j)  (1280 + 64 * (j))
#define XB_XGEN(j)  (2304 + 64 * (j))
#define XB_TOP      3328
#define XB_TOPGEN   3392
#define XCD_BAR_WORDS 3456
#define XB_SPIN_CAP (1u << 24)

__device__ __forceinline__ unsigned xb_ld(unsigned* p)              { return __hip_atomic_load(p, __ATOMIC_RELAXED, __HIP_MEMORY_SCOPE_AGENT); }
__device__ __forceinline__ unsigned xb_add(unsigned* p, unsigned v) { return __hip_atomic_fetch_add(p, v, __ATOMIC_RELAXED, __HIP_MEMORY_SCOPE_AGENT); }
__device__ __forceinline__ unsigned xb_xcc_id() { return (unsigned)__builtin_amdgcn_s_getreg((3 << 11) | 20) & 0xFu; }
#define XB_SPIN(cond, bar) do { unsigned _sp = 0; while (cond) { __builtin_amdgcn_s_sleep(1); \
    if ((++_sp & 255u) == 0u) { if (xb_ld(&(bar)[XB_TMO])) break; if (_sp > XB_SPIN_CAP) { atomicAdd(&(bar)[XB_TMO], 1u); break; } } } } while (0)

struct XcdBarrier {
    unsigned* bar; unsigned x;
    volatile LAS unsigned* st;
};

__device__ __forceinline__ XcdBarrier xcd_barrier_post(unsigned* bar, volatile LAS unsigned* st) {
    XcdBarrier b; b.bar = bar; b.x = xb_xcc_id(); b.st = st;
    if (threadIdx.x == 0) (void)xb_add(&bar[XB_XCNT(b.x)], 1u);
    return b;
}
__device__ __forceinline__ void xcd_barrier_complete(unsigned* bar, unsigned x, unsigned& nloc, unsigned& nx) {
    const unsigned G = gridDim.x * gridDim.y * gridDim.z;
    unsigned sum, cnt, mine, sp = 0u;
    for (;;) {
        sum = 0u; cnt = 0u; mine = 0u;
#pragma unroll
        for (unsigned j = 0; j < 16; ++j) { const unsigned c = xb_ld(&bar[XB_XCNT(j)]); sum += c; cnt += (c > 0u) ? 1u : 0u; mine = (j == x) ? c : mine; }
        if (sum == G) break;
        __builtin_amdgcn_s_sleep(1);
        if ((++sp & 255u) == 0u) { if (xb_ld(&bar[XB_TMO])) break; if (sp > XB_SPIN_CAP) { atomicAdd(&bar[XB_TMO], 1u); break; } }
    }
    nloc = mine > 0u ? mine : 1u; nx = cnt > 0u ? cnt : 1u;
}

__device__ __forceinline__ void xcd_barrier(const XcdBarrier& b) {
    asm volatile("s_waitcnt vmcnt(0)" ::: "memory");
    __syncthreads();
    if (threadIdx.x == 0) {
        unsigned* bar = b.bar;
        __builtin_amdgcn_s_waitcnt(0);
        unsigned nloc = b.st[0], nx = b.st[1];
        if (nloc == 0u) { xcd_barrier_complete(bar, b.x, nloc, nx); b.st[0] = nloc; b.st[1] = nx; }
        const unsigned old = xb_add(&bar[XB_XSUB(b.x)], 1u);
        const unsigned gen = old / nloc;
        if (old + 1u == (gen + 1u) * nloc) {
            __builtin_amdgcn_fence(__ATOMIC_RELEASE, "agent");
            asm volatile("s_waitcnt vmcnt(0)" ::: "memory");
            const unsigned og = xb_add(&bar[XB_TOP], 1u);
            const unsigned tg = og / nx;
            if (og + 1u == (tg + 1u) * nx) xb_add(&bar[XB_TOPGEN], 1u);
            else XB_SPIN(xb_ld(&bar[XB_TOPGEN]) == tg, bar);
            __builtin_amdgcn_fence(__ATOMIC_ACQUIRE, "agent");
            xb_add(&bar[XB_XGEN(b.x)], 1u);
            asm volatile("s_waitcnt vmcnt(0)" ::: "memory");
        } else {
            XB_SPIN(xb_ld(&bar[XB_XGEN(b.x)]) == gen, bar);
            __builtin_amdgcn_fence(__ATOMIC_ACQUIRE, "agent");
            asm volatile("s_waitcnt vmcnt(0)" ::: "memory");
        }
    }
    __syncthreads();
}

__global__ void __launch_bounds__(512) fwd_kernel(Params p) {
    extern __shared__ __attribute__((aligned(16))) unsigned char lds_raw[];
    LAS unsigned char* lds = (LAS unsigned char*)lds_raw;
    cg::grid_group grid = cg::this_grid();
    { const int t_ = otid(); if (t_ < 16) ((LAS unsigned*)(lds + LDS_BYTES - 64))[t_] = 0u; }
    __syncthreads();
    XcdBarrier xbar = xcd_barrier_post((unsigned*)p.ws, (volatile LAS unsigned*)(lds + LDS_BYTES - 64));
    const int G = gridDim.x, bx = obid();
    bf16_t* P = (bf16_t*)(p.ws + WS_P); bf16_t* MIX = (bf16_t*)(p.ws + WS_MIX); bf16_t* XN = (bf16_t*)(p.ws + WS_XN);
    bf16_t* YB = (bf16_t*)(p.ws + WS_YG); bf16_t* HB = (bf16_t*)(p.ws + WS_H);
    float* GS = (float*)(p.ws + WS_YG); float* GD = (float*)(p.ws + WS_GD);
    bf16_t* DQ = (bf16_t*)(p.ws + WS_DQ); bf16_t* DK = (bf16_t*)(p.ws + WS_DK); bf16_t* DVt = (bf16_t*)(p.ws + WS_DVT); bf16_t* NAVt = (bf16_t*)(p.ws + WS_NAVT);
    for (int ph = p.ph_lo; ph < p.ph_hi; ++ph) {
        bool is_gemm = false; pg8::Gemm g{nullptr, nullptr, 0, 0, 0}; pg8::EpiAct E{nullptr, 0, 0};
        if (ph == 0) { if (EN(0)) { ph_mod(p, lds); ph_wconv(p, lds, 0); } }
        else if (ph == 1) { if (EN(1)) row_pass(p, 0, 0); }
        else {
            const int l = (ph - 2) / 9, s = (ph - 2) % 9;
            const bool need_ctx = (l + 1 < DEPTH);
            const int Mpost = need_ctx ? MTOT : MLAT;
            if (s == 0) { is_gemm = true; g = pg8::Gemm{XN, (const bf16_t*)(p.ws + WS_WIN), MTOT, INWP, D}; E = pg8::EpiAct{P, INWP, 0}; }
            else if (s == 4) { is_gemm = true; g = pg8::Gemm{MIX, (const bf16_t*)(p.ws + WS_WOUT), Mpost, D, D}; E = pg8::EpiAct{YB, D, 0}; }
            else if (s == 6) { is_gemm = true; g = pg8::Gemm{XN, (const bf16_t*)(p.ws + WS_W1), Mpost, HID, D}; E = pg8::EpiAct{HB, HID, 1}; }
            else if (s == 7) { is_gemm = true; g = pg8::Gemm{HB, (const bf16_t*)(p.ws + WS_W2), Mpost, D, HID}; E = pg8::EpiAct{YB, D, 0}; }
            else if (s == 1 && EN(2)) {
                rope_rows(p);
                vtrans_loop<128>(lds, P, DIFF_OFF + 2048, DVt, bx, G);
                vtrans_loop<64>(lds, P, 1024, NAVt, bx, G);
                const float* wg = p.gla_w_gate + (size_t)l * 2 * 16 * 256; const float* bg = p.gla_b_gate + (size_t)l * 2 * 256;
                for (int it = bx; it < NB * NTILE * 4; it += G) { const int h = it & 3, c = (it >> 2) % NTILE, b = it / (4 * NTILE); gla_g1_item(lds, P, wg, bg, GS, GD, b, c, h); }
            }
            else if (s == 2 && EN(3)) {
                if (EN(11)) gla_scan(GS, GD);
                const float* relb = p.na_rel_bias + (size_t)l * 8 * 465;
                const int nq = need_ctx ? 260 : 256;
                if (EN(10)) for (int it = bx; it < NB * 2 * nq; it += G) { int hg, qblk, b;
                    if (it < NB * 2 * 256) {
                        if (G == 256) { const int u = (it >> 8) * 32 + (bx >> 3), x = bx & 7; hg = u & 1; qblk = (x & 3) * 64 + (u >> 1); b = x >> 2; }
                        else { hg = it & 1; qblk = (it >> 1) & 255; b = it >> 9; } }
                    else { const int r = it - NB * 2 * 256; hg = r & 1; qblk = 256 + ((r >> 1) & 3); b = r >> 3; }
                    na_unit(lds, P, NAVt, MIX, relb, b, hg, qblk); }
            }
            else if (s == 3 && EN(4)) {
                const float* wg = p.gla_w_gate + (size_t)l * 2 * 16 * 256; const float* bg = p.gla_b_gate + (size_t)l * 2 * 256;
                const int nc = need_ctx ? NTILE : 256;
                if (EN(8)) for (int it = bx; it < NB * nc * 4; it += G) { const int h = it & 3, c = (it >> 2) % nc, b = it / (4 * nc); gla_g3_item(lds, P, wg, bg, GS, p.gla_g_norm + l * 128, MIX, b, c, h); }
                const float* lp = p.diff_lambda + (size_t)l * 4 * 64;
                float d01 = 0.f, d23 = 0.f;
                for (int i = 0; i < 64; ++i) { d01 += lp[i] * lp[64 + i]; d23 += lp[128 + i] * lp[192 + i]; }
                const float lam_init = 0.8f - 0.6f * __expf(-0.3f * (float)l);
                const float lam = __expf(d01) - __expf(d23) + lam_init;
                const int nqb = need_ctx ? 130 : 128;
                if (EN(9)) for (int it = bx; it < NB * 8 * nqb; it += G) {
                    int qb, h, b;
                    if (it < NB * 8 * 128) { qb = it & 127; h = (it >> 7) & 7; b = it >> 10; }
                    else { const int r = it - NB * 8 * 128; qb = 128 + (r & 1); h = (r >> 1) & 7; b = r >> 4; }
                    const bool isctx = qb >= 128;
                    diff_unit(lds, DQ, DK, DVt, MIX, b, h, qb * 128, isctx ? 256 : 0, NTILE, lam, p.diff_g_norm + l * 128, 1.f - lam_init);
                }
            }
            else if (s == 5 && EN(5)) { row_pass(p, l, 1); }
            else if (s == 8 && EN(6)) { row_pass(p, l, 2); if (l + 1 < DEPTH) ph_wconv(p, lds, l + 1); }
        }
        if (is_gemm && EN(7)) { pg8::StaticOrder S; S.init(g.M, g.N, G, bx); pg8::gemm_phase<pg8::EpiAct, pg8::StaticOrder, true, true>(lds, g, S, E); }
        if (ph + 1 < p.ph_hi) { if (ph == 0) grid.sync(); else xcd_barrier(xbar); }
    }

}

extern "C" void kernel_launch(void* const* d_in, const int* in_sizes, int n_in, void* d_out, int out_size, void* d_ws, size_t ws_size, hipStream_t stream) {
    static int grid = 0;
    if (grid == 0) {
        if (n_in != 20 || in_sizes[0] != MLAT * D || out_size != MLAT * D || ws_size < WS_END) {
            fprintf(stderr, "kernel_launch: unexpected shapes (n_in %d, in0 %d, out %d, ws %zu); nothing launched\n", n_in, n_in > 0 ? in_sizes[0] : -1, out_size, ws_size); grid = -1; return; }
        int dev = 0, cus = 0, per_cu = 0;
        if (hipGetDevice(&dev) != hipSuccess || hipDeviceGetAttribute(&cus, hipDeviceAttributeMultiprocessorCount, dev) != hipSuccess) { grid = -1; return; }
        if (hipFuncSetAttribute((const void*)fwd_kernel, hipFuncAttributeMaxDynamicSharedMemorySize, LDS_BYTES) != hipSuccess) { fprintf(stderr, "kernel_launch: hipFuncSetAttribute failed\n"); grid = -1; return; }
        if (hipOccupancyMaxActiveBlocksPerMultiprocessor(&per_cu, (const void*)fwd_kernel, 512, LDS_BYTES) != hipSuccess || per_cu < 1) { fprintf(stderr, "kernel_launch: occupancy query gave %d\n", per_cu); per_cu = 1; }
        (void)hipGetLastError();
        grid = cus * per_cu;
    }
    if (grid < 0) return;
    (void)hipMemsetAsync(d_ws, 0, WS_ZERO_BYTES, stream);
    Params p{};
    const float** pp = (const float**)&p;
    for (int i = 0; i < 20; ++i) pp[i] = (const float*)d_in[i];
    p.out = (float*)d_out; p.ws = (unsigned char*)d_ws; p.ph_lo = 0; p.ph_hi = NPH;
    void* args[] = {&p};
    hipError_t e = hipLaunchCooperativeKernel((const void*)fwd_kernel, dim3(grid), dim3(512), args, LDS_BYTES, stream);
    if (e != hipSuccess) fprintf(stderr, "cooperative launch failed: %s (grid %d)\n", hipGetErrorString(e), grid);
}
```

```cpp
#include <hip/hip_runtime.h>
#include <hip/hip_cooperative_groups.h>
#include <cstdio>
#include <cstdint>
namespace cg = cooperative_groups;
__device__ __forceinline__ int otid() { int t = threadIdx.x; asm volatile("" : "+v"(t)); return t; }
__device__ __forceinline__ int obid() { int t = blockIdx.x; asm volatile("" : "+s"(t)); return t; }
namespace pg8 {
#define PG8_LAS __attribute__((address_space(3)))
typedef unsigned short bf16_t;
typedef short bf16x8 __attribute__((ext_vector_type(8)));
typedef float f32x4 __attribute__((ext_vector_type(4)));
typedef unsigned u32x4 __attribute__((ext_vector_type(4)));
constexpr int BM = 256, BK = 64, HALF = 128, HTB = HALF * BK * 2  , STAGE_BYTES = 8 * HTB, NXCD = 8, WGM = 4;

__host__ __device__ __forceinline__ int lds_byte(int r, int c) { const int st = (r >> 4) * 2 + (c >> 5), rr = r & 15, cc = c & 31, ob = rr * 64 + cc * 2; return st * 1024 + (ob ^ (((ob >> 9) & 1) << 5)); }
__host__ __device__ __forceinline__ void stage_rc(int b, int& R, int& C) { const int st = b / 1024, sb = b % 1024, swz = sb ^ (((sb >> 9) & 1) << 5); R = (st >> 1) * 16 + swz / 64; C = (st & 1) * 32 + (swz % 64) / 2; }
__host__ __device__ __forceinline__ int perm32(int rho) { const int n = rho >> 4, i = rho & 15; return 8 * (i >> 2) + 4 * n + (i & 3); }

struct Unit { int pm, pn; };
struct Gemm { const bf16_t* A; const bf16_t* Bt; int M, N, K; };

struct StaticOrder {
    int nM, nN, nwg, G, c;
    __host__ __device__ void init(int M, int N, int G_, int c_) { nM = M / BM; nN = N / BM; nwg = nM * nN; G = G_; c = c_; }
    __host__ __device__ bool next(int i, Unit& u) const {
        const long L = (long)i * G + c; if (L >= nwg) return false;
        int wgid = (int)L; { const int q = nwg / NXCD, r = nwg % NXCD, xcd = wgid % NXCD, off = wgid / NXCD; wgid = (xcd < r ? xcd * (q + 1) : r * (q + 1) + (xcd - r) * q) + off; }
        const int nig = WGM * nN, gid = wgid / nig, fm = gid * WGM, gsz = (nM - fm) < WGM ? (nM - fm) : WGM;
        u.pm = fm + ((wgid % nig) % gsz); u.pn = (wgid % nig) / gsz; return true;
    }
    __device__ __forceinline__ void a_ready(const Unit&) const {}
    __device__ __forceinline__ void done(const Unit&) const {}
};

__device__ __forceinline__ unsigned cvt_pk_bf16(float lo, float hi) { unsigned r; asm volatile("v_cvt_pk_bf16_f32 %0, %1, %2" : "=v"(r) : "v"(lo), "v"(hi)); return r; }
typedef float f32x2 __attribute__((ext_vector_type(2)));
struct EpiAct {
    static constexpr bool PERM = true, AFTER_DRAIN = false;
    bf16_t* O; int ldc; int act;
    __device__ __forceinline__ void operator()(const f32x4 (&acc)[2][2][4][2], const Unit& u, int wr, int wc, int fr, int fq) const {
        const int row0 = u.pm * BM + wr * 64 + fr; const int col0 = u.pn * BM + wc * 32 + 8 * fq;
#pragma unroll
        for (int ai = 0; ai < 2; ++ai)
#pragma unroll
            for (int m = 0; m < 4; ++m) { bf16_t* rowp = O + (size_t)(row0 + ai * HALF + m * 16) * ldc + col0;
#pragma unroll
                for (int bj = 0; bj < 2; ++bj) { f32x4 v0 = acc[ai][bj][m][0], v1 = acc[ai][bj][m][1];
                    if (act) {
#pragma unroll
                        for (int e = 0; e < 4; ++e) { float a = fmaxf(v0[e], 0.f), b = fmaxf(v1[e], 0.f); v0[e] = a * a; v1[e] = b * b; } }
                    u32x4 w; w.x = cvt_pk_bf16(v0[0], v0[1]); w.y = cvt_pk_bf16(v0[2], v0[3]); w.z = cvt_pk_bf16(v1[0], v1[1]); w.w = cvt_pk_bf16(v1[2], v1[3]);
                    *(u32x4*)(rowp + bj * HALF) = w; } }
    }
};
template <class Epi, class Sched, bool ALIGN_EPI = false, bool SP2 = false>
__device__ __forceinline__ void gemm_phase(PG8_LAS unsigned char* lds, const Gemm g, const Sched& S, const Epi& E) {
    const int tid = otid(), wid = __builtin_amdgcn_readfirstlane(tid >> 6), lane = tid & 63, wr = wid >> 2, wc = wid & 3, fr = lane & 15, fq = lane >> 4;
    const int K = g.K, nt = K / BK;
    unsigned voffA[2], voffB[2];
#pragma unroll
    for (int i = 0; i < 2; ++i) { int R, C; stage_rc(tid * 16 + i * 8192, R, C); const int Rb = Epi::PERM ? ((R & ~31) + perm32(R & 31)) : R;
        voffA[i] = (unsigned)(R * K + C) * 2u; voffB[i] = (unsigned)(Rb * K + C) * 2u; }
    const size_t kstep = (size_t)(BK * 2);
    const size_t hstep = (size_t)HALF * K * 2;
    const size_t tstep = 2 * hstep;
    const unsigned ldsw = (unsigned)wid * 1024u;
    const int aoff = lds_byte(wr * 64 + fr, fq * 8), boff = lds_byte(wc * 32 + fr, fq * 8);
#define PG8_SA(b, h) (((b) * 2 + (h)) * HTB)
#define PG8_SB(b, h) ((4 + (b) * 2 + (h)) * HTB)
#define PG8_STAGE(bufoff, gbase, voff) do { _Pragma("unroll") for (int _i = 0; _i < 2; ++_i) \
        __builtin_amdgcn_global_load_lds((const unsigned*)((const char*)(gbase) + (voff)[_i]), (PG8_LAS unsigned*)(lds + (bufoff) + ldsw + _i * 8192), 16, 0, 0); } while (0)
#define PG8_LDA(dst, b, h) do { _Pragma("unroll") for (int m = 0; m < 4; ++m) _Pragma("unroll") for (int k = 0; k < 2; ++k) dst[m][k] = *(const PG8_LAS bf16x8*)(lds + PG8_SA(b, h) + aoff + m * 2048 + k * 1024); } while (0)
#define PG8_LDB(dst, b, h) do { _Pragma("unroll") for (int n = 0; n < 2; ++n) _Pragma("unroll") for (int k = 0; k < 2; ++k) dst[n][k] = *(const PG8_LAS bf16x8*)(lds + PG8_SB(b, h) + boff + n * 2048 + k * 1024); } while (0)
#define PG8_MMA(ai, bj, At, Bt) do { __builtin_amdgcn_s_setprio(1); _Pragma("unroll") for (int m = 0; m < 4; ++m) _Pragma("unroll") for (int n = 0; n < 2; ++n) _Pragma("unroll") for (int k = 0; k < 2; ++k) \
        acc[ai][bj][m][n] = __builtin_amdgcn_mfma_f32_16x16x32_bf16(Bt[n][k], At[m][k], acc[ai][bj][m][n], 0, 0, 0); __builtin_amdgcn_s_setprio(0); } while (0)
#define PG8_WAIT_V(n) asm volatile("s_waitcnt vmcnt(" #n ")" ::: "memory")
#define PG8_WAIT_L(n) asm volatile("s_waitcnt lgkmcnt(" #n ")" ::: "memory")
#define PG8_BAR __builtin_amdgcn_s_barrier()
#define PG8_SCHED __builtin_amdgcn_sched_barrier(0)
    Unit cur, nxt; int ui = 0;
    if (!S.next(0, cur)) return;
    f32x4 acc[2][2][4][2];
#pragma unroll
    for (int a = 0; a < 2; ++a)
#pragma unroll
        for (int b = 0; b < 2; ++b)
#pragma unroll
            for (int m = 0; m < 4; ++m)
#pragma unroll
                for (int n = 0; n < 2; ++n) acc[a][b][m][n] = (f32x4){0.f, 0.f, 0.f, 0.f};
    bf16x8 At[4][2], B0[2][2], B1[2][2];
    const char* cA = (const char*)g.A + (size_t)cur.pm * tstep; const char* cB = (const char*)g.Bt + (size_t)cur.pn * tstep;
    S.a_ready(cur);
    if constexpr (SP2) {
        PG8_STAGE(PG8_SB(0, 0), cB, voffB); PG8_STAGE(PG8_SB(0, 1), cB + hstep, voffB); PG8_STAGE(PG8_SA(0, 0), cA, voffA); PG8_STAGE(PG8_SA(0, 1), cA + hstep, voffA);
        if (wr == 1) PG8_BAR;
        PG8_WAIT_V(2); PG8_BAR;
        PG8_STAGE(PG8_SB(1, 0), cB + kstep, voffB); PG8_STAGE(PG8_SA(1, 0), cA + kstep, voffA); PG8_STAGE(PG8_SB(1, 1), cB + hstep + kstep, voffB);
        PG8_WAIT_V(6); PG8_BAR;
    } else {
        PG8_STAGE(PG8_SB(0, 0), cB, voffB); PG8_STAGE(PG8_SA(0, 0), cA, voffA); PG8_STAGE(PG8_SB(0, 1), cB + hstep, voffB); PG8_STAGE(PG8_SA(0, 1), cA + hstep, voffA);
        if (wr == 1) PG8_BAR;
        PG8_WAIT_V(4); PG8_BAR;
        PG8_STAGE(PG8_SB(1, 0), cB + kstep, voffB); PG8_STAGE(PG8_SA(1, 0), cA + kstep, voffA); PG8_STAGE(PG8_SB(1, 1), cB + hstep + kstep, voffB);
        PG8_WAIT_V(6); PG8_BAR;
    }
    for (;;) {
        const bool has_next = S.next(ui + 1, nxt);
        const char* nA = has_next ? (const char*)g.A + (size_t)nxt.pm * tstep : cA; const char* nB = has_next ? (const char*)g.Bt + (size_t)nxt.pn * tstep : cB;
        for (int t = 0; t < nt; t += 2) {
            const bool last = (t == nt - 2);
            const char* a1 = cA + (size_t)(t + 1) * kstep;
            const char* a2 = last ? nA : cA + (size_t)(t + 2) * kstep; const char* b2 = last ? nB : cB + (size_t)(t + 2) * kstep;
            const char* a3 = a2 + kstep; const char* b3 = b2 + kstep;
            if (last && has_next) S.a_ready(nxt);
            if constexpr (SP2) {
            PG8_LDB(B0, 0, 0); PG8_LDB(B1, 0, 1); PG8_SCHED; PG8_LDA(At, 0, 0); PG8_STAGE(PG8_SA(1, 1), a1 + hstep, voffA);
            PG8_WAIT_V(8); PG8_WAIT_L(0); PG8_BAR; PG8_MMA(0, 0, At, B0); PG8_MMA(0, 1, At, B1); PG8_BAR; PG8_SCHED;
            PG8_LDA(At, 0, 1); PG8_STAGE(PG8_SB(0, 0), b2, voffB); PG8_STAGE(PG8_SB(0, 1), b2 + hstep, voffB); PG8_STAGE(PG8_SA(0, 0), a2, voffA);
            PG8_WAIT_V(8); PG8_WAIT_L(0); PG8_BAR; PG8_MMA(1, 0, At, B0); PG8_MMA(1, 1, At, B1); PG8_BAR; PG8_SCHED;
            PG8_LDB(B0, 1, 0); PG8_LDB(B1, 1, 1); PG8_SCHED; PG8_LDA(At, 1, 0); PG8_STAGE(PG8_SA(0, 1), a2 + hstep, voffA);
            PG8_WAIT_V(8); PG8_WAIT_L(0); PG8_BAR; PG8_MMA(0, 0, At, B0); PG8_MMA(0, 1, At, B1); PG8_BAR; PG8_SCHED;
            PG8_LDA(At, 1, 1); PG8_STAGE(PG8_SB(1, 0), b3, voffB); PG8_STAGE(PG8_SB(1, 1), b3 + hstep, voffB); PG8_STAGE(PG8_SA(1, 0), a3, voffA);
            PG8_WAIT_V(8); PG8_WAIT_L(0); PG8_BAR; PG8_MMA(1, 0, At, B0); PG8_MMA(1, 1, At, B1); PG8_BAR; PG8_SCHED;
            } else {
            PG8_LDB(B0, 0, 0); PG8_SCHED; PG8_LDA(At, 0, 0); PG8_STAGE(PG8_SA(1, 1), a1 + hstep, voffA);
            PG8_WAIT_L(8); PG8_BAR; PG8_WAIT_L(0); PG8_MMA(0, 0, At, B0); PG8_BAR; PG8_SCHED;
            PG8_LDB(B1, 0, 1); PG8_STAGE(PG8_SB(0, 0), b2, voffB);
            PG8_BAR; PG8_WAIT_L(0); PG8_MMA(0, 1, At, B1); PG8_BAR;
            PG8_LDA(At, 0, 1); PG8_STAGE(PG8_SA(0, 0), a2, voffA);
            PG8_BAR; PG8_WAIT_L(0); PG8_MMA(1, 0, At, B0); PG8_BAR; PG8_SCHED;
            PG8_STAGE(PG8_SB(0, 1), b2 + hstep, voffB);
            PG8_WAIT_V(6); PG8_BAR; PG8_MMA(1, 1, At, B1); PG8_BAR;
            PG8_LDB(B0, 1, 0); PG8_SCHED; PG8_LDA(At, 1, 0); PG8_STAGE(PG8_SA(0, 1), a2 + hstep, voffA);
            PG8_WAIT_L(8); PG8_BAR; PG8_WAIT_L(0); PG8_MMA(0, 0, At, B0); PG8_BAR; PG8_SCHED;
            PG8_LDB(B1, 1, 1); PG8_STAGE(PG8_SB(1, 0), b3, voffB);
            PG8_BAR; PG8_WAIT_L(0); PG8_MMA(0, 1, At, B1); PG8_BAR;
            PG8_LDA(At, 1, 1); PG8_STAGE(PG8_SA(1, 0), a3, voffA);
            PG8_BAR; PG8_WAIT_L(0); PG8_MMA(1, 0, At, B0); PG8_BAR; PG8_SCHED;
            PG8_STAGE(PG8_SB(1, 1), b3 + hstep, voffB);
            PG8_WAIT_V(6); PG8_BAR; PG8_MMA(1, 1, At, B1); PG8_BAR;
            }
        }
        if constexpr (ALIGN_EPI) { if (wr == 0) PG8_BAR; }
        if constexpr (!Epi::AFTER_DRAIN) { E(acc, cur, wr, wc, fr, fq); S.done(cur); }
        if (!has_next) break;
#pragma unroll
        for (int a = 0; a < 2; ++a)
#pragma unroll
            for (int b = 0; b < 2; ++b)
#pragma unroll
                for (int m = 0; m < 4; ++m)
#pragma unroll
                    for (int n = 0; n < 2; ++n) acc[a][b][m][n] = (f32x4){0.f, 0.f, 0.f, 0.f};
        cur = nxt; cA = nA; cB = nB; ++ui;
        if constexpr (ALIGN_EPI) { if (wr == 1) PG8_BAR; }
    }
    PG8_WAIT_V(0);
    if constexpr (!ALIGN_EPI) { if (wr == 0) PG8_BAR; }
    PG8_BAR;
    if constexpr (Epi::AFTER_DRAIN) { E.fused(acc, cur, wr, wc, fr, fq, lds, wid, lane); S.done(cur); }
#undef PG8_SA
#undef PG8_SB
#undef PG8_STAGE
#undef PG8_LDA
#undef PG8_LDB
#undef PG8_MMA
#undef PG8_WAIT_V
#undef PG8_WAIT_L
#undef PG8_BAR
#undef PG8_SCHED
}
}
constexpr int D = 2048, NB = 2, SEQ = 16384, NCTX = 256, DEPTH = 2;
constexpr int MLAT = NB * SEQ, MCTX = NB * NCTX, MTOT = MLAT + MCTX;
constexpr int INW = 6176, INWP = 6400, HID = 8192;
constexpr int NKEY = SEQ + NCTX;
constexpr int NTILE = NKEY / 64;
constexpr int GLA_OFF = 1536, DIFF_OFF = 3104;
constexpr float EPS = 1e-6f;
constexpr float LOG2E = 1.4426950408889634f;
constexpr float C2 = 0.125f * LOG2E;
constexpr int NPH = 2 + 9 * DEPTH;
constexpr int LDS_BYTES = 147456;
#ifndef PHMASK
#define PHMASK 0xFFFF
#endif
#define EN(x) (((PHMASK) >> (x)) & 1)

constexpr size_t MiB = 1u << 20;
constexpr size_t WS_MOD = 1 * MiB, WS_ZERO_BYTES = 2 * MiB;
constexpr size_t WS_WIN = 2 * MiB, WS_WOUT = 27 * MiB, WS_W1 = 35 * MiB, WS_W2 = 67 * MiB;
constexpr size_t WS_XN = 99 * MiB;
constexpr size_t WS_DQ = WS_XN, WS_DK = WS_XN + 65 * MiB;
constexpr size_t WS_P = 229 * MiB;
constexpr size_t WS_MIX = WS_P + (size_t)MTOT * INWP * 2;
constexpr size_t WS_H = WS_P;
constexpr size_t WS_YG = 766 * MiB;
constexpr size_t WS_HC = 896 * MiB;
constexpr size_t WS_DVT = 900 * MiB;
constexpr size_t WS_NAVT = 965 * MiB;
constexpr size_t WS_GD = 998 * MiB;
constexpr size_t WS_END = 1000 * MiB;
static_assert(WS_MIX + (size_t)MTOT * D * 2 <= WS_YG && WS_H + (size_t)MTOT * HID * 2 <= WS_MIX + (size_t)MTOT * D * 2, "ws map");
static_assert((size_t)NB * 16 * NKEY * 64 * 2 == 65 * MiB, "dq size");

typedef unsigned short bf16_t;
typedef float f32x2 __attribute__((ext_vector_type(2)));
typedef float f32x4 __attribute__((ext_vector_type(4)));
typedef float f32x16 __attribute__((ext_vector_type(16)));
typedef short bf16x8 __attribute__((ext_vector_type(8)));
typedef unsigned u32x4 __attribute__((ext_vector_type(4)));
typedef unsigned u32x2 __attribute__((ext_vector_type(2)));
#define LAS __attribute__((address_space(3)))
#define LDS_WAIT() asm volatile("s_waitcnt lgkmcnt(0)" ::: "memory")

struct Params {
    const float *x, *c, *ctx, *c_ctx, *w_ada, *b_ada, *g_pre_mix, *g_post_mix, *g_pre_mlp, *g_post_mlp,
                *w_in, *w_out, *na_rel_bias, *gla_w_gate, *gla_b_gate, *gla_g_norm, *diff_lambda, *diff_g_norm, *w_mlp_in, *w_mlp_out;
    float* out; unsigned char* ws; int ph_lo, ph_hi;
};

__device__ __forceinline__ float bf2f(unsigned u) { return __uint_as_float(u << 16); }
__device__ __forceinline__ unsigned f2bf(float f) { unsigned u = __float_as_uint(f); return (u + 0x7fffu + ((u >> 16) & 1u)) >> 16; }
__device__ __forceinline__ unsigned pk2(float lo, float hi) { return f2bf(lo) | (f2bf(hi) << 16); }
__device__ __forceinline__ float wave_sum(float v) {
#pragma unroll
    for (int o = 1; o < 64; o <<= 1) v += __shfl_xor(v, o);
    return v;
}
__device__ __forceinline__ int prow(int b, int n) { return n < SEQ ? b * SEQ + n : MLAT + b * NCTX + (n - SEQ); }

__device__ __forceinline__ void ph_mod(const Params& p, LAS unsigned char* lds) {
    LAS float* sc = (LAS float*)lds;
    const int tid = otid();
    for (int i = tid; i < 3 * D; i += 512) { const float v = i < 2 * D ? p.c[i] : p.c_ctx[i - 2 * D]; sc[i] = v / (1.f + __expf(-v)); }
    __syncthreads();
    float* MOD = (float*)(p.ws + WS_MOD);
    const int col_in = tid & 255, kh = tid >> 8;
    for (int it = obid(); it < 2 * 48 * 8; it += gridDim.x) {
        const int ks = it & 7, cb = (it >> 3) % 48, l = it / 384;
        const int col = cb * 256 + col_in;
        const float* W = p.w_ada + (size_t)l * D * 12288 + col;
        const int k0 = ks * 256 + kh * 128;
        float a0 = 0.f, a1 = 0.f, a2 = 0.f;
#pragma unroll 8
        for (int k = k0; k < k0 + 128; ++k) { const float w = W[(size_t)k * 12288]; a0 += sc[k] * w; a1 += sc[D + k] * w; a2 += sc[2 * D + k] * w; }
        if (ks == 0 && kh == 0) { const float bb = p.b_ada[l * 12288 + col]; a0 += bb; a1 += bb; a2 += bb; }
        float* m = MOD + (size_t)l * 3 * 12288 + col;
        atomicAdd(m, a0); atomicAdd(m + 12288, a1); atomicAdd(m + 2 * 12288, a2);
    }
    __syncthreads();
}

__device__ __forceinline__ void transpose_item(const float* W, int K, int N, bf16_t* WT, LAS float* scr, int item, int lane) {
    const int nblk = N / 32, kb = item / nblk, nb = item % nblk, k0 = 64 * kb, n0 = 32 * nb;
#pragma unroll 8
    for (int i = 0; i < 32; ++i) { const int kk = 2 * i + (lane >> 5); scr[kk * 33 + (lane & 31)] = W[(size_t)(k0 + kk) * N + n0 + (lane & 31)]; }
    LDS_WAIT();
    const int c = lane & 7;
#pragma unroll
    for (int j = 0; j < 4; ++j) { const int n = (lane >> 3) + 8 * j; const LAS float* s = scr + (8 * c) * 33 + n;
        u32x4 o; o.x = pk2(s[0 * 33], s[1 * 33]); o.y = pk2(s[2 * 33], s[3 * 33]); o.z = pk2(s[4 * 33], s[5 * 33]); o.w = pk2(s[6 * 33], s[7 * 33]);
        *(u32x4*)(WT + (size_t)(n0 + n) * K + k0 + 8 * c) = o; }
    LDS_WAIT();
}
__device__ __forceinline__ void ph_wconv(const Params& p, LAS unsigned char* lds, int l) {
    const int tid = otid(), lane = tid & 63, wave = tid >> 6;
    LAS float* scr = (LAS float*)(lds + wave * 16384);
    const int gw = obid() * 8 + wave, NGW = gridDim.x * 8;
    constexpr int I_IN = (D / 64) * (INW / 32), I_OUT = (D / 64) * (D / 32), I_1 = (D / 64) * (HID / 32), I_2 = (HID / 64) * (D / 32);
    const float* win = p.w_in + (size_t)l * D * INW; const float* wout = p.w_out + (size_t)l * D * D;
    const float* w1 = p.w_mlp_in + (size_t)l * D * HID; const float* w2 = p.w_mlp_out + (size_t)l * HID * D;
    for (int it = gw; it < I_IN + I_OUT + I_1 + I_2; it += NGW) {
        int r = it;
        if (r < I_IN) { transpose_item(win, D, INW, (bf16_t*)(p.ws + WS_WIN), scr, r, lane); continue; } r -= I_IN;
        if (r < I_OUT) { transpose_item(wout, D, D, (bf16_t*)(p.ws + WS_WOUT), scr, r, lane); continue; } r -= I_OUT;
        if (r < I_1) { transpose_item(w1, D, HID, (bf16_t*)(p.ws + WS_W1), scr, r, lane); continue; } r -= I_1;
        transpose_item(w2, HID, D, (bf16_t*)(p.ws + WS_W2), scr, r, lane);
    }
    __syncthreads();
}

__device__ __forceinline__ void row_pass(const Params& p, int l, int mode) {
    const int tid = otid(), lane = tid & 63, wave = tid >> 6;
    const int gw = obid() * 8 + wave, NGW = gridDim.x * 8;
    const float* MOD = (const float*)(p.ws + WS_MOD);
    float* HC = (float*)(p.ws + WS_HC);
    const bf16_t* Y = (const bf16_t*)(p.ws + WS_YG);
    bf16_t* XN = (bf16_t*)(p.ws + WS_XN);
    const int nrows = (l == 0) ? MTOT : MLAT;
    const float* xin_lat; const float* xin_ctx; const float* gpost = nullptr; const float* gn; int jg = 0, jsh, jsc, lnext; bool do_next = true;
    if (mode == 0) { xin_lat = p.x; xin_ctx = p.ctx; gn = p.g_pre_mix; jsh = 0; jsc = 1; lnext = 0; }
    else if (mode == 1) { xin_lat = (l == 0) ? p.x : p.out; xin_ctx = (l == 0) ? p.ctx : HC; gpost = p.g_post_mix + l * D; jg = 2; gn = p.g_pre_mlp + l * D; jsh = 3; jsc = 4; lnext = l; }
    else { xin_lat = p.out; xin_ctx = HC; gpost = p.g_post_mlp + l * D; jg = 5; lnext = l + 1; do_next = (l + 1 < DEPTH); gn = p.g_pre_mix + (do_next ? lnext : l) * D; jsh = 0; jsc = 1; }
    f32x4 nxv[8]; u32x2 nyr[8];
#define ROW_LOAD(mm) do { const int m_ = (mm); const float* xr_ = m_ < MLAT ? xin_lat + (size_t)m_ * D : xin_ctx + (size_t)(m_ - MLAT) * D; \
        _Pragma("unroll") for (int j = 0; j < 8; ++j) nxv[j] = *(const f32x4*)(xr_ + j * 256 + lane * 4); \
        if (mode != 0) { const bf16_t* yr_ = Y + (size_t)m_ * D; _Pragma("unroll") for (int j = 0; j < 8; ++j) nyr[j] = *(const u32x2*)(yr_ + j * 256 + lane * 4); } } while (0)
    if (gw < nrows) ROW_LOAD(gw);
    for (int m = gw; m < nrows; m += NGW) {
        const int s = m < MLAT ? (m >> 14) : 2;
        f32x4 xv[8]; u32x2 yraw[8];
#pragma unroll
        for (int j = 0; j < 8; ++j) { xv[j] = nxv[j]; yraw[j] = nyr[j]; }
        if (m + NGW < nrows) ROW_LOAD(m + NGW);
        if (mode != 0) {
            f32x4 yv[8]; float ss = 0.f;
#pragma unroll
            for (int j = 0; j < 8; ++j) { const u32x2 raw = yraw[j];
                yv[j] = (f32x4){bf2f(raw.x & 0xffffu), bf2f(raw.x >> 16), bf2f(raw.y & 0xffffu), bf2f(raw.y >> 16)};
                ss += (yv[j].x * yv[j].x + yv[j].y * yv[j].y) + (yv[j].z * yv[j].z + yv[j].w * yv[j].w); }
            ss = wave_sum(ss);
            const float r = rsqrtf(ss * (1.f / D) + EPS);
            const float* gate = MOD + ((size_t)(l * 3 + s) * 6 + jg) * D;
            float* xo = m < MLAT ? p.out + (size_t)m * D : HC + (size_t)(m - MLAT) * D;
#pragma unroll
            for (int j = 0; j < 8; ++j) { const int col = j * 256 + lane * 4;
                const f32x4 g4 = *(const f32x4*)(gpost + col), gt = *(const f32x4*)(gate + col);
                xv[j] = xv[j] + gt * (yv[j] * r * g4);
                *(f32x4*)(xo + col) = xv[j]; }
        }
        if (do_next) {
            float ss = 0.f;
#pragma unroll
            for (int j = 0; j < 8; ++j) ss += (xv[j].x * xv[j].x + xv[j].y * xv[j].y) + (xv[j].z * xv[j].z + xv[j].w * xv[j].w);
            ss = wave_sum(ss);
            const float r = rsqrtf(ss * (1.f / D) + EPS);
            const float* sh = MOD + ((size_t)(lnext * 3 + s) * 6 + jsh) * D; const float* scl = MOD + ((size_t)(lnext * 3 + s) * 6 + jsc) * D;
            bf16_t* xn = XN + (size_t)m * D;
#pragma unroll
            for (int j = 0; j < 8; ++j) { const int col = j * 256 + lane * 4;
                const f32x4 g4 = *(const f32x4*)(gn + col), s4 = *(const f32x4*)(sh + col), c4 = *(const f32x4*)(scl + col);
                const f32x4 h = (xv[j] * r * g4) * (c4 + 1.f) + s4;
                u32x2 w; w.x = pk2(h.x, h.y); w.y = pk2(h.z, h.w);
                *(u32x2*)(xn + col) = w; }
        }
    }
#undef ROW_LOAD
}

constexpr int TSB = 144;
constexpr int KTB = 64 * TSB;
__device__ __forceinline__ int crow(int r, int hi) { return (r & 3) + 8 * (r >> 2) + 4 * hi; }
__device__ __forceinline__ float xhalf_max(float m) { auto rr = __builtin_amdgcn_permlane32_swap(__float_as_uint(m), __float_as_uint(m), false, false); return fmaxf(__uint_as_float(rr[0]), __uint_as_float(rr[1])); }
__device__ __forceinline__ float xhalf_sum(float m) { auto rr = __builtin_amdgcn_permlane32_swap(__float_as_uint(m), __float_as_uint(m), false, false); return __uint_as_float(rr[0]) + __uint_as_float(rr[1]); }
__device__ __forceinline__ float max3f(float a, float b, float c) { float r; asm("v_max3_f32 %0, %1, %2, %3" : "=v"(r) : "v"(a), "v"(b), "v"(c)); return r; }
__device__ __forceinline__ float fadd_s(float a, float b) { float r; asm("v_add_f32_e32 %0, %1, %2" : "=v"(r) : "v"(a), "v"(b)); return r; }
__device__ __forceinline__ void glds16(const void* gsrc, unsigned lds_dst) { unsigned keep;
    asm volatile("s_mov_b32 %0, m0\n\ts_mov_b32 m0, %2\n\ts_nop 0\n\tglobal_load_lds_dwordx4 %1, off\n\ts_mov_b32 m0, %0" : "=&s"(keep) : "v"(gsrc), "s"(lds_dst) : "memory"); }
__device__ __forceinline__ void glds16s(unsigned voff, const void* sbase, unsigned lds_dst) { unsigned keep;
    asm volatile("s_mov_b32 %0, m0\n\ts_mov_b32 m0, %3\n\ts_nop 0\n\tglobal_load_lds_dwordx4 %1, %2\n\ts_mov_b32 m0, %0" : "=&s"(keep) : "v"(voff), "s"(sbase), "s"(lds_dst) : "memory"); }
#define LBARV() asm volatile("s_waitcnt vmcnt(0) lgkmcnt(0)\n\ts_barrier" ::: "memory")
#define LBAR() asm volatile("s_waitcnt lgkmcnt(0)\n\ts_barrier" ::: "memory")
typedef __bf16 bf16x2_t __attribute__((ext_vector_type(2)));
__device__ __forceinline__ unsigned cvtpk(float lo, float hi) { f32x2 v = {lo, hi}; bf16x2_t b = __builtin_convertvector(v, bf16x2_t); return __builtin_bit_cast(unsigned, b); }

__device__ __forceinline__ void wave_qk(f32x16& s0, f32x16& s1, const LAS unsigned char* Kt, const bf16x8 (&qf)[4], int r32, int hi) {
    s0 = (f32x16){}; s1 = (f32x16){};
#pragma unroll
    for (int d0 = 0; d0 < 4; ++d0) {
        const bf16x8 k0 = *(const LAS bf16x8*)(Kt + r32 * TSB + d0 * 32 + hi * 16);
        const bf16x8 k1 = *(const LAS bf16x8*)(Kt + (32 + r32) * TSB + d0 * 32 + hi * 16);
        s0 = __builtin_amdgcn_mfma_f32_32x32x16_bf16(k0, qf[d0], s0, 0, 0, 0);
        s1 = __builtin_amdgcn_mfma_f32_32x32x16_bf16(k1, qf[d0], s1, 0, 0, 0);
    }
}
template <int NDB, bool MASKED>
__device__ __forceinline__ void wave_softmax_pv(f32x16& s0, f32x16& s1, f32x16 (&o)[NDB], float& m, float& l, const LAS unsigned char* Vt, LAS float* scr, int r32, int hi) {
    float mx = fmaxf(s0[0], s1[0]);
#pragma unroll
    for (int r = 1; r < 16; ++r) mx = fmaxf(mx, fmaxf(s0[r], s1[r]));
    mx = xhalf_max(mx);
    if (__any(mx > m + 8.f)) {
        const float mn = fmaxf(m, mx); const float alpha = __builtin_amdgcn_exp2f(m - mn); m = mn; l *= alpha;
        if (hi == 0) scr[r32] = alpha;
        LDS_WAIT();
#pragma unroll
        for (int r = 0; r < 16; ++r) { const float a = scr[crow(r, hi)];
#pragma unroll
            for (int db = 0; db < NDB; ++db) o[db][r] *= a; }
        LDS_WAIT();
    }
    float ls = 0.f;
#pragma unroll
    for (int r = 0; r < 16; ++r) {
        float p0 = __builtin_amdgcn_exp2f(s0[r] - m), p1 = __builtin_amdgcn_exp2f(s1[r] - m);
        if (MASKED) { p0 = s0[r] < -1e29f ? 0.f : p0; p1 = s1[r] < -1e29f ? 0.f : p1; }
        s0[r] = p0; s1[r] = p1; ls += p0 + p1;
    }
    l += ls;
    bf16x8 pa[2][2];
#pragma unroll
    for (int s2 = 0; s2 < 2; ++s2) {
        u32x4 w0, w1;
        w0.x = cvtpk(s0[8 * s2 + 0], s0[8 * s2 + 1]); w0.y = cvtpk(s0[8 * s2 + 2], s0[8 * s2 + 3]); w0.z = cvtpk(s0[8 * s2 + 4], s0[8 * s2 + 5]); w0.w = cvtpk(s0[8 * s2 + 6], s0[8 * s2 + 7]);
        w1.x = cvtpk(s1[8 * s2 + 0], s1[8 * s2 + 1]); w1.y = cvtpk(s1[8 * s2 + 2], s1[8 * s2 + 3]); w1.z = cvtpk(s1[8 * s2 + 4], s1[8 * s2 + 5]); w1.w = cvtpk(s1[8 * s2 + 6], s1[8 * s2 + 7]);
        pa[0][s2] = __builtin_bit_cast(bf16x8, w0); pa[1][s2] = __builtin_bit_cast(bf16x8, w1);
    }
#pragma unroll
    for (int db = 0; db < NDB; ++db)
#pragma unroll
        for (int pp = 0; pp < 2; ++pp)
#pragma unroll
            for (int s2 = 0; s2 < 2; ++s2) {
                const bf16x8 v = *(const LAS bf16x8*)(Vt + (db * 32 + r32) * TSB + (32 * pp + 16 * s2 + 8 * hi) * 2);
                o[db] = __builtin_amdgcn_mfma_f32_32x32x16_bf16(pa[pp][s2], v, o[db], 0, 0, 0);
            }
}

constexpr int DTILEB = 2 * KTB + 128 * TSB;
__device__ __forceinline__ void diff_unit(LAS unsigned char* lds, const bf16_t* DQ, const bf16_t* DK, const bf16_t* DVt, bf16_t* MIX,
                                          int b, int h, int q0, int t0, int t1, float lam, const float* gnorm, float oscale) {
    const int tid = otid(), lane = tid & 63, wid = __builtin_amdgcn_readfirstlane(tid >> 6), r32 = lane & 31, hi = lane >> 5;
    const int grp = wid >> 2, p = wid & 1, qg = grp * 2 + ((wid >> 1) & 1);
    const int T = t1 - t0;
    LAS float* scr = (LAS float*)(lds + 3 * DTILEB) + wid * 32;
    const bf16_t* k0src = DK + ((size_t)((b * 8 + h) * 2 + 0) * NKEY) * 64 + tid * 8;
    const bf16_t* k1src = DK + ((size_t)((b * 8 + h) * 2 + 1) * NKEY) * 64 + tid * 8;
    const bf16_t* v0src = DVt + ((size_t)((b * 8 + h) * 128 + (tid >> 3)) * NKEY) + (tid & 7) * 8;
    const bf16_t* v1src = v0src + (size_t)64 * NKEY;
    const int kdst = (tid >> 3) * TSB + (tid & 7) * 16;
    u32x4 rk0, rk1, rv0, rv1;
#define DLOADK(t) do { rk0 = *(const u32x4*)(k0src + (size_t)(t) * 4096); rk1 = *(const u32x4*)(k1src + (size_t)(t) * 4096); } while (0)
#define DLOADV(t) do { rv0 = *(const u32x4*)(v0src + (t) * 64); rv1 = *(const u32x4*)(v1src + (t) * 64); } while (0)
#define DSTOREK(buf) do { LAS unsigned char* bb_ = lds + (buf) * DTILEB; *(LAS u32x4*)(bb_ + kdst) = rk0; *(LAS u32x4*)(bb_ + KTB + kdst) = rk1; } while (0)
#define DSTOREV(buf) do { LAS unsigned char* bb_ = lds + (buf) * DTILEB; *(LAS u32x4*)(bb_ + 2 * KTB + kdst) = rv0; *(LAS u32x4*)(bb_ + 2 * KTB + 64 * TSB + kdst) = rv1; } while (0)
    const bf16_t* qsrc = DQ + ((size_t)((b * 8 + h) * 2 + p) * NKEY + q0 + qg * 32 + r32) * 64 + hi * 8;
    bf16x8 qf[4];
#pragma unroll
    for (int d0 = 0; d0 < 4; ++d0) qf[d0] = *(const bf16x8*)(qsrc + d0 * 16);
    LAS unsigned char* qlds = lds + 3 * DTILEB + 1024 + wid * 4096 + lane * 16;
#pragma unroll
    for (int d0 = 0; d0 < 4; ++d0) *(LAS bf16x8*)(qlds + d0 * 1024) = qf[d0];
    f32x16 o[4]; o[0] = (f32x16){}; o[1] = (f32x16){}; o[2] = (f32x16){}; o[3] = (f32x16){};
    float m = 0.f, l = 0.f;
    f32x16 negm = (f32x16){};
    bf16x8 pa[2][2];
    f32x16 s0, s1;
    DLOADK(t0); DSTOREK(2); DLOADK(t0 + 1); DLOADV(t0); DSTOREK(0); DSTOREV(0);
    __syncthreads();
    wave_qk(s0, s1, lds + 2 * DTILEB + p * KTB, qf, r32, hi);
    const int wsub = wid & 3;
    unsigned poff[5];
#pragma unroll
    for (int k = 0; k < 5; ++k) {
        const int B = (wsub + 4 * k) * 1024 + lane * 16;
        if (grp == 0) { const int pp = B >= KTB ? 1 : 0, Bp = B - pp * KTB, row = Bp / TSB; int col = Bp % TSB; if (col >= 128) col = 0;
            poff[k] = (unsigned)(pp * (NKEY * 128) + row * 128 + col); }
        else { const int row = B / TSB; int col = B % TSB; if (col >= 128) col = 0;
            poff[k] = (unsigned)(row * (NKEY * 2) + col); }
    }
    const char* dbase0 = (grp == 0) ? (const char*)(DK + ((size_t)((b * 8 + h) * 2) * NKEY) * 64) + (size_t)(t0 + 2) * 8192
                                    : (const char*)(DVt + ((size_t)((b * 8 + h) * 128) * NKEY)) + (size_t)(t0 + 1) * 128;
    const int dstride = grp == 0 ? 8192 : 128, gahead = 2 - grp;
    const unsigned ldsb = (unsigned)(size_t)(lds + (grp ? 2 * KTB : 0)) + wsub * 1024;
    auto STG = [&](const int e) __attribute__((always_inline)) {
        if (e + gahead < T) {
            const unsigned dbase = ldsb + (unsigned)(((e + 1) % 3) * DTILEB);
            const unsigned long long sb_ = (unsigned long long)(dbase0 + (size_t)e * dstride);
            const void* sbs = (const void*)(((unsigned long long)(unsigned)__builtin_amdgcn_readfirstlane((int)(sb_ >> 32)) << 32) | (unsigned)__builtin_amdgcn_readfirstlane((int)sb_));
#pragma unroll
            for (int k = 0; k < 4; ++k) glds16s(poff[k], sbs, (unsigned)__builtin_amdgcn_readfirstlane(dbase + k * 4096));
            if (wsub < 2) glds16s(poff[4], sbs, (unsigned)__builtin_amdgcn_readfirstlane(dbase + 16384));
        }
    };
    auto XH = [&](const int j) __attribute__((always_inline)) {
            {
                if (!(j & 1)) {
                asm volatile("s_nop 15\n\ts_nop 7" : "+v"(s0), "+v"(s1));
                float mxa = max3f(s0[0], s0[1], s1[0]), mxb = max3f(s0[2], s0[3], s1[1]); mxa = max3f(mxa, s1[2], s1[3]);
#pragma unroll
                for (int r = 4; r < 16; r += 4) { mxa = max3f(mxa, s0[r], s0[r + 1]); mxb = max3f(mxb, s0[r + 2], s0[r + 3]); mxa = max3f(mxa, s1[r], s1[r + 1]); mxb = max3f(mxb, s1[r + 2], s1[r + 3]); }
                float mx = max3f(mxa, mxb, mxb);
                { auto rr = __builtin_amdgcn_permlane32_swap(__float_as_uint(mx), __float_as_uint(mx), false, false); mx = max3f(__uint_as_float(rr[0]), __uint_as_float(rr[1]), __uint_as_float(rr[1])); }
                if (j == 0) {
                    m = mx;
#pragma unroll
                    for (int r = 0; r < 16; ++r) { s0[r] -= mx; s1[r] -= mx; negm[r] = -mx; }
                } else if (__any(mx > 8.f)) {
                    const float delta = fmaxf(mx, 0.f); const float alpha = __builtin_amdgcn_exp2f(-delta); m += delta; l *= alpha;
#pragma unroll
                    for (int r = 0; r < 16; ++r) { s0[r] -= delta; s1[r] -= delta; negm[r] = -m; }
                    if (hi == 0) scr[r32] = alpha;
                    LDS_WAIT();
#pragma unroll
                    for (int r = 0; r < 16; ++r) { const float a = scr[crow(r, hi)];
#pragma unroll
                        for (int db = 0; db < 4; ++db) o[db][r] *= a; }
                    LDS_WAIT();
                }
                }
                float ls = 0.f;
#pragma unroll
                for (int r = 0; r < 16; ++r) { s0[r] = __builtin_amdgcn_exp2f(s0[r]); s1[r] = __builtin_amdgcn_exp2f(s1[r]); }
                __builtin_amdgcn_sched_barrier(0);
                f32x2 la2 = {0.f, 0.f}, lb2 = {0.f, 0.f};
#pragma unroll
                for (int r = 0; r < 16; r += 2) {
                    const f32x2 pa2 = {s0[r], s0[r + 1]}, pb2 = {s1[r], s1[r + 1]};
                    asm("v_pk_add_f32 %0, %1, %2" : "=v"(la2) : "v"(la2), "v"(pa2));
                    asm("v_pk_add_f32 %0, %1, %2" : "=v"(lb2) : "v"(lb2), "v"(pb2));
                }
                l += (la2.x + la2.y) + (lb2.x + lb2.y) + ls;
#pragma unroll
                for (int s2 = 0; s2 < 2; ++s2) {
                    u32x4 w0, w1;
                    w0.x = cvtpk(s0[8 * s2 + 0], s0[8 * s2 + 1]); w0.y = cvtpk(s0[8 * s2 + 2], s0[8 * s2 + 3]); w0.z = cvtpk(s0[8 * s2 + 4], s0[8 * s2 + 5]); w0.w = cvtpk(s0[8 * s2 + 6], s0[8 * s2 + 7]);
                    w1.x = cvtpk(s1[8 * s2 + 0], s1[8 * s2 + 1]); w1.y = cvtpk(s1[8 * s2 + 2], s1[8 * s2 + 3]); w1.z = cvtpk(s1[8 * s2 + 4], s1[8 * s2 + 5]); w1.w = cvtpk(s1[8 * s2 + 6], s1[8 * s2 + 7]);
                    pa[0][s2] = __builtin_bit_cast(bf16x8, w0); pa[1][s2] = __builtin_bit_cast(bf16x8, w1);
                }
            }
    };
    auto YH = [&](const int j) __attribute__((always_inline)) {
            {
                const LAS unsigned char* bb = lds + (j % 3) * DTILEB;
                const LAS unsigned char* Vt = bb + 2 * KTB + r32 * TSB + hi * 16;
                const LAS unsigned char* Kt = bb + p * KTB + r32 * TSB + hi * 16;
                const bool more = (j + 1 < T);
                bf16x8 fa[4], fb[4];
#define VLD(dst, db) do { _Pragma("unroll") for (int pp = 0; pp < 2; ++pp) _Pragma("unroll") for (int s2 = 0; s2 < 2; ++s2) \
                        dst[pp * 2 + s2] = *(const LAS bf16x8*)(Vt + (db) * 32 * TSB + (32 * pp + 16 * s2) * 2); } while (0)
#define KLD(dst, dh) do { _Pragma("unroll") for (int dd = 0; dd < 2; ++dd) { dst[dd * 2] = *(const LAS bf16x8*)(Kt + ((dh) * 2 + dd) * 32); \
                        dst[dd * 2 + 1] = *(const LAS bf16x8*)(Kt + 32 * TSB + ((dh) * 2 + dd) * 32); } } while (0)
#define PVM(src, db) do { _Pragma("unroll") for (int pp = 0; pp < 2; ++pp) _Pragma("unroll") for (int s2 = 0; s2 < 2; ++s2) \
                        o[db] = __builtin_amdgcn_mfma_f32_32x32x16_bf16(pa[pp][s2], src[pp * 2 + s2], o[db], 0, 0, 0); } while (0)
#define QKM(src, dh) do { _Pragma("unroll") for (int dd = 0; dd < 2; ++dd) { s0 = __builtin_amdgcn_mfma_f32_32x32x16_bf16(src[dd * 2], qf[(dh) * 2 + dd], s0, 0, 0, 0); \
                        s1 = __builtin_amdgcn_mfma_f32_32x32x16_bf16(src[dd * 2 + 1], qf[(dh) * 2 + dd], s1, 0, 0, 0); } } while (0)
#define FENCE() do { asm volatile("" ::: "memory"); __builtin_amdgcn_sched_barrier(0); } while (0)
                VLD(fa, 0); FENCE();
                __builtin_amdgcn_s_setprio(1);
                VLD(fb, 1); FENCE(); PVM(fa, 0); FENCE();
                VLD(fa, 2); FENCE(); PVM(fb, 1); FENCE();
                VLD(fb, 3); FENCE(); PVM(fa, 2); FENCE();
                if (more) {
                    bf16x8 q0 = qf[0], q1 = qf[1];
                    KLD(fa, 0); FENCE(); PVM(fb, 3); FENCE();
                    KLD(fb, 1); FENCE();
                    s0 = __builtin_amdgcn_mfma_f32_32x32x16_bf16(fa[0], q0, negm, 0, 0, 0); s1 = __builtin_amdgcn_mfma_f32_32x32x16_bf16(fa[1], q0, negm, 0, 0, 0);
                    s0 = __builtin_amdgcn_mfma_f32_32x32x16_bf16(fa[2], q1, s0, 0, 0, 0);   s1 = __builtin_amdgcn_mfma_f32_32x32x16_bf16(fa[3], q1, s1, 0, 0, 0);
                    q0 = qf[2]; q1 = qf[3];
                    FENCE();
                    s0 = __builtin_amdgcn_mfma_f32_32x32x16_bf16(fb[0], q0, s0, 0, 0, 0); s1 = __builtin_amdgcn_mfma_f32_32x32x16_bf16(fb[1], q0, s1, 0, 0, 0);
                    s0 = __builtin_amdgcn_mfma_f32_32x32x16_bf16(fb[2], q1, s0, 0, 0, 0); s1 = __builtin_amdgcn_mfma_f32_32x32x16_bf16(fb[3], q1, s1, 0, 0, 0);
                } else { PVM(fb, 3); }
                __builtin_amdgcn_s_setprio(0);
#undef VLD
#undef KLD
#undef PVM
#undef QKM
#undef FENCE
            }
    };
    if (grp == 0) {
        for (int j = 0; j < T; ++j) { STG(j); XH(j); __builtin_amdgcn_sched_barrier(0); YH(j); LBARV(); __builtin_amdgcn_sched_barrier(0); }
        LBARV();
    } else {
        STG(0); XH(0); LBARV(); __builtin_amdgcn_sched_barrier(0);
        for (int j = 1; j < T; ++j) { STG(j); YH(j - 1); __builtin_amdgcn_sched_barrier(0); XH(j); LBARV(); __builtin_amdgcn_sched_barrier(0); }
        YH(T - 1); LBARV();
    }
#undef DLOADK
#undef DLOADV
#undef DSTOREK
#undef DSTOREV
    {
        const float lt = xhalf_sum(l); const float inv = 1.f / lt; const float coef = p ? -lam * inv : inv;
        if (hi == 0) scr[r32] = coef;
        LDS_WAIT();
#pragma unroll
        for (int r = 0; r < 16; ++r) { const float a = scr[crow(r, hi)];
#pragma unroll
            for (int db = 0; db < 4; ++db) o[db][r] *= a; }
        LDS_WAIT();
    }
    LAS float* stage = (LAS float*)lds;
    if (p == 1) {
#pragma unroll
        for (int r = 0; r < 16; ++r)
#pragma unroll
            for (int db = 0; db < 4; ++db) stage[(qg * 32 + crow(r, hi)) * 128 + db * 32 + r32] = o[db][r];
    }
    __syncthreads();
    if (p == 0) {
#pragma unroll
        for (int r = 0; r < 16; ++r)
#pragma unroll
            for (int db = 0; db < 4; ++db) { const int idx = (qg * 32 + crow(r, hi)) * 128 + db * 32 + r32; stage[idx] = stage[idx] + o[db][r]; }
    }
    __syncthreads();
    const float g0 = gnorm[lane], g1 = gnorm[64 + lane];
    for (int i = 0; i < 16; ++i) {
        const int row = wid * 16 + i;
        const float v0 = stage[row * 128 + lane], v1 = stage[row * 128 + 64 + lane];
        const float ss = wave_sum(v0 * v0 + v1 * v1);
        const float rs = rsqrtf(ss * (1.f / 128.f) + EPS) * oscale;
        bf16_t* dst = MIX + (size_t)prow(b, q0 + row) * D + 1024 + h * 128;
        dst[lane] = (bf16_t)f2bf(v0 * rs * g0); dst[64 + lane] = (bf16_t)f2bf(v1 * rs * g1);
    }
    __syncthreads();
}

constexpr int NHB = 2 * KTB;
__device__ __forceinline__ void na_unit(LAS unsigned char* lds, const bf16_t* P, const bf16_t* NAVt, bf16_t* MIX, const float* relb, int b, int hg, int qblk) {
    const int tid = otid(), lane = tid & 63, wid = __builtin_amdgcn_readfirstlane(tid >> 6), r32 = lane & 31, hi = lane >> 5;
    const int hh = wid >> 1, qg = wid & 1, head = hg * 4 + hh;
    const bool isctx = qblk >= 256;
    const int n0q = isctx ? SEQ + (qblk - 256) * 64 : qblk * 64;
    const int kr0 = isctx ? 0 : min(max(qblk - 4, 0), 248);
    const int NT = isctx ? 4 : 12;
#define NTILE_OF(i) (isctx ? 256 + (i) : ((i) < 4 ? 256 + (i) : kr0 + (i) - 4))
    LAS float* biasL = (LAS float*)(lds + 4 * NHB);
    LAS float* scr = (LAS float*)(lds + 4 * NHB + 7680) + wid * 32;
    for (int i = tid; i < 4 * 15 * 32; i += 512) { const int hh_ = i / 480, rem = i % 480, dr_ = rem >> 5, dc_ = rem & 31;
        biasL[i] = dc_ < 31 ? relb[(hg * 4 + hh_) * 465 + dr_ * 31 + dc_] * LOG2E : -1e30f; }
    unsigned boff0[4] = {0u, 0u, 0u, 0u}, boff1[4] = {0u, 0u, 0u, 0u};
    { const int qc = qg * 32 + r32, c0 = min(max(qc - 8, 0), 48);
#pragma unroll
      for (int r = 0; r < 16; ++r) { const int kc0 = crow(r, hi), kc1 = kc0 + 32;
          boff0[r >> 2] |= (unsigned)(((kc0 >= c0 && kc0 < c0 + 16) ? (kc0 - qc + 15) : 31) * 4) << (8 * (r & 3));
          boff1[r >> 2] |= (unsigned)(((kc1 >= c0 && kc1 < c0 + 16) ? (kc1 - qc + 15) : 31) * 4) << (8 * (r & 3)); } }
    const bf16_t* qsrc = P + (size_t)prow(b, n0q + qg * 32 + r32) * INWP + head * 64 + hi * 8;
    bf16x8 qf[4];
#pragma unroll
    for (int d0 = 0; d0 < 4; ++d0) qf[d0] = *(const bf16x8*)(qsrc + d0 * 16);
    const int kdst = (tid >> 3) * TSB + (tid & 7) * 16;
    u32x4 rk[4], rv[4];
#define NLOAD(tile) do { const int n0_ = (tile) * 64; const bf16_t* kp_ = P + (size_t)prow(b, n0_ + (tid >> 3)) * INWP + 512 + hg * 256 + (tid & 7) * 8; \
        const bf16_t* vp_ = NAVt + ((size_t)((b * 8 + hg * 4) * 64 + (tid >> 3)) * NKEY) + n0_ + (tid & 7) * 8; \
        _Pragma("unroll") for (int j = 0; j < 4; ++j) { rk[j] = *(const u32x4*)(kp_ + j * 64); rv[j] = *(const u32x4*)(vp_ + (size_t)j * 64 * NKEY); } } while (0)
#define NSTORE() do { _Pragma("unroll") for (int j = 0; j < 4; ++j) { *(LAS u32x4*)(lds + j * NHB + kdst) = rk[j]; *(LAS u32x4*)(lds + j * NHB + KTB + kdst) = rv[j]; } } while (0)
    f32x16 o[2]; o[0] = (f32x16){}; o[1] = (f32x16){};
    float m = -1e30f, l = 0.f;
    NLOAD(NTILE_OF(0));
    for (int i = 0; i < NT; ++i) {
        NSTORE(); __syncthreads();
        const int tl = NTILE_OF(i);
        if (i + 1 < NT) NLOAD(NTILE_OF(i + 1));
        f32x16 s0, s1;
        wave_qk(s0, s1, lds + hh * NHB, qf, r32, hi);
        if (tl < 256) {
            const LAS unsigned char* bl = (const LAS unsigned char*)biasL + hh * 1920 + (tl - qblk + 7) * 128;
#pragma unroll
            for (int r = 0; r < 16; ++r) {
                s0[r] = s0[r] * C2 + *(const LAS float*)(bl + ((boff0[r >> 2] >> (8 * (r & 3))) & 0xffu));
                s1[r] = s1[r] * C2 + *(const LAS float*)(bl + ((boff1[r >> 2] >> (8 * (r & 3))) & 0xffu));
            }
        } else {
#pragma unroll
            for (int r = 0; r < 16; ++r) { s0[r] *= C2; s1[r] *= C2; }
        }
        wave_softmax_pv<2, false>(s0, s1, o, m, l, lds + hh * NHB + KTB, scr, r32, hi);
        __syncthreads();
    }
#undef NLOAD
#undef NSTORE
#undef NTILE_OF
    {
        const float lt = xhalf_sum(l); const float inv = 1.f / lt;
        if (hi == 0) scr[r32] = inv;
        LDS_WAIT();
#pragma unroll
        for (int r = 0; r < 16; ++r) { const float a = scr[crow(r, hi)];
            bf16_t* dst = MIX + (size_t)prow(b, n0q + qg * 32 + crow(r, hi)) * D + head * 64 + r32;
            dst[0] = (bf16_t)f2bf(o[0][r] * a); dst[32] = (bf16_t)f2bf(o[1][r] * a); }
        LDS_WAIT();
    }
    __syncthreads();
}

__device__ __forceinline__ void rope_rows(const Params& p) {
    const bf16_t* P = (const bf16_t*)(p.ws + WS_P); bf16_t* DQ = (bf16_t*)(p.ws + WS_DQ); bf16_t* DK = (bf16_t*)(p.ws + WS_DK);
    const int tid = otid(), rsel = tid >> 8, hp = (tid >> 4) & 15, i2 = (tid & 15) * 2;
    const float inv0 = __builtin_amdgcn_exp2f(-(float)(i2 & 15) * (13.287712379549449f / 16.f));
    const float inv1 = __builtin_amdgcn_exp2f(-(float)((i2 + 1) & 15) * (13.287712379549449f / 16.f));
    for (int m0 = obid() * 8; m0 < MTOT; m0 += gridDim.x * 8) {
        unsigned q1[4], q2[4], k1[4], k2[4];
#pragma unroll
        for (int r = 0; r < 4; ++r) { const bf16_t* src = P + (size_t)(m0 + 2 * r + rsel) * INWP + DIFF_OFF + hp * 64 + i2;
            q1[r] = *(const unsigned*)src; q2[r] = *(const unsigned*)(src + 32); k1[r] = *(const unsigned*)(src + 1024); k2[r] = *(const unsigned*)(src + 1024 + 32); }
#pragma unroll
        for (int r = 0; r < 4; ++r) {
            const int m = m0 + 2 * r + rsel; int b, n; float cs0 = 1.f, sn0 = 0.f, cs1 = 1.f, sn1 = 0.f;
            if (m < MLAT) { b = m >> 14; const int t = m & (SEQ - 1); n = t; const float pos = (float)((i2 < 16) ? (t >> 6) : (t & 63));
                float rev0 = pos * inv0 * 0.15915494309189535f; rev0 -= rintf(rev0); sn0 = __builtin_amdgcn_sinf(rev0); cs0 = __builtin_amdgcn_cosf(rev0);
                float rev1 = pos * inv1 * 0.15915494309189535f; rev1 -= rintf(rev1); sn1 = __builtin_amdgcn_sinf(rev1); cs1 = __builtin_amdgcn_cosf(rev1); }
            else { b = (m - MLAT) >> 8; n = SEQ + ((m - MLAT) & 255); }
            const float qa0 = bf2f(q1[r] & 0xffffu), qa1 = bf2f(q1[r] >> 16), qb0 = bf2f(q2[r] & 0xffffu), qb1 = bf2f(q2[r] >> 16);
            const float ka0 = bf2f(k1[r] & 0xffffu), ka1 = bf2f(k1[r] >> 16), kb0 = bf2f(k2[r] & 0xffffu), kb1 = bf2f(k2[r] >> 16);
            const size_t dst = ((size_t)(b * 16 + hp) * NKEY + n) * 64 + i2;
            *(unsigned*)(DQ + dst) = pk2((qa0 * cs0 - qb0 * sn0) * C2, (qa1 * cs1 - qb1 * sn1) * C2);
            *(unsigned*)(DQ + dst + 32) = pk2((qa0 * sn0 + qb0 * cs0) * C2, (qa1 * sn1 + qb1 * cs1) * C2);
            *(unsigned*)(DK + dst) = pk2(ka0 * cs0 - kb0 * sn0, ka1 * cs1 - kb1 * sn1);
            *(unsigned*)(DK + dst + 32) = pk2(ka0 * sn0 + kb0 * cs0, ka1 * sn1 + kb1 * cs1);
        }
    }
}
template <int DV>
__device__ __forceinline__ void vtrans_item(LAS unsigned char* lds, const bf16_t* P, int colbase, bf16_t* Vt, int b, int hh, int tile) {
    constexpr int ST = DV + 2;
    LAS bf16_t* L = (LAS bf16_t*)lds;
    const int tid = otid();
    constexpr int CPR = DV / 8;
#pragma unroll
    for (int j = 0; j < (64 * CPR) / 512; ++j) {
        const int c = tid + 512 * j, key = c / CPR, ch = c % CPR;
        const u32x4 raw = *(const u32x4*)(P + (size_t)prow(b, tile * 64 + key) * INWP + colbase + hh * DV + ch * 8);
        LAS unsigned* d = (LAS unsigned*)(L + key * ST + ch * 8);
        d[0] = raw.x; d[1] = raw.y; d[2] = raw.z; d[3] = raw.w;
    }
    __syncthreads();
    if (tid < DV * 4) {
        const int d = tid >> 2, pg = tid & 3;
        unsigned w[8];
#pragma unroll
        for (int j2 = 0; j2 < 8; ++j2) {
            const int ja = 2 * j2, jb = 2 * j2 + 1;
            const int ka = 16 * pg + ((ja & 3) | ((ja & 4) << 1) | ((ja & 8) >> 1)), kb = 16 * pg + ((jb & 3) | ((jb & 4) << 1) | ((jb & 8) >> 1));
            w[j2] = (unsigned)L[ka * ST + d] | ((unsigned)L[kb * ST + d] << 16);
        }
        bf16_t* dst = Vt + ((size_t)((b * 8 + hh) * DV + d) * NKEY) + tile * 64 + 16 * pg;
        *(u32x4*)dst = (u32x4){w[0], w[1], w[2], w[3]}; *(u32x4*)(dst + 8) = (u32x4){w[4], w[5], w[6], w[7]};
    }
    __syncthreads();
}

template <int DV>
__device__ __forceinline__ void vtrans_loop(LAS unsigned char* lds, const bf16_t* P, int colbase, bf16_t* Vt, int bx, int G) {
    constexpr int ST = DV + 2, CPR = DV / 8, NCH = (64 * CPR) / 512, NITEMS = NB * 8 * NTILE;
    LAS bf16_t* L = (LAS bf16_t*)lds;
    const int tid = otid();
    u32x4 nx[NCH];
#define VT_LOAD(it_) do { const int b_ = (it_) / (8 * NTILE), hh_ = ((it_) / NTILE) % 8, tile_ = (it_) % NTILE; \
        _Pragma("unroll") for (int j = 0; j < NCH; ++j) { const int c = tid + 512 * j, key = c / CPR, ch = c % CPR; \
            nx[j] = *(const u32x4*)(P + (size_t)prow(b_, tile_ * 64 + key) * INWP + colbase + hh_ * DV + ch * 8); } } while (0)
    int it = bx;
    if (it < NITEMS) VT_LOAD(it);
    for (; it < NITEMS; it += G) {
        const int b = it / (8 * NTILE), hh = (it / NTILE) % 8, tile = it % NTILE;
#pragma unroll
        for (int j = 0; j < NCH; ++j) { const int c = tid + 512 * j, key = c / CPR, ch = c % CPR;
            LAS unsigned* d = (LAS unsigned*)(L + key * ST + ch * 8);
            d[0] = nx[j].x; d[1] = nx[j].y; d[2] = nx[j].z; d[3] = nx[j].w; }
        if (it + G < NITEMS) VT_LOAD(it + G);
        __syncthreads();
        if (tid < DV * 4) {
            const int d = tid >> 2, pg = tid & 3;
            unsigned w[8];
#pragma unroll
            for (int j2 = 0; j2 < 8; ++j2) {
                const int ja = 2 * j2, jb = 2 * j2 + 1;
                const int ka = 16 * pg + ((ja & 3) | ((ja & 4) << 1) | ((ja & 8) >> 1)), kb = 16 * pg + ((jb & 3) | ((jb & 4) << 1) | ((jb & 8) >> 1));
                w[j2] = (unsigned)L[ka * ST + d] | ((unsigned)L[kb * ST + d] << 16);
            }
            bf16_t* dst = Vt + ((size_t)((b * 8 + hh) * DV + d) * NKEY) + tile * 64 + 16 * pg;
            *(u32x4*)dst = (u32x4){w[0], w[1], w[2], w[3]}; *(u32x4*)(dst + 8) = (u32x4){w[4], w[5], w[6], w[7]};
        }
        __syncthreads();
    }
#undef VT_LOAD
}

__device__ __forceinline__ float logsig16(float x) { return (fminf(x, 0.f) - __logf(1.f + __expf(-fabsf(x)))) * (1.f / 16.f); }
__device__ __forceinline__ void gla_gates(LAS unsigned char* lds, const bf16_t* P, const float* wg, const float* bg, int b, int c, int h) {
    LAS float* la = (LAS float*)lds; LAS float* aL = (LAS float*)(lds + 33280);
    const int tid = otid();
    {
        const int t = tid >> 3, q4 = (tid & 7) * 4;
        const u32x2 raw = *(const u32x2*)(P + (size_t)prow(b, c * 64 + t) * INWP + GLA_OFF + 1536 + q4);
        LAS float* dst = aL + ((q4 >> 4) * 64 + t) * 16 + (q4 & 15);
        dst[0] = bf2f(raw.x & 0xffffu); dst[1] = bf2f(raw.x >> 16); dst[2] = bf2f(raw.y & 0xffffu); dst[3] = bf2f(raw.y >> 16);
    }
    const int d = tid & 63, tq = tid >> 6;
    float w0[16], w1[16];
#pragma unroll
    for (int r = 0; r < 16; ++r) { w0[r] = wg[r * 256 + h * 64 + d]; w1[r] = wg[(16 + r) * 256 + h * 64 + d]; }
    const float b0 = bg[h * 64 + d], b1 = bg[256 + h * 64 + d];
    __syncthreads();
#pragma unroll
    for (int tt = 0; tt < 8; ++tt) {
        const int t = tq * 8 + tt;
        float p0 = b0, p1 = b1;
#pragma unroll
        for (int r4 = 0; r4 < 4; ++r4) {
            const f32x4 a0 = *(const LAS f32x4*)(aL + t * 16 + r4 * 4), a1 = *(const LAS f32x4*)(aL + (64 + t) * 16 + r4 * 4);
            p0 += a0.x * w0[r4 * 4] + a0.y * w0[r4 * 4 + 1] + a0.z * w0[r4 * 4 + 2] + a0.w * w0[r4 * 4 + 3];
            p1 += a1.x * w1[r4 * 4] + a1.y * w1[r4 * 4 + 1] + a1.z * w1[r4 * 4 + 2] + a1.w * w1[r4 * 4 + 3];
        }
        la[t * 65 + d] = logsig16(p0); la[4160 + t * 65 + d] = logsig16(p1);
    }
    __syncthreads();
    {
        const int cz = (tid >> 6) & 1, seg = tid >> 7; LAS float* col = la + cz * 4160 + (tid & 63);
        float v[16];
#pragma unroll
        for (int i = 0; i < 16; ++i) v[i] = col[(seg * 16 + i) * 65];
        if (cz == 0) {
#pragma unroll
            for (int i = 1; i < 16; ++i) v[i] += v[i - 1];
        } else {
#pragma unroll
            for (int i = 14; i >= 0; --i) v[i] += v[i + 1];
        }
        LAS float* tot = aL + (tid & 127);
        tot[seg * 128] = cz == 0 ? v[15] : v[0];
        __syncthreads();
        float off = 0.f;
#pragma unroll
        for (int q = 0; q < 4; ++q) { const float tq_ = tot[q * 128]; off += ((cz == 0) ? (q < seg) : (q > seg)) ? tq_ : 0.f; }
#pragma unroll
        for (int i = 0; i < 16; ++i) col[(seg * 16 + i) * 65] = v[i] + off;
    }
    __syncthreads();
}
__device__ __forceinline__ void gla_g1_item(LAS unsigned char* lds, const bf16_t* P, const float* wg, const float* bg, float* GS, float* GD, int b, int c, int h) {
    gla_gates(lds, P, wg, bg, b, c, h);
    const LAS float* la = (const LAS float*)lds; LAS float* kd = (LAS float*)(lds + 41472); LAS float* vL = (LAS float*)(lds + 74240);
    const int tid = otid();
    {   const int t = tid >> 3, ch = tid & 7;
        const u32x4 rk = *(const u32x4*)(P + (size_t)prow(b, c * 64 + t) * INWP + GLA_OFF + 256 + h * 64 + ch * 8);
        u32x4 rv[2];
#pragma unroll
        for (int jj = 0; jj < 2; ++jj) { const int cc_ = tid + 512 * jj; rv[jj] = *(const u32x4*)(P + (size_t)prow(b, c * 64 + (cc_ >> 4)) * INWP + GLA_OFF + 512 + h * 128 + (cc_ & 15) * 8); }
        const unsigned kw[4] = {rk.x, rk.y, rk.z, rk.w};
#pragma unroll
        for (int e = 0; e < 8; ++e) { const int d = ch * 8 + e; const float k = bf2f((e & 1) ? (kw[e >> 1] >> 16) : (kw[e >> 1] & 0xffffu));
            kd[t * 64 + d] = k * __expf(la[63 * 65 + d] - la[t * 65 + d]);
            kd[4096 + t * 64 + d] = k * __expf(la[4160 + d] - la[4160 + t * 65 + d]); }
#pragma unroll
        for (int jj = 0; jj < 2; ++jj) { const int cc_ = tid + 512 * jj; LAS float* dv = vL + (cc_ >> 4) * 128 + (cc_ & 15) * 8;
            *(LAS f32x4*)dv = (f32x4){bf2f(rv[jj].x & 0xffffu), bf2f(rv[jj].x >> 16), bf2f(rv[jj].y & 0xffffu), bf2f(rv[jj].y >> 16)};
            *(LAS f32x4*)(dv + 4) = (f32x4){bf2f(rv[jj].z & 0xffffu), bf2f(rv[jj].z >> 16), bf2f(rv[jj].w & 0xffffu), bf2f(rv[jj].w >> 16)}; }
    }
    __syncthreads();
    const int v = tid & 127, dg = tid >> 7;
    f32x4 af4[4], ab4[4];
#pragma unroll
    for (int i = 0; i < 4; ++i) { af4[i] = (f32x4){0.f, 0.f, 0.f, 0.f}; ab4[i] = (f32x4){0.f, 0.f, 0.f, 0.f}; }
    for (int t = 0; t < 64; ++t) {
        const float vs = vL[t * 128 + v];
#pragma unroll
        for (int q = 0; q < 4; ++q) {
            const f32x4 kf = *(const LAS f32x4*)(kd + t * 64 + dg * 16 + q * 4), kb = *(const LAS f32x4*)(kd + 4096 + t * 64 + dg * 16 + q * 4);
            af4[q] += kf * vs; ab4[q] += kb * vs;
        }
    }
    float* gf = GS + ((size_t)((b * 2 + 0) * 4 + h) * NTILE + c) * 8192 + (dg * 16) * 128 + v;
    float* gb = GS + ((size_t)((b * 2 + 1) * 4 + h) * NTILE + c) * 8192 + (dg * 16) * 128 + v;
#pragma unroll
    for (int i = 0; i < 16; ++i) { gf[i * 128] = af4[i >> 2][i & 3]; gb[i * 128] = ab4[i >> 2][i & 3]; }
    if (tid < 128) { const int z = tid >> 6, d = tid & 63;
        GD[((size_t)((b * 2 + z) * 4 + h) * NTILE + c) * 64 + d] = __expf(z == 0 ? la[63 * 65 + d] : la[4160 + d]); }
    __syncthreads();
}
__device__ __forceinline__ void gla_scan(float* GS, const float* GD) {
    for (int gid = obid() * 512 + otid(); gid < 16 * 8192; gid += gridDim.x * 512) {
        const int v = gid & 127, d = (gid >> 7) & 63, chain = gid >> 13, z = (chain >> 2) & 1;
        float* gs = GS + (size_t)chain * NTILE * 8192 + d * 128 + v; const float* gd = GD + (size_t)chain * NTILE * 64 + d;
        float S = 0.f;
        for (int k0 = 0; k0 < NTILE; k0 += 10) {
            float L[10], Dc[10]; int cc[10];
#pragma unroll
            for (int j = 0; j < 10; ++j) { const int k = k0 + j; const int c = z ? (NTILE - 1 - k) : (k < 4 ? 256 + k : k - 4); cc[j] = c; L[j] = gs[(size_t)c * 8192]; Dc[j] = gd[c * 64]; }
#pragma unroll
            for (int j = 0; j < 10; ++j) { gs[(size_t)cc[j] * 8192] = S; S = Dc[j] * S + L[j]; }
        }
    }
}
__device__ __forceinline__ void gla_g3_item(LAS unsigned char* lds, const bf16_t* P, const float* wg, const float* bg, const float* GS, const float* gn, bf16_t* MIX, int b, int c, int h) {
    gla_gates(lds, P, wg, bg, b, c, h);
    const LAS float* la = (const LAS float*)lds;
    LAS float* QfT = (LAS float*)(lds + 41472); LAS float* QbT = (LAS float*)(lds + 57856);
    LAS float* KfT = (LAS float*)(lds + 74240); LAS float* KbT = (LAS float*)(lds + 90624);
    LAS float* VR = (LAS float*)(lds + 107008);
    LAS float* AT = (LAS float*)lds;
    LAS float* OL = KfT;
    const int tid = otid(), lane = tid & 63, wid = tid >> 6;
    {   const int t = tid >> 3, ch = tid & 7;
        const bf16_t* src = P + (size_t)prow(b, c * 64 + t) * INWP + GLA_OFF + h * 64 + ch * 8;
        const u32x4 rq = *(const u32x4*)src, rk = *(const u32x4*)(src + 256);
        LAS float* dq = VR + t * 65 + ch * 8; LAS float* dk = VR + 4160 + t * 65 + ch * 8;
        dq[0] = bf2f(rq.x & 0xffffu) * 0.125f; dq[1] = bf2f(rq.x >> 16) * 0.125f; dq[2] = bf2f(rq.y & 0xffffu) * 0.125f; dq[3] = bf2f(rq.y >> 16) * 0.125f;
        dq[4] = bf2f(rq.z & 0xffffu) * 0.125f; dq[5] = bf2f(rq.z >> 16) * 0.125f; dq[6] = bf2f(rq.w & 0xffffu) * 0.125f; dq[7] = bf2f(rq.w >> 16) * 0.125f;
        dk[0] = bf2f(rk.x & 0xffffu); dk[1] = bf2f(rk.x >> 16); dk[2] = bf2f(rk.y & 0xffffu); dk[3] = bf2f(rk.y >> 16);
        dk[4] = bf2f(rk.z & 0xffffu); dk[5] = bf2f(rk.z >> 16); dk[6] = bf2f(rk.w & 0xffffu); dk[7] = bf2f(rk.w >> 16); }
    __syncthreads();
    for (int idx = tid; idx < 4096; idx += 512) { const int t = idx & 63, d = idx >> 6;
        const float q = VR[t * 65 + d], k = VR[4160 + t * 65 + d], bp = la[t * 65 + d], bs = la[4160 + t * 65 + d];
        QfT[d * 64 + t] = q * __expf(bp); QbT[d * 64 + t] = q * __expf(bs); KfT[d * 64 + t] = k * __expf(-bp); KbT[d * 64 + t] = k * __expf(-bs); }
    __syncthreads();
#pragma unroll
    for (int jj = 0; jj < 2; ++jj) { const int cc_ = tid + 512 * jj, t = cc_ >> 4, ch = cc_ & 15;
        const u32x4 rv = *(const u32x4*)(P + (size_t)prow(b, c * 64 + t) * INWP + GLA_OFF + 512 + h * 128 + ch * 8);
        LAS float* dv = VR + t * 128 + ch * 8;
        *(LAS f32x4*)dv = (f32x4){bf2f(rv.x & 0xffffu), bf2f(rv.x >> 16), bf2f(rv.y & 0xffffu), bf2f(rv.y >> 16)};
        *(LAS f32x4*)(dv + 4) = (f32x4){bf2f(rv.z & 0xffffu), bf2f(rv.z >> 16), bf2f(rv.w & 0xffffu), bf2f(rv.w >> 16)}; }
    {
        const int t0 = 2 * (tid >> 4), s0 = 4 * (tid & 15);
        f32x4 af[2], ab[2];
#pragma unroll
        for (int i = 0; i < 2; ++i) { af[i] = (f32x4){0.f, 0.f, 0.f, 0.f}; ab[i] = (f32x4){0.f, 0.f, 0.f, 0.f}; }
        for (int d = 0; d < 64; ++d) {
            const f32x2 qf = *(const LAS f32x2*)(QfT + d * 64 + t0), qb = *(const LAS f32x2*)(QbT + d * 64 + t0);
            const f32x4 kf = *(const LAS f32x4*)(KfT + d * 64 + s0), kb = *(const LAS f32x4*)(KbT + d * 64 + s0);
#pragma unroll
            for (int i = 0; i < 2; ++i) { af[i] += kf * qf[i]; ab[i] += kb * qb[i]; }
        }
#pragma unroll
        for (int i = 0; i < 2; ++i)
#pragma unroll
            for (int j = 0; j < 4; ++j) { const int t = t0 + i, s = s0 + j; AT[s * 64 + t] = (s <= t) ? af[i][j] : ab[i][j]; }
    }
    __syncthreads();
    {
        const int v = tid & 127, tg = tid >> 7;
        f32x4 acc4[4];
#pragma unroll
        for (int i = 0; i < 4; ++i) acc4[i] = (f32x4){0.f, 0.f, 0.f, 0.f};
        const float* Sf = GS + ((size_t)((b * 2 + 0) * 4 + h) * NTILE + c) * 8192 + v; const float* Sb = GS + ((size_t)((b * 2 + 1) * 4 + h) * NTILE + c) * 8192 + v;
#define G3_LD(buf, d0) do { _Pragma("unroll") for (int k = 0; k < 4; ++k) { buf[k] = Sf[((d0) + k) * 128]; buf[4 + k] = Sb[((d0) + k) * 128]; } } while (0)
#define G3_FMA(buf, d0) do { _Pragma("unroll") for (int k = 0; k < 4; ++k) { const int d = (d0) + k; const float sf = buf[k], sb = buf[4 + k]; \
            _Pragma("unroll") for (int q = 0; q < 4; ++q) { \
                const f32x4 a = *(const LAS f32x4*)(QfT + d * 64 + tg * 16 + q * 4), bq = *(const LAS f32x4*)(QbT + d * 64 + tg * 16 + q * 4); \
                acc4[q] += a * sf + bq * sb; } } } while (0)
        {   float sA[8], sB[8];
            G3_LD(sA, 0);
            for (int d0 = 0; d0 < 64; d0 += 8) {
                G3_LD(sB, d0 + 4); asm volatile("" ::: "memory");
                G3_FMA(sA, d0);
                if (d0 + 8 < 64) G3_LD(sA, d0 + 8);
                asm volatile("" ::: "memory");
                G3_FMA(sB, d0 + 4);
            }
        }
#undef G3_LD
#undef G3_FMA
        for (int s = 0; s < 64; ++s) {
            const float vs = VR[s * 128 + v];
#pragma unroll
            for (int q = 0; q < 4; ++q) {
                const f32x4 a = *(const LAS f32x4*)(AT + s * 64 + tg * 16 + q * 4);
                acc4[q] += a * vs;
            }
        }
#pragma unroll
        for (int i = 0; i < 16; ++i) OL[(tg * 16 + i) * 128 + v] = acc4[i >> 2][i & 3];
    }
    __syncthreads();
    const float g0 = gn[lane], g1 = gn[64 + lane];
    for (int i = 0; i < 8; ++i) {
        const int t = wid * 8 + i;
        const float v0 = OL[t * 128 + lane], v1 = OL[t * 128 + 64 + lane];
        const float ss = wave_sum(v0 * v0 + v1 * v1);
        const float rs = rsqrtf(ss * (1.f / 128.f) + EPS);
        const size_t row = prow(b, c * 64 + t);
        const bf16_t* gp = P + row * INWP + GLA_OFF + 1024 + h * 128;
        const float ga = bf2f(gp[lane]), gb = bf2f(gp[64 + lane]);
        bf16_t* dst = MIX + row * D + 512 + h * 128;
        dst[lane] = (bf16_t)f2bf(v0 * rs * g0 * (ga / (1.f + __expf(-ga)))); dst[64 + lane] = (bf16_t)f2bf(v1 * rs * g1 * (gb / (1.f + __expf(-gb))));
    }
    __syncthreads();
}

#define XB_TMO      128
#define XB_XCNT(j)  (256  + 64 * (j))
#define XB_XSUB(j)  (1280 + 64 * (j))
#define XB_XGEN(j)  (2304 + 64 * (j))
#define XB_TOP      3328
#define XB_TOPGEN   3392
#define XCD_BAR_WORDS 3456
#define XB_SPIN_CAP (1u << 24)

__device__ __forceinline__ unsigned xb_ld(unsigned* p)              { return __hip_atomic_load(p, __ATOMIC_RELAXED, __HIP_MEMORY_SCOPE_AGENT); }
__device__ __forceinline__ unsigned xb_add(unsigned* p, unsigned v) { return __hip_atomic_fetch_add(p, v, __ATOMIC_RELAXED, __HIP_MEMORY_SCOPE_AGENT); }
__device__ __forceinline__ unsigned xb_xcc_id() { return (unsigned)__builtin_amdgcn_s_getreg((3 << 11) | 20) & 0xFu; }
#define XB_SPIN(cond, bar) do { unsigned _sp = 0; while (cond) { __builtin_amdgcn_s_sleep(1); \
    if ((++_sp & 255u) == 0u) { if (xb_ld(&(bar)[XB_TMO])) break; if (_sp > XB_SPIN_CAP) { atomicAdd(&(bar)[XB_TMO], 1u); break; } } } } while (0)

struct XcdBarrier {
    unsigned* bar; unsigned x;
    volatile LAS unsigned* st;
};

__device__ __forceinline__ XcdBarrier xcd_barrier_post(unsigned* bar, volatile LAS unsigned* st) {
    XcdBarrier b; b.bar = bar; b.x = xb_xcc_id(); b.st = st;
    if (threadIdx.x == 0) (void)xb_add(&bar[XB_XCNT(b.x)], 1u);
    return b;
}
__device__ __forceinline__ void xcd_barrier_complete(unsigned* bar, unsigned x, unsigned& nloc, unsigned& nx) {
    const unsigned G = gridDim.x * gridDim.y * gridDim.z;
    unsigned sum, cnt, mine, sp = 0u;
    for (;;) {
        sum = 0u; cnt = 0u; mine = 0u;
#pragma unroll
        for (unsigned j = 0; j < 16; ++j) { const unsigned c = xb_ld(&bar[XB_XCNT(j)]); sum += c; cnt += (c > 0u) ? 1u : 0u; mine = (j == x) ? c : mine; }
        if (sum == G) break;
        __builtin_amdgcn_s_sleep(1);
        if ((++sp & 255u) == 0u) { if (xb_ld(&bar[XB_TMO])) break; if (sp > XB_SPIN_CAP) { atomicAdd(&bar[XB_TMO], 1u); break; } }
    }
    nloc = mine > 0u ? mine : 1u; nx = cnt > 0u ? cnt : 1u;
}

__device__ __forceinline__ void xcd_barrier(const XcdBarrier& b) {
    asm volatile("s_waitcnt vmcnt(0)" ::: "memory");
    __syncthreads();
    if (threadIdx.x == 0) {
        unsigned* bar = b.bar;
        __builtin_amdgcn_s_waitcnt(0);
        unsigned nloc = b.st[0], nx = b.st[1];
        if (nloc == 0u) { xcd_barrier_complete(bar, b.x, nloc, nx); b.st[0] = nloc; b.st[1] = nx; }
        const unsigned old = xb_add(&bar[XB_XSUB(b.x)], 1u);
        const unsigned gen = old / nloc;
        if (old + 1u == (gen + 1u) * nloc) {
            __builtin_amdgcn_fence(__ATOMIC_RELEASE, "agent");
            asm volatile("s_waitcnt vmcnt(0)" ::: "memory");
            const unsigned og = xb_add(&bar[XB_TOP], 1u);
            const unsigned tg = og / nx;
            if (og + 1u == (tg + 1u) * nx) xb_add(&bar[XB_TOPGEN], 1u);
            else XB_SPIN(xb_ld(&bar[XB_TOPGEN]) == tg, bar);
            __builtin_amdgcn_fence(__ATOMIC_ACQUIRE, "agent");
            xb_add(&bar[XB_XGEN(b.x)], 1u);
            asm volatile("s_waitcnt vmcnt(0)" ::: "memory");
        } else {
            XB_SPIN(xb_ld(&bar[XB_XGEN(b.x)]) == gen, bar);
            __builtin_amdgcn_fence(__ATOMIC_ACQUIRE, "agent");
            asm volatile("s_waitcnt vmcnt(0)" ::: "memory");
        }
    }
    __syncthreads();
}

__global__ void __launch_bounds__(512) fwd_kernel(Params p) {
    extern __shared__ __attribute__((aligned(16))) unsigned char lds_raw[];
    LAS unsigned char* lds = (LAS unsigned char*)lds_raw;
    cg::grid_group grid = cg::this_grid();
    { const int t_ = otid(); if (t_ < 16) ((LAS unsigned*)(lds + LDS_BYTES - 64))[t_] = 0u; }
    __syncthreads();
    XcdBarrier xbar = xcd_barrier_post((unsigned*)p.ws, (volatile LAS unsigned*)(lds + LDS_BYTES - 64));
    const int G = gridDim.x, bx = obid();
    bf16_t* P = (bf16_t*)(p.ws + WS_P); bf16_t* MIX = (bf16_t*)(p.ws + WS_MIX); bf16_t* XN = (bf16_t*)(p.ws + WS_XN);
    bf16_t* YB = (bf16_t*)(p.ws + WS_YG); bf16_t* HB = (bf16_t*)(p.ws + WS_H);
    float* GS = (float*)(p.ws + WS_YG); float* GD = (float*)(p.ws + WS_GD);
    bf16_t* DQ = (bf16_t*)(p.ws + WS_DQ); bf16_t* DK = (bf16_t*)(p.ws + WS_DK); bf16_t* DVt = (bf16_t*)(p.ws + WS_DVT); bf16_t* NAVt = (bf16_t*)(p.ws + WS_NAVT);
    for (int ph = p.ph_lo; ph < p.ph_hi; ++ph) {
        bool is_gemm = false; pg8::Gemm g{nullptr, nullptr, 0, 0, 0}; pg8::EpiAct E{nullptr, 0, 0};
        if (ph == 0) { if (EN(0)) { ph_mod(p, lds); ph_wconv(p, lds, 0); } }
        else if (ph == 1) { if (EN(1)) row_pass(p, 0, 0); }
        else {
            const int l = (ph - 2) / 9, s = (ph - 2) % 9;
            const bool need_ctx = (l + 1 < DEPTH);
            const int Mpost = need_ctx ? MTOT : MLAT;
            if (s == 0) { is_gemm = true; g = pg8::Gemm{XN, (const bf16_t*)(p.ws + WS_WIN), MTOT, INWP, D}; E = pg8::EpiAct{P, INWP, 0}; }
            else if (s == 4) { is_gemm = true; g = pg8::Gemm{MIX, (const bf16_t*)(p.ws + WS_WOUT), Mpost, D, D}; E = pg8::EpiAct{YB, D, 0}; }
            else if (s == 6) { is_gemm = true; g = pg8::Gemm{XN, (const bf16_t*)(p.ws + WS_W1), Mpost, HID, D}; E = pg8::EpiAct{HB, HID, 1}; }
            else if (s == 7) { is_gemm = true; g = pg8::Gemm{HB, (const bf16_t*)(p.ws + WS_W2), Mpost, D, HID}; E = pg8::EpiAct{YB, D, 0}; }
            else if (s == 1 && EN(2)) {
                rope_rows(p);
                vtrans_loop<128>(lds, P, DIFF_OFF + 2048, DVt, bx, G);
                vtrans_loop<64>(lds, P, 1024, NAVt, bx, G);
                const float* wg = p.gla_w_gate + (size_t)l * 2 * 16 * 256; const float* bg = p.gla_b_gate + (size_t)l * 2 * 256;
                for (int it = bx; it < NB * NTILE * 4; it += G) { const int h = it & 3, c = (it >> 2) % NTILE, b = it / (4 * NTILE); gla_g1_item(lds, P, wg, bg, GS, GD, b, c, h); }
            }
            else if (s == 2 && EN(3)) {
                if (EN(11)) gla_scan(GS, GD);
                const float* relb = p.na_rel_bias + (size_t)l * 8 * 465;
                const int nq = need_ctx ? 260 : 256;
                if (EN(10)) for (int it = bx; it < NB * 2 * nq; it += G) { int hg, qblk, b;
                    if (it < NB * 2 * 256) {
                        if (G == 256) { const int u = (it >> 8) * 32 + (bx >> 3), x = bx & 7; hg = u & 1; qblk = (x & 3) * 64 + (u >> 1); b = x >> 2; }
                        else { hg = it & 1; qblk = (it >> 1) & 255; b = it >> 9; } }
                    else { const int r = it - NB * 2 * 256; hg = r & 1; qblk = 256 + ((r >> 1) & 3); b = r >> 3; }
                    na_unit(lds, P, NAVt, MIX, relb, b, hg, qblk); }
            }
            else if (s == 3 && EN(4)) {
                const float* wg = p.gla_w_gate + (size_t)l * 2 * 16 * 256; const float* bg = p.gla_b_gate + (size_t)l * 2 * 256;
                const int nc = need_ctx ? NTILE : 256;
                if (EN(8)) for (int it = bx; it < NB * nc * 4; it += G) { const int h = it & 3, c = (it >> 2) % nc, b = it / (4 * nc); gla_g3_item(lds, P, wg, bg, GS, p.gla_g_norm + l * 128, MIX, b, c, h); }
                const float* lp = p.diff_lambda + (size_t)l * 4 * 64;
                float d01 = 0.f, d23 = 0.f;
                for (int i = 0; i < 64; ++i) { d01 += lp[i] * lp[64 + i]; d23 += lp[128 + i] * lp[192 + i]; }
                const float lam_init = 0.8f - 0.6f * __expf(-0.3f * (float)l);
                const float lam = __expf(d01) - __expf(d23) + lam_init;
                const int nqb = need_ctx ? 130 : 128;
                if (EN(9)) for (int it = bx; it < NB * 8 * nqb; it += G) {
                    int qb, h, b;
                    if (it < NB * 8 * 128) { qb = it & 127; h = (it >> 7) & 7; b = it >> 10; }
                    else { const int r = it - NB * 8 * 128; qb = 128 + (r & 1); h = (r >> 1) & 7; b = r >> 4; }
                    const bool isctx = qb >= 128;
                    diff_unit(lds, DQ, DK, DVt, MIX, b, h, qb * 128, isctx ? 256 : 0, NTILE, lam, p.diff_g_norm + l * 128, 1.f - lam_init);
                }
            }
            else if (s == 5 && EN(5)) { row_pass(p, l, 1); }
            else if (s == 8 && EN(6)) { row_pass(p, l, 2); if (l + 1 < DEPTH) ph_wconv(p, lds, l + 1); }
        }
        if (is_gemm && EN(7)) { pg8::StaticOrder S; S.init(g.M, g.N, G, bx); pg8::gemm_phase<pg8::EpiAct, pg8::StaticOrder, true, true>(lds, g, S, E); }
        if (ph + 1 < p.ph_hi) { if (ph == 0) grid.sync(); else xcd_barrier(xbar); }
    }

}

extern "C" void kernel_launch(void* const* d_in, const int* in_sizes, int n_in, void* d_out, int out_size, void* d_ws, size_t ws_size, hipStream_t stream) {
    static int grid = 0;
    if (grid == 0) {
        if (n_in != 20 || in_sizes[0] != MLAT * D || out_size != MLAT * D || ws_size < WS_END) {
            fprintf(stderr, "kernel_launch: unexpected shapes (n_in %d, in0 %d, out %d, ws %zu); nothing launched\n", n_in, n_in > 0 ? in_sizes[0] : -1, out_size, ws_size); grid = -1; return; }
        int dev = 0, cus = 0, per_cu = 0;
        if (hipGetDevice(&dev) != hipSuccess || hipDeviceGetAttribute(&cus, hipDeviceAttributeMultiprocessorCount, dev) != hipSuccess) { grid = -1; return; }
        if (hipFuncSetAttribute((const void*)fwd_kernel, hipFuncAttributeMaxDynamicSharedMemorySize, LDS_BYTES) != hipSuccess) { fprintf(stderr, "kernel_launch: hipFuncSetAttribute failed\n"); grid = -1; return; }
        if (hipOccupancyMaxActiveBlocksPerMultiprocessor(&per_cu, (const void*)fwd_kernel, 512, LDS_BYTES) != hipSuccess || per_cu < 1) { fprintf(stderr, "kernel_launch: occupancy query gave %d\n", per_cu); per_cu = 1; }
        (void)hipGetLastError();
        grid = cus * per_cu;
    }
    if (grid < 0) return;
    (void)hipMemsetAsync(d_ws, 0, WS_ZERO_BYTES, stream);
    Params p{};
    const float** pp = (const float**)&p;
    for (int i = 0; i < 20; ++i) pp[i] = (const float*)d_in[i];
    p.out = (float*)d_out; p.ws = (unsigned char*)d_ws; p.ph_lo = 0; p.ph_hi = NPH;
    void* args[] = {&p};
    hipError_t e = hipLaunchCooperativeKernel((const void*)fwd_kernel, dim3(grid), dim3(512), args, LDS_BYTES, stream);
    if (e != hipSuccess) fprintf(stderr, "cooperative launch failed: %s (grid %d)\n", hipGetErrorString(e), grid);
}
```

```cpp
#include <hip/hip_runtime.h>
#include <hip/hip_cooperative_groups.h>
#include <cstdio>
#include <cstdint>
namespace cg = cooperative_groups;
__device__ __forceinline__ int otid() { int t = threadIdx.x; asm volatile("" : "+v"(t)); return t; }
__device__ __forceinline__ int obid() { int t = blockIdx.x; asm volatile("" : "+s"(t)); return t; }
namespace pg8 {
#define PG8_LAS __attribute__((address_space(3)))
typedef unsigned short bf16_t;
typedef short bf16x8 __attribute__((ext_vector_type(8)));
typedef float f32x4 __attribute__((ext_vector_type(4)));
typedef unsigned u32x4 __attribute__((ext_vector_type(4)));
constexpr int BM = 256, BK = 64, HALF = 128, HTB = HALF * BK * 2  , STAGE_BYTES = 8 * HTB, NXCD = 8, WGM = 4;

__host__ __device__ __forceinline__ int lds_byte(int r, int c) { const int st = (r >> 4) * 2 + (c >> 5), rr = r & 15, cc = c & 31, ob = rr * 64 + cc * 2; return st * 1024 + (ob ^ (((ob >> 9) & 1) << 5)); }
__host__ __device__ __forceinline__ void stage_rc(int b, int& R, int& C) { const int st = b / 1024, sb = b % 1024, swz = sb ^ (((sb >> 9) & 1) << 5); R = (st >> 1) * 16 + swz / 64; C = (st & 1) * 32 + (swz % 64) / 2; }
__host__ __device__ __forceinline__ int perm32(int rho) { const int n = rho >> 4, i = rho & 15; return 8 * (i >> 2) + 4 * n + (i & 3); }

struct Unit { int pm, pn; };
struct Gemm { const bf16_t* A; const bf16_t* Bt; int M, N, K; };

struct StaticOrder {
    int nM, nN, nwg, G, c;
    __host__ __device__ void init(int M, int N, int G_, int c_) { nM = M / BM; nN = N / BM; nwg = nM * nN; G = G_; c = c_; }
    __host__ __device__ bool next(int i, Unit& u) const {
        const long L = (long)i * G + c; if (L >= nwg) return false;
        int wgid = (int)L; { const int q = nwg / NXCD, r = nwg % NXCD, xcd = wgid % NXCD, off = wgid / NXCD; wgid = (xcd < r ? xcd * (q + 1) : r * (q + 1) + (xcd - r) * q) + off; }
        const int nig = WGM * nN, gid = wgid / nig, fm = gid * WGM, gsz = (nM - fm) < WGM ? (nM - fm) : WGM;
        u.pm = fm + ((wgid % nig) % gsz); u.pn = (wgid % nig) / gsz; return true;
    }
    __device__ __forceinline__ void a_ready(const Unit&) const {}
    __device__ __forceinline__ void done(const Unit&) const {}
};

__device__ __forceinline__ unsigned cvt_pk_bf16(float lo, float hi) { unsigned r; asm volatile("v_cvt_pk_bf16_f32 %0, %1, %2" : "=v"(r) : "v"(lo), "v"(hi)); return r; }
typedef float f32x2 __attribute__((ext_vector_type(2)));
struct EpiAct {
    static constexpr bool PERM = true, AFTER_DRAIN = false;
    bf16_t* O; int ldc; int act;
    __device__ __forceinline__ void operator()(const f32x4 (&acc)[2][2][4][2], const Unit& u, int wr, int wc, int fr, int fq) const {
        const int row0 = u.pm * BM + wr * 64 + fr; const int col0 = u.pn * BM + wc * 32 + 8 * fq;
#pragma unroll
        for (int ai = 0; ai < 2; ++ai)
#pragma unroll
            for (int m = 0; m < 4; ++m) { bf16_t* rowp = O + (size_t)(row0 + ai * HALF + m * 16) * ldc + col0;
#pragma unroll
                for (int bj = 0; bj < 2; ++bj) { f32x4 v0 = acc[ai][bj][m][0], v1 = acc[ai][bj][m][1];
                    if (act) {
#pragma unroll
                        for (int e = 0; e < 4; ++e) { float a = fmaxf(v0[e], 0.f), b = fmaxf(v1[e], 0.f); v0[e] = a * a; v1[e] = b * b; } }
                    u32x4 w; w.x = cvt_pk_bf16(v0[0], v0[1]); w.y = cvt_pk_bf16(v0[2], v0[3]); w.z = cvt_pk_bf16(v1[0], v1[1]); w.w = cvt_pk_bf16(v1[2], v1[3]);
                    *(u32x4*)(rowp + bj * HALF) = w; } }
    }
};
template <class Epi, class Sched, bool ALIGN_EPI = false, bool SP2 = false>
__device__ __forceinline__ void gemm_phase(PG8_LAS unsigned char* lds, const Gemm g, const Sched& S, const Epi& E) {
    const int tid = otid(), wid = __builtin_amdgcn_readfirstlane(tid >> 6), lane = tid & 63, wr = wid >> 2, wc = wid & 3, fr = lane & 15, fq = lane >> 4;
    const int K = g.K, nt = K / BK;
    unsigned voffA[2], voffB[2];
#pragma unroll
    for (int i = 0; i < 2; ++i) { int R, C; stage_rc(tid * 16 + i * 8192, R, C); const int Rb = Epi::PERM ? ((R & ~31) + perm32(R & 31)) : R;
        voffA[i] = (unsigned)(R * K + C) * 2u; voffB[i] = (unsigned)(Rb * K + C) * 2u; }
    const size_t kstep = (size_t)(BK * 2);
    const size_t hstep = (size_t)HALF * K * 2;
    const size_t tstep = 2 * hstep;
    const unsigned ldsw = (unsigned)wid * 1024u;
    const int aoff = lds_byte(wr * 64 + fr, fq * 8), boff = lds_byte(wc * 32 + fr, fq * 8);
#define PG8_SA(b, h) (((b) * 2 + (h)) * HTB)
#define PG8_SB(b, h) ((4 + (b) * 2 + (h)) * HTB)
#define PG8_STAGE(bufoff, gbase, voff) do { _Pragma("unroll") for (int _i = 0; _i < 2; ++_i) \
        __builtin_amdgcn_global_load_lds((const unsigned*)((const char*)(gbase) + (voff)[_i]), (PG8_LAS unsigned*)(lds + (bufoff) + ldsw + _i * 8192), 16, 0, 0); } while (0)
#define PG8_LDA(dst, b, h) do { _Pragma("unroll") for (int m = 0; m < 4; ++m) _Pragma("unroll") for (int k = 0; k < 2; ++k) dst[m][k] = *(const PG8_LAS bf16x8*)(lds + PG8_SA(b, h) + aoff + m * 2048 + k * 1024); } while (0)
#define PG8_LDB(dst, b, h) do { _Pragma("unroll") for (int n = 0; n < 2; ++n) _Pragma("unroll") for (int k = 0; k < 2; ++k) dst[n][k] = *(const PG8_LAS bf16x8*)(lds + PG8_SB(b, h) + boff + n * 2048 + k * 1024); } while (0)
#define PG8_MMA(ai, bj, At, Bt) do { __builtin_amdgcn_s_setprio(1); _Pragma("unroll") for (int m = 0; m < 4; ++m) _Pragma("unroll") for (int n = 0; n < 2; ++n) _Pragma("unroll") for (int k = 0; k < 2; ++k) \
        acc[ai][bj][m][n] = __builtin_amdgcn_mfma_f32_16x16x32_bf16(Bt[n][k], At[m][k], acc[ai][bj][m][n], 0, 0, 0); __builtin_amdgcn_s_setprio(0); } while (0)
#define PG8_WAIT_V(n) asm volatile("s_waitcnt vmcnt(" #n ")" ::: "memory")
#define PG8_WAIT_L(n) asm volatile("s_waitcnt lgkmcnt(" #n ")" ::: "memory")
#define PG8_BAR __builtin_amdgcn_s_barrier()
#define PG8_SCHED __builtin_amdgcn_sched_barrier(0)
    Unit cur, nxt; int ui = 0;
    if (!S.next(0, cur)) return;
    f32x4 acc[2][2][4][2];
#pragma unroll
    for (int a = 0; a < 2; ++a)
#pragma unroll
        for (int b = 0; b < 2; ++b)
#pragma unroll
            for (int m = 0; m < 4; ++m)
#pragma unroll
                for (int n = 0; n < 2; ++n) acc[a][b][m][n] = (f32x4){0.f, 0.f, 0.f, 0.f};
    bf16x8 At[4][2], B0[2][2], B1[2][2];
    const char* cA = (const char*)g.A + (size_t)cur.pm * tstep; const char* cB = (const char*)g.Bt + (size_t)cur.pn * tstep;
    S.a_ready(cur);
    if constexpr (SP2) {
        PG8_STAGE(PG8_SB(0, 0), cB, voffB); PG8_STAGE(PG8_SB(0, 1), cB + hstep, voffB); PG8_STAGE(PG8_SA(0, 0), cA, voffA); PG8_STAGE(PG8_SA(0, 1), cA + hstep, voffA);
        if (wr == 1) PG8_BAR;
        PG8_WAIT_V(2); PG8_BAR;
        PG8_STAGE(PG8_SB(1, 0), cB + kstep, voffB); PG8_STAGE(PG8_SA(1, 0), cA + kstep, voffA); PG8_STAGE(PG8_SB(1, 1), cB + hstep + kstep, voffB);
        PG8_WAIT_V(6); PG8_BAR;
    } else {
        PG8_STAGE(PG8_SB(0, 0), cB, voffB); PG8_STAGE(PG8_SA(0, 0), cA, voffA); PG8_STAGE(PG8_SB(0, 1), cB + hstep, voffB); PG8_STAGE(PG8_SA(0, 1), cA + hstep, voffA);
        if (wr == 1) PG8_BAR;
        PG8_WAIT_V(4); PG8_BAR;
        PG8_STAGE(PG8_SB(1, 0), cB + kstep, voffB); PG8_STAGE(PG8_SA(1, 0), cA + kstep, voffA); PG8_STAGE(PG8_SB(1, 1), cB + hstep + kstep, voffB);
        PG8_WAIT_V(6); PG8_BAR;
    }
    for (;;) {
        const bool has_next = S.next(ui + 1, nxt);
        const char* nA = has_next ? (const char*)g.A + (size_t)nxt.pm * tstep : cA; const char* nB = has_next ? (const char*)g.Bt + (size_t)nxt.pn * tstep : cB;
        for (int t = 0; t < nt; t += 2) {
            const bool last = (t == nt - 2);
            const char* a1 = cA + (size_t)(t + 1) * kstep;
            const char* a2 = last ? nA : cA + (size_t)(t + 2) * kstep; const char* b2 = last ? nB : cB + (size_t)(t + 2) * kstep;
            const char* a3 = a2 + kstep; const char* b3 = b2 + kstep;
            if (last && has_next) S.a_ready(nxt);
            if constexpr (SP2) {
            PG8_LDB(B0, 0, 0); PG8_LDB(B1, 0, 1); PG8_SCHED; PG8_LDA(At, 0, 0); PG8_STAGE(PG8_SA(1, 1), a1 + hstep, voffA);
            PG8_WAIT_V(8); PG8_WAIT_L(0); PG8_BAR; PG8_MMA(0, 0, At, B0); PG8_MMA(0, 1, At, B1); PG8_BAR; PG8_SCHED;
            PG8_LDA(At, 0, 1); PG8_STAGE(PG8_SB(0, 0), b2, voffB); PG8_STAGE(PG8_SB(0, 1), b2 + hstep, voffB); PG8_STAGE(PG8_SA(0, 0), a2, voffA);
            PG8_WAIT_V(8); PG8_WAIT_L(0); PG8_BAR; PG8_MMA(1, 0, At, B0); PG8_MMA(1, 1, At, B1); PG8_BAR; PG8_SCHED;
            PG8_LDB(B0, 1, 0); PG8_LDB(B1, 1, 1); PG8_SCHED; PG8_LDA(At, 1, 0); PG8_STAGE(PG8_SA(0, 1), a2 + hstep, voffA);
            PG8_WAIT_V(8); PG8_WAIT_L(0); PG8_BAR; PG8_MMA(0, 0, At, B0); PG8_MMA(0, 1, At, B1); PG8_BAR; PG8_SCHED;
            PG8_LDA(At, 1, 1); PG8_STAGE(PG8_SB(1, 0), b3, voffB); PG8_STAGE(PG8_SB(1, 1), b3 + hstep, voffB); PG8_STAGE(PG8_SA(1, 0), a3, voffA);
            PG8_WAIT_V(8); PG8_WAIT_L(0); PG8_BAR; PG8_MMA(1, 0, At, B0); PG8_MMA(1, 1, At, B1); PG8_BAR; PG8_SCHED;
            } else {
            PG8_LDB(B0, 0, 0); PG8_SCHED; PG8_LDA(At, 0, 0); PG8_STAGE(PG8_SA(1, 1), a1 + hstep, voffA);
            PG8_WAIT_L(8); PG8_BAR; PG8_WAIT_L(0); PG8_MMA(0, 0, At, B0); PG8_BAR; PG8_SCHED;
            PG8_LDB(B1, 0, 1); PG8_STAGE(PG8_SB(0, 0), b2, voffB);
            PG8_BAR; PG8_WAIT_L(0); PG8_MMA(0, 1, At, B1); PG8_BAR;
            PG8_LDA(At, 0, 1); PG8_STAGE(PG8_SA(0, 0), a2, voffA);
            PG8_BAR; PG8_WAIT_L(0); PG8_MMA(1, 0, At, B0); PG8_BAR; PG8_SCHED;
            PG8_STAGE(PG8_SB(0, 1), b2 + hstep, voffB);
            PG8_WAIT_V(6); PG8_BAR; PG8_MMA(1, 1, At, B1); PG8_BAR;
            PG8_LDB(B0, 1, 0); PG8_SCHED; PG8_LDA(At, 1, 0); PG8_STAGE(PG8_SA(0, 1), a2 + hstep, voffA);
            PG8_WAIT_L(8); PG8_BAR; PG8_WAIT_L(0); PG8_MMA(0, 0, At, B0); PG8_BAR; PG8_SCHED;
            PG8_LDB(B1, 1, 1); PG8_STAGE(PG8_SB(1, 0), b3, voffB);
            PG8_BAR; PG8_WAIT_L(0); PG8_MMA(0, 1, At, B1); PG8_BAR;
            PG8_LDA(At, 1, 1); PG8_STAGE(PG8_SA(1, 0), a3, voffA);
            PG8_BAR; PG8_WAIT_L(0); PG8_MMA(1, 0, At, B0); PG8_BAR; PG8_SCHED;
            PG8_STAGE(PG8_SB(1, 1), b3 + hstep, voffB);
            PG8_WAIT_V(6); PG8_BAR; PG8_MMA(1, 1, At, B1); PG8_BAR;
            }
        }
        if constexpr (ALIGN_EPI) { if (wr == 0) PG8_BAR; }
        if constexpr (!Epi::AFTER_DRAIN) { E(acc, cur, wr, wc, fr, fq); S.done(cur); }
        if (!has_next) break;
#pragma unroll
        for (int a = 0; a < 2; ++a)
#pragma unroll
            for (int b = 0; b < 2; ++b)
#pragma unroll
                for (int m = 0; m < 4; ++m)
#pragma unroll
                    for (int n = 0; n < 2; ++n) acc[a][b][m][n] = (f32x4){0.f, 0.f, 0.f, 0.f};
        cur = nxt; cA = nA; cB = nB; ++ui;
        if constexpr (ALIGN_EPI) { if (wr == 1) PG8_BAR; }
    }
    PG8_WAIT_V(0);
    if constexpr (!ALIGN_EPI) { if (wr == 0) PG8_BAR; }
    PG8_BAR;
    if constexpr (Epi::AFTER_DRAIN) { E.fused(acc, cur, wr, wc, fr, fq, lds, wid, lane); S.done(cur); }
#undef PG8_SA
#undef PG8_SB
#undef PG8_STAGE
#undef PG8_LDA
#undef PG8_LDB
#undef PG8_MMA
#undef PG8_WAIT_V
#undef PG8_WAIT_L
#undef PG8_BAR
#undef PG8_SCHED
}
}
constexpr int D = 2048, NB = 2, SEQ = 16384, NCTX = 256, DEPTH = 2;
constexpr int MLAT = NB * SEQ, MCTX = NB * NCTX, MTOT = MLAT + MCTX;
constexpr int INW = 6176, INWP = 6400, HID = 8192;
constexpr int NKEY = SEQ + NCTX;
constexpr int NTILE = NKEY / 64;
constexpr int GLA_OFF = 1536, DIFF_OFF = 3104;
constexpr float EPS = 1e-6f;
constexpr float LOG2E = 1.4426950408889634f;
constexpr float C2 = 0.125f * LOG2E;
constexpr int NPH = 2 + 9 * DEPTH;
constexpr int LDS_BYTES = 147456;
#ifndef PHMASK
#define PHMASK 0xFFFF
#endif
#define EN(x) (((PHMASK) >> (x)) & 1)

constexpr size_t MiB = 1u << 20;
constexpr size_t WS_MOD = 1 * MiB, WS_ZERO_BYTES = 2 * MiB;
constexpr size_t WS_WIN = 2 * MiB, WS_WOUT = 27 * MiB, WS_W1 = 35 * MiB, WS_W2 = 67 * MiB;
constexpr size_t WS_XN = 99 * MiB;
constexpr size_t WS_DQ = WS_XN, WS_DK = WS_XN + 65 * MiB;
constexpr size_t WS_P = 229 * MiB;
constexpr size_t WS_MIX = WS_P + (size_t)MTOT * INWP * 2;
constexpr size_t WS_H = WS_P;
constexpr size_t WS_YG = 766 * MiB;
constexpr size_t WS_HC = 896 * MiB;
constexpr size_t WS_DVT = 900 * MiB;
constexpr size_t WS_NAVT = 965 * MiB;
constexpr size_t WS_GD = 998 * MiB;
constexpr size_t WS_END = 1000 * MiB;
static_assert(WS_MIX + (size_t)MTOT * D * 2 <= WS_YG && WS_H + (size_t)MTOT * HID * 2 <= WS_MIX + (size_t)MTOT * D * 2, "ws map");
static_assert((size_t)NB * 16 * NKEY * 64 * 2 == 65 * MiB, "dq size");

typedef unsigned short bf16_t;
typedef float f32x2 __attribute__((ext_vector_type(2)));
typedef float f32x4 __attribute__((ext_vector_type(4)));
typedef float f32x16 __attribute__((ext_vector_type(16)));
typedef short bf16x8 __attribute__((ext_vector_type(8)));
typedef unsigned u32x4 __attribute__((ext_vector_type(4)));
typedef unsigned u32x2 __attribute__((ext_vector_type(2)));
#define LAS __attribute__((address_space(3)))
#define LDS_WAIT() asm volatile("s_waitcnt lgkmcnt(0)" ::: "memory")

struct Params {
    const float *x, *c, *ctx, *c_ctx, *w_ada, *b_ada, *g_pre_mix, *g_post_mix, *g_pre_mlp, *g_post_mlp,
                *w_in, *w_out, *na_rel_bias, *gla_w_gate, *gla_b_gate, *gla_g_norm, *diff_lambda, *diff_g_norm, *w_mlp_in, *w_mlp_out;
    float* out; unsigned char* ws; int ph_lo, ph_hi;
};

__device__ __forceinline__ float bf2f(unsigned u) { return __uint_as_float(u << 16); }
__device__ __forceinline__ unsigned f2bf(float f) { unsigned u = __float_as_uint(f); return (u + 0x7fffu + ((u >> 16) & 1u)) >> 16; }
__device__ __forceinline__ unsigned pk2(float lo, float hi) { return f2bf(lo) | (f2bf(hi) << 16); }
__device__ __forceinline__ float wave_sum(float v) {
#pragma unroll
    for (int o = 1; o < 64; o <<= 1) v += __shfl_xor(v, o);
    return v;
}
__device__ __forceinline__ int prow(int b, int n) { return n < SEQ ? b * SEQ + n : MLAT + b * NCTX + (n - SEQ); }

__device__ __forceinline__ void ph_mod(const Params& p, LAS unsigned char* lds) {
    LAS float* sc = (LAS float*)lds;
    const int tid = otid();
    for (int i = tid; i < 3 * D; i += 512) { const float v = i < 2 * D ? p.c[i] : p.c_ctx[i - 2 * D]; sc[i] = v / (1.f + __expf(-v)); }
    __syncthreads();
    float* MOD = (float*)(p.ws + WS_MOD);
    const int col_in = tid & 255, kh = tid >> 8;
    for (int it = obid(); it < 2 * 48 * 8; it += gridDim.x) {
        const int ks = it & 7, cb = (it >> 3) % 48, l = it / 384;
        const int col = cb * 256 + col_in;
        const float* W = p.w_ada + (size_t)l * D * 12288 + col;
        const int k0 = ks * 256 + kh * 128;
        float a0 = 0.f, a1 = 0.f, a2 = 0.f;
#pragma unroll 8
        for (int k = k0; k < k0 + 128; ++k) { const float w = W[(size_t)k * 12288]; a0 += sc[k] * w; a1 += sc[D + k] * w; a2 += sc[2 * D + k] * w; }
        if (ks == 0 && kh == 0) { const float bb = p.b_ada[l * 12288 + col]; a0 += bb; a1 += bb; a2 += bb; }
        float* m = MOD + (size_t)l * 3 * 12288 + col;
        atomicAdd(m, a0); atomicAdd(m + 12288, a1); atomicAdd(m + 2 * 12288, a2);
    }
    __syncthreads();
}

__device__ __forceinline__ void transpose_item(const float* W, int K, int N, bf16_t* WT, LAS float* scr, int item, int lane) {
    const int nblk = N / 32, kb = item / nblk, nb = item % nblk, k0 = 64 * kb, n0 = 32 * nb;
#pragma unroll 8
    for (int i = 0; i < 32; ++i) { const int kk = 2 * i + (lane >> 5); scr[kk * 33 + (lane & 31)] = W[(size_t)(k0 + kk) * N + n0 + (lane & 31)]; }
    LDS_WAIT();
    const int c = lane & 7;
#pragma unroll
    for (int j = 0; j < 4; ++j) { const int n = (lane >> 3) + 8 * j; const LAS float* s = scr + (8 * c) * 33 + n;
        u32x4 o; o.x = pk2(s[0 * 33], s[1 * 33]); o.y = pk2(s[2 * 33], s[3 * 33]); o.z = pk2(s[4 * 33], s[5 * 33]); o.w = pk2(s[6 * 33], s[7 * 33]);
        *(u32x4*)(WT + (size_t)(n0 + n) * K + k0 + 8 * c) = o; }
    LDS_WAIT();
}
__device__ __forceinline__ void ph_wconv(const Params& p, LAS unsigned char* lds, int l) {
    const int tid = otid(), lane = tid & 63, wave = tid >> 6;
    LAS float* scr = (LAS float*)(lds + wave * 16384);
    const int gw = obid() * 8 + wave, NGW = gridDim.x * 8;
    constexpr int I_IN = (D / 64) * (INW / 32), I_OUT = (D / 64) * (D / 32), I_1 = (D / 64) * (HID / 32), I_2 = (HID / 64) * (D / 32);
    const float* win = p.w_in + (size_t)l * D * INW; const float* wout = p.w_out + (size_t)l * D * D;
    const float* w1 = p.w_mlp_in + (size_t)l * D * HID; const float* w2 = p.w_mlp_out + (size_t)l * HID * D;
    for (int it = gw; it < I_IN + I_OUT + I_1 + I_2; it += NGW) {
        int r = it;
        if (r < I_IN) { transpose_item(win, D, INW, (bf16_t*)(p.ws + WS_WIN), scr, r, lane); continue; } r -= I_IN;
        if (r < I_OUT) { transpose_item(wout, D, D, (bf16_t*)(p.ws + WS_WOUT), scr, r, lane); continue; } r -= I_OUT;
        if (r < I_1) { transpose_item(w1, D, HID, (bf16_t*)(p.ws + WS_W1), scr, r, lane); continue; } r -= I_1;
        transpose_item(w2, HID, D, (bf16_t*)(p.ws + WS_W2), scr, r, lane);
    }
    __syncthreads();
}

__device__ __forceinline__ void row_pass(const Params& p, int l, int mode) {
    const int tid = otid(), lane = tid & 63, wave = tid >> 6;
    const int gw = obid() * 8 + wave, NGW = gridDim.x * 8;
    const float* MOD = (const float*)(p.ws + WS_MOD);
    float* HC = (float*)(p.ws + WS_HC);
    const bf16_t* Y = (const bf16_t*)(p.ws + WS_YG);
    bf16_t* XN = (bf16_t*)(p.ws + WS_XN);
    const int nrows = (l == 0) ? MTOT : MLAT;
    const float* xin_lat; const float* xin_ctx; const float* gpost = nullptr; const float* gn; int jg = 0, jsh, jsc, lnext; bool do_next = true;
    if (mode == 0) { xin_lat = p.x; xin_ctx = p.ctx; gn = p.g_pre_mix; jsh = 0; jsc = 1; lnext = 0; }
    else if (mode == 1) { xin_lat = (l == 0) ? p.x : p.out; xin_ctx = (l == 0) ? p.ctx : HC; gpost = p.g_post_mix + l * D; jg = 2; gn = p.g_pre_mlp + l * D; jsh = 3; jsc = 4; lnext = l; }
    else { xin_lat = p.out; xin_ctx = HC; gpost = p.g_post_mlp + l * D; jg = 5; lnext = l + 1; do_next = (l + 1 < DEPTH); gn = p.g_pre_mix + (do_next ? lnext : l) * D; jsh = 0; jsc = 1; }
    f32x4 nxv[8]; u32x2 nyr[8];
#define ROW_LOAD(mm) do { const int m_ = (mm); const float* xr_ = m_ < MLAT ? xin_lat + (size_t)m_ * D : xin_ctx + (size_t)(m_ - MLAT) * D; \
        _Pragma("unroll") for (int j = 0; j < 8; ++j) nxv[j] = *(const f32x4*)(xr_ + j * 256 + lane * 4); \
        if (mode != 0) { const bf16_t* yr_ = Y + (size_t)m_ * D; _Pragma("unroll") for (int j = 0; j < 8; ++j) nyr[j] = *(const u32x2*)(yr_ + j * 256 + lane * 4); } } while (0)
    if (gw < nrows) ROW_LOAD(gw);
    for (int m = gw; m < nrows; m += NGW) {
        const int s = m < MLAT ? (m >> 14) : 2;
        f32x4 xv[8]; u32x2 yraw[8];
#pragma unroll
        for (int j = 0; j < 8; ++j) { xv[j] = nxv[j]; yraw[j] = nyr[j]; }
        if (m + NGW < nrows) ROW_LOAD(m + NGW);
        if (mode != 0) {
            f32x4 yv[8]; float ss = 0.f;
#pragma unroll
            for (int j = 0; j < 8; ++j) { const u32x2 raw = yraw[j];
                yv[j] = (f32x4){bf2f(raw.x & 0xffffu), bf2f(raw.x >> 16), bf2f(raw.y & 0xffffu), bf2f(raw.y >> 16)};
                ss += (yv[j].x * yv[j].x + yv[j].y * yv[j].y) + (yv[j].z * yv[j].z + yv[j].w * yv[j].w); }
            ss = wave_sum(ss);
            const float r = rsqrtf(ss * (1.f / D) + EPS);
            const float* gate = MOD + ((size_t)(l * 3 + s) * 6 + jg) * D;
            float* xo = m < MLAT ? p.out + (size_t)m * D : HC + (size_t)(m - MLAT) * D;
#pragma unroll
            for (int j = 0; j < 8; ++j) { const int col = j * 256 + lane * 4;
                const f32x4 g4 = *(const f32x4*)(gpost + col), gt = *(const f32x4*)(gate + col);
                xv[j] = xv[j] + gt * (yv[j] * r * g4);
                *(f32x4*)(xo + col) = xv[j]; }
        }
        if (do_next) {
            float ss = 0.f;
#pragma unroll
            for (int j = 0; j < 8; ++j) ss += (xv[j].x * xv[j].x + xv[j].y * xv[j].y) + (xv[j].z * xv[j].z + xv[j].w * xv[j].w);
            ss = wave_sum(ss);
            const float r = rsqrtf(ss * (1.f / D) + EPS);
            const float* sh = MOD + ((size_t)(lnext * 3 + s) * 6 + jsh) * D; const float* scl = MOD + ((size_t)(lnext * 3 + s) * 6 + jsc) * D;
            bf16_t* xn = XN + (size_t)m * D;
#pragma unroll
            for (int j = 0; j < 8; ++j) { const int col = j * 256 + lane * 4;
                const f32x4 g4 = *(const f32x4*)(gn + col), s4 = *(const f32x4*)(sh + col), c4 = *(const f32x4*)(scl + col);
                const f32x4 h = (xv[j] * r * g4) * (c4 + 1.f) + s4;
                u32x2 w; w.x = pk2(h.x, h.y); w.y = pk2(h.z, h.w);
                *(u32x2*)(xn + col) = w; }
        }
    }
#undef ROW_LOAD
}

constexpr int TSB = 144;
constexpr int KTB = 64 * TSB;
__device__ __forceinline__ int crow(int r, int hi) { return (r & 3) + 8 * (r >> 2) + 4 * hi; }
__device__ __forceinline__ float xhalf_max(float m) { auto rr = __builtin_amdgcn_permlane32_swap(__float_as_uint(m), __float_as_uint(m), false, false); return fmaxf(__uint_as_float(rr[0]), __uint_as_float(rr[1])); }
__device__ __forceinline__ float xhalf_sum(float m) { auto rr = __builtin_amdgcn_permlane32_swap(__float_as_uint(m), __float_as_uint(m), false, false); return __uint_as_float(rr[0]) + __uint_as_float(rr[1]); }
__device__ __forceinline__ float max3f(float a, float b, float c) { float r; asm("v_max3_f32 %0, %1, %2, %3" : "=v"(r) : "v"(a), "v"(b), "v"(c)); return r; }
__device__ __forceinline__ float fadd_s(float a, float b) { float r; asm("v_add_f32_e32 %0, %1, %2" : "=v"(r) : "v"(a), "v"(b)); return r; }
__device__ __forceinline__ void glds16(const void* gsrc, unsigned lds_dst) { unsigned keep;
    asm volatile("s_mov_b32 %0, m0\n\ts_mov_b32 m0, %2\n\ts_nop 0\n\tglobal_load_lds_dwordx4 %1, off\n\ts_mov_b32 m0, %0" : "=&s"(keep) : "v"(gsrc), "s"(lds_dst) : "memory"); }
__device__ __forceinline__ void glds16s(unsigned voff, const void* sbase, unsigned lds_dst) { unsigned keep;
    asm volatile("s_mov_b32 %0, m0\n\ts_mov_b32 m0, %3\n\ts_nop 0\n\tglobal_load_lds_dwordx4 %1, %2\n\ts_mov_b32 m0, %0" : "=&s"(keep) : "v"(voff), "s"(sbase), "s"(lds_dst) : "memory"); }
#define LBARV() asm volatile("s_waitcnt vmcnt(0) lgkmcnt(0)\n\ts_barrier" ::: "memory")
#define LBAR() asm volatile("s_waitcnt lgkmcnt(0)\n\ts_barrier" ::: "memory")
typedef __bf16 bf16x2_t __attribute__((ext_vector_type(2)));
__device__ __forceinline__ unsigned cvtpk(float lo, float hi) { f32x2 v = {lo, hi}; bf16x2_t b = __builtin_convertvector(v, bf16x2_t); return __builtin_bit_cast(unsigned, b); }

__device__ __forceinline__ void wave_qk(f32x16& s0, f32x16& s1, const LAS unsigned char* Kt, const bf16x8 (&qf)[4], int r32, int hi) {
    s0 = (f32x16){}; s1 = (f32x16){};
#pragma unroll
    for (int d0 = 0; d0 < 4; ++d0) {
        const bf16x8 k0 = *(const LAS bf16x8*)(Kt + r32 * TSB + d0 * 32 + hi * 16);
        const bf16x8 k1 = *(const LAS bf16x8*)(Kt + (32 + r32) * TSB + d0 * 32 + hi * 16);
        s0 = __builtin_amdgcn_mfma_f32_32x32x16_bf16(k0, qf[d0], s0, 0, 0, 0);
        s1 = __builtin_amdgcn_mfma_f32_32x32x16_bf16(k1, qf[d0], s1, 0, 0, 0);
    }
}
template <int NDB, bool MASKED>
__device__ __forceinline__ void wave_softmax_pv(f32x16& s0, f32x16& s1, f32x16 (&o)[NDB], float& m, float& l, const LAS unsigned char* Vt, LAS float* scr, int r32, int hi) {
    float mx = fmaxf(s0[0], s1[0]);
#pragma unroll
    for (int r = 1; r < 16; ++r) mx = fmaxf(mx, fmaxf(s0[r], s1[r]));
    mx = xhalf_max(mx);
    if (__any(mx > m + 8.f)) {
        const float mn = fmaxf(m, mx); const float alpha = __builtin_amdgcn_exp2f(m - mn); m = mn; l *= alpha;
        if (hi == 0) scr[r32] = alpha;
        LDS_WAIT();
#pragma unroll
        for (int r = 0; r < 16; ++r) { const float a = scr[crow(r, hi)];
#pragma unroll
            for (int db = 0; db < NDB; ++db) o[db][r] *= a; }
        LDS_WAIT();
    }
    float ls = 0.f;
#pragma unroll
    for (int r = 0; r < 16; ++r) {
        float p0 = __builtin_amdgcn_exp2f(s0[r] - m), p1 = __builtin_amdgcn_exp2f(s1[r] - m);
        if (MASKED) { p0 = s0[r] < -1e29f ? 0.f : p0; p1 = s1[r] < -1e29f ? 0.f : p1; }
        s0[r] = p0; s1[r] = p1; ls += p0 + p1;
    }
    l += ls;
    bf16x8 pa[2][2];
#pragma unroll
    for (int s2 = 0; s2 < 2; ++s2) {
        u32x4 w0, w1;
        w0.x = cvtpk(s0[8 * s2 + 0], s0[8 * s2 + 1]); w0.y = cvtpk(s0[8 * s2 + 2], s0[8 * s2 + 3]); w0.z = cvtpk(s0[8 * s2 + 4], s0[8 * s2 + 5]); w0.w = cvtpk(s0[8 * s2 + 6], s0[8 * s2 + 7]);
        w1.x = cvtpk(s1[8 * s2 + 0], s1[8 * s2 + 1]); w1.y = cvtpk(s1[8 * s2 + 2], s1[8 * s2 + 3]); w1.z = cvtpk(s1[8 * s2 + 4], s1[8 * s2 + 5]); w1.w = cvtpk(s1[8 * s2 + 6], s1[8 * s2 + 7]);
        pa[0][s2] = __builtin_bit_cast(bf16x8, w0); pa[1][s2] = __builtin_bit_cast(bf16x8, w1);
    }
#pragma unroll
    for (int db = 0; db < NDB; ++db)
#pragma unroll
        for (int pp = 0; pp < 2; ++pp)
#pragma unroll
            for (int s2 = 0; s2 < 2; ++s2) {
                const bf16x8 v = *(const LAS bf16x8*)(Vt + (db * 32 + r32) * TSB + (32 * pp + 16 * s2 + 8 * hi) * 2);
                o[db] = __builtin_amdgcn_mfma_f32_32x32x16_bf16(pa[pp][s2], v, o[db], 0, 0, 0);
            }
}

constexpr int DTILEB = 2 * KTB + 128 * TSB;
__device__ __forceinline__ void diff_unit(LAS unsigned char* lds, const bf16_t* DQ, const bf16_t* DK, const bf16_t* DVt, bf16_t* MIX,
                                          int b, int h, int q0, int t0, int t1, float lam, const float* gnorm, float oscale) {
    const int tid = otid(), lane = tid & 63, wid = __builtin_amdgcn_readfirstlane(tid >> 6), r32 = lane & 31, hi = lane >> 5;
    const int grp = wid >> 2, p = wid & 1, qg = grp * 2 + ((wid >> 1) & 1);
    const int T = t1 - t0;
    LAS float* scr = (LAS float*)(lds + 3 * DTILEB) + wid * 32;
    const bf16_t* k0src = DK + ((size_t)((b * 8 + h) * 2 + 0) * NKEY) * 64 + tid * 8;
    const bf16_t* k1src = DK + ((size_t)((b * 8 + h) * 2 + 1) * NKEY) * 64 + tid * 8;
    const bf16_t* v0src = DVt + ((size_t)((b * 8 + h) * 128 + (tid >> 3)) * NKEY) + (tid & 7) * 8;
    const bf16_t* v1src = v0src + (size_t)64 * NKEY;
    const int kdst = (tid >> 3) * TSB + (tid & 7) * 16;
    u32x4 rk0, rk1, rv0, rv1;
#define DLOADK(t) do { rk0 = *(const u32x4*)(k0src + (size_t)(t) * 4096); rk1 = *(const u32x4*)(k1src + (size_t)(t) * 4096); } while (0)
#define DLOADV(t) do { rv0 = *(const u32x4*)(v0src + (t) * 64); rv1 = *(const u32x4*)(v1src + (t) * 64); } while (0)
#define DSTOREK(buf) do { LAS unsigned char* bb_ = lds + (buf) * DTILEB; *(LAS u32x4*)(bb_ + kdst) = rk0; *(LAS u32x4*)(bb_ + KTB + kdst) = rk1; } while (0)
#define DSTOREV(buf) do { LAS unsigned char* bb_ = lds + (buf) * DTILEB; *(LAS u32x4*)(bb_ + 2 * KTB + kdst) = rv0; *(LAS u32x4*)(bb_ + 2 * KTB + 64 * TSB + kdst) = rv1; } while (0)
    const bf16_t* qsrc = DQ + ((size_t)((b * 8 + h) * 2 + p) * NKEY + q0 + qg * 32 + r32) * 64 + hi * 8;
    bf16x8 qf[4];
#pragma unroll
    for (int d0 = 0; d0 < 4; ++d0) qf[d0] = *(const bf16x8*)(qsrc + d0 * 16);
    LAS unsigned char* qlds = lds + 3 * DTILEB + 1024 + wid * 4096 + lane * 16;
#pragma unroll
    for (int d0 = 0; d0 < 4; ++d0) *(LAS bf16x8*)(qlds + d0 * 1024) = qf[d0];
    f32x16 o[4]; o[0] = (f32x16){}; o[1] = (f32x16){}; o[2] = (f32x16){}; o[3] = (f32x16){};
    float m = 0.f, l = 0.f;
    f32x16 negm = (f32x16){};
    bf16x8 pa[2][2];
    f32x16 s0, s1;
    DLOADK(t0); DSTOREK(2); DLOADK(t0 + 1); DLOADV(t0); DSTOREK(0); DSTOREV(0);
    __syncthreads();
    wave_qk(s0, s1, lds + 2 * DTILEB + p * KTB, qf, r32, hi);
    const int wsub = wid & 3;
    unsigned poff[5];
#pragma unroll
    for (int k = 0; k < 5; ++k) {
        const int B = (wsub + 4 * k) * 1024 + lane * 16;
        if (grp == 0) { const int pp = B >= KTB ? 1 : 0, Bp = B - pp * KTB, row = Bp / TSB; int col = Bp % TSB; if (col >= 128) col = 0;
            poff[k] = (unsigned)(pp * (NKEY * 128) + row * 128 + col); }
        else { const int row = B / TSB; int col = B % TSB; if (col >= 128) col = 0;
            poff[k] = (unsigned)(row * (NKEY * 2) + col); }
    }
    const char* dbase0 = (grp == 0) ? (const char*)(DK + ((size_t)((b * 8 + h) * 2) * NKEY) * 64) + (size_t)(t0 + 2) * 8192
                                    : (const char*)(DVt + ((size_t)((b * 8 + h) * 128) * NKEY)) + (size_t)(t0 + 1) * 128;
    const int dstride = grp == 0 ? 8192 : 128, gahead = 2 - grp;
    const unsigned ldsb = (unsigned)(size_t)(lds + (grp ? 2 * KTB : 0)) + wsub * 1024;
    auto STG = [&](const int e) __attribute__((always_inline)) {
        if (e + gahead < T) {
            const unsigned dbase = ldsb + (unsigned)(((e + 1) % 3) * DTILEB);
            const unsigned long long sb_ = (unsigned long long)(dbase0 + (size_t)e * dstride);
            const void* sbs = (const void*)(((unsigned long long)(unsigned)__builtin_amdgcn_readfirstlane((int)(sb_ >> 32)) << 32) | (unsigned)__builtin_amdgcn_readfirstlane((int)sb_));
#pragma unroll
            for (int k = 0; k < 4; ++k) glds16s(poff[k], sbs, (unsigned)__builtin_amdgcn_readfirstlane(dbase + k * 4096));
            if (wsub < 2) glds16s(poff[4], sbs, (unsigned)__builtin_amdgcn_readfirstlane(dbase + 16384));
        }
    };
    auto XH = [&](const int j) __attribute__((always_inline)) {
            {
                if (!(j & 1)) {
                asm volatile("s_nop 15\n\ts_nop 7" : "+v"(s0), "+v"(s1));
                float mxa = max3f(s0[0], s0[1], s1[0]), mxb = max3f(s0[2], s0[3], s1[1]); mxa = max3f(mxa, s1[2], s1[3]);
#pragma unroll
                for (int r = 4; r < 16; r += 4) { mxa = max3f(mxa, s0[r], s0[r + 1]); mxb = max3f(mxb, s0[r + 2], s0[r + 3]); mxa = max3f(mxa, s1[r], s1[r + 1]); mxb = max3f(mxb, s1[r + 2], s1[r + 3]); }
                float mx = max3f(mxa, mxb, mxb);
                { auto rr = __builtin_amdgcn_permlane32_swap(__float_as_uint(mx), __float_as_uint(mx), false, false); mx = max3f(__uint_as_float(rr[0]), __uint_as_float(rr[1]), __uint_as_float(rr[1])); }
                if (j == 0) {
                    m = mx;
#pragma unroll
                    for (int r = 0; r < 16; ++r) { s0[r] -= mx; s1[r] -= mx; negm[r] = -mx; }
                } else if (__any(mx > 8.f)) {
                    const float delta = fmaxf(mx, 0.f); const float alpha = __builtin_amdgcn_exp2f(-delta); m += delta; l *= alpha;
#pragma unroll
                    for (int r = 0; r < 16; ++r) { s0[r] -= delta; s1[r] -= delta; negm[r] = -m; }
                    if (hi == 0) scr[r32] = alpha;
                    LDS_WAIT();
#pragma unroll
                    for (int r = 0; r < 16; ++r) { const float a = scr[crow(r, hi)];
#pragma unroll
                        for (int db = 0; db < 4; ++db) o[db][r] *= a; }
                    LDS_WAIT();
                }
                }
                float ls = 0.f;
#pragma unroll
                for (int r = 0; r < 16; ++r) { s0[r] = __builtin_amdgcn_exp2f(s0[r]); s1[r] = __builtin_amdgcn_exp2f(s1[r]); }
                __builtin_amdgcn_sched_barrier(0);
                f32x2 la2 = {0.f, 0.f}, lb2 = {0.f, 0.f};
#pragma unroll
                for (int r = 0; r < 16; r += 2) {
                    const f32x2 pa2 = {s0[r], s0[r + 1]}, pb2 = {s1[r], s1[r + 1]};
                    asm("v_pk_add_f32 %0, %1, %2" : "=v"(la2) : "v"(la2), "v"(pa2));
                    asm("v_pk_add_f32 %0, %1, %2" : "=v"(lb2) : "v"(lb2), "v"(pb2));
                }
                l += (la2.x + la2.y) + (lb2.x + lb2.y) + ls;
#pragma unroll
                for (int s2 = 0; s2 < 2; ++s2) {
                    u32x4 w0, w1;
                    w0.x = cvtpk(s0[8 * s2 + 0], s0[8 * s2 + 1]); w0.y = cvtpk(s0[8 * s2 + 2], s0[8 * s2 + 3]); w0.z = cvtpk(s0[8 * s2 + 4], s0[8 * s2 + 5]); w0.w = cvtpk(s0[8 * s2 + 6], s0[8 * s2 + 7]);
                    w1.x = cvtpk(s1[8 * s2 + 0], s1[8 * s2 + 1]); w1.y = cvtpk(s1[8 * s2 + 2], s1[8 * s2 + 3]); w1.z = cvtpk(s1[8 * s2 + 4], s1[8 * s2 + 5]); w1.w = cvtpk(s1[8 * s2 + 6], s1[8 * s2 + 7]);
                    pa[0][s2] = __builtin_bit_cast(bf16x8, w0); pa[1][s2] = __builtin_bit_cast(bf16x8, w1);
                }
            }
    };
    auto YH = [&](const int j) __attribute__((always_inline)) {
            {
                const LAS unsigned char* bb = lds + (j % 3) * DTILEB;
                const LAS unsigned char* Vt = bb + 2 * KTB + r32 * TSB + hi * 16;
                const LAS unsigned char* Kt = bb + p * KTB + r32 * TSB + hi * 16;
                const bool more = (j + 1 < T);
                bf16x8 fa[4], fb[4];
#define VLD(dst, db) do { _Pragma("unroll") for (int pp = 0; pp < 2; ++pp) _Pragma("unroll") for (int s2 = 0; s2 < 2; ++s2) \
                        dst[pp * 2 + s2] = *(const LAS bf16x8*)(Vt + (db) * 32 * TSB + (32 * pp + 16 * s2) * 2); } while (0)
#define KLD(dst, dh) do { _Pragma("unroll") for (int dd = 0; dd < 2; ++dd) { dst[dd * 2] = *(const LAS bf16x8*)(Kt + ((dh) * 2 + dd) * 32); \
                        dst[dd * 2 + 1] = *(const LAS bf16x8*)(Kt + 32 * TSB + ((dh) * 2 + dd) * 32); } } while (0)
#define PVM(src, db) do { _Pragma("unroll") for (int pp = 0; pp < 2; ++pp) _Pragma("unroll") for (int s2 = 0; s2 < 2; ++s2) \
                        o[db] = __builtin_amdgcn_mfma_f32_32x32x16_bf16(pa[pp][s2], src[pp * 2 + s2], o[db], 0, 0, 0); } while (0)
#define QKM(src, dh) do { _Pragma("unroll") for (int dd = 0; dd < 2; ++dd) { s0 = __builtin_amdgcn_mfma_f32_32x32x16_bf16(src[dd * 2], qf[(dh) * 2 + dd], s0, 0, 0, 0); \
                        s1 = __builtin_amdgcn_mfma_f32_32x32x16_bf16(src[dd * 2 + 1], qf[(dh) * 2 + dd], s1, 0, 0, 0); } } while (0)
#define FENCE() do { asm volatile("" ::: "memory"); __builtin_amdgcn_sched_barrier(0); } while (0)
                VLD(fa, 0); FENCE();
                __builtin_amdgcn_s_setprio(1);
                VLD(fb, 1); FENCE(); PVM(fa, 0); FENCE();
                VLD(fa, 2); FENCE(); PVM(fb, 1); FENCE();
                VLD(fb, 3); FENCE(); PVM(fa, 2); FENCE();
                if (more) {
                    bf16x8 q0 = qf[0], q1 = qf[1];
                    KLD(fa, 0); FENCE(); PVM(fb, 3); FENCE();
                    KLD(fb, 1); FENCE();
                    s0 = __builtin_amdgcn_mfma_f32_32x32x16_bf16(fa[0], q0, negm, 0, 0, 0); s1 = __builtin_amdgcn_mfma_f32_32x32x16_bf16(fa[1], q0, negm, 0, 0, 0);
                    s0 = __builtin_amdgcn_mfma_f32_32x32x16_bf16(fa[2], q1, s0, 0, 0, 0);   s1 = __builtin_amdgcn_mfma_f32_32x32x16_bf16(fa[3], q1, s1, 0, 0, 0);
                    q0 = qf[2]; q1 = qf[3];
                    FENCE();
                    s0 = __builtin_amdgcn_mfma_f32_32x32x16_bf16(fb[0], q0, s0, 0, 0, 0); s1 = __builtin_amdgcn_mfma_f32_32x32x16_bf16(fb[1], q0, s1, 0, 0, 0);
                    s0 = __builtin_amdgcn_mfma_f32_32x32x16_bf16(fb[2], q1, s0, 0, 0, 0); s1 = __builtin_amdgcn_mfma_f32_32x32x16_bf16(fb[3], q1, s1, 0, 0, 0);
                } else { PVM(fb, 3); }
                __builtin_amdgcn_s_setprio(0);
#undef VLD
#undef KLD
#undef PVM
#undef QKM
#undef FENCE
            }
    };
    if (grp == 0) {
        for (int j = 0; j < T; ++j) { STG(j); XH(j); __builtin_amdgcn_sched_barrier(0); YH(j); LBARV(); __builtin_amdgcn_sched_barrier(0); }
        LBARV();
    } else {
        STG(0); XH(0); LBARV(); __builtin_amdgcn_sched_barrier(0);
        for (int j = 1; j < T; ++j) { STG(j); YH(j - 1); __builtin_amdgcn_sched_barrier(0); XH(j); LBARV(); __builtin_amdgcn_sched_barrier(0); }
        YH(T - 1); LBARV();
    }
#undef DLOADK
#undef DLOADV
#undef DSTOREK
#undef DSTOREV
    {
        const float lt = xhalf_sum(l); const float inv = 1.f / lt; const float coef = p ? -lam * inv : inv;
        if (hi == 0) scr[r32] = coef;
        LDS_WAIT();
#pragma unroll
        for (int r = 0; r < 16; ++r) { const float a = scr[crow(r, hi)];
#pragma unroll
            for (int db = 0; db < 4; ++db) o[db][r] *= a; }
        LDS_WAIT();
    }
    LAS float* stage = (LAS float*)lds;
    if (p == 1) {
#pragma unroll
        for (int r = 0; r < 16; ++r)
#pragma unroll
            for (int db = 0; db < 4; ++db) stage[(qg * 32 + crow(r, hi)) * 128 + db * 32 + r32] = o[db][r];
    }
    __syncthreads();
    if (p == 0) {
#pragma unroll
        for (int r = 0; r < 16; ++r)
#pragma unroll
            for (int db = 0; db < 4; ++db) { const int idx = (qg * 32 + crow(r, hi)) * 128 + db * 32 + r32; stage[idx] = stage[idx] + o[db][r]; }
    }
    __syncthreads();
    const float g0 = gnorm[lane], g1 = gnorm[64 + lane];
    for (int i = 0; i < 16; ++i) {
        const int row = wid * 16 + i;
        const float v0 = stage[row * 128 + lane], v1 = stage[row * 128 + 64 + lane];
        const float ss = wave_sum(v0 * v0 + v1 * v1);
        const float rs = rsqrtf(ss * (1.f / 128.f) + EPS) * oscale;
        bf16_t* dst = MIX + (size_t)prow(b, q0 + row) * D + 1024 + h * 128;
        dst[lane] = (bf16_t)f2bf(v0 * rs * g0); dst[64 + lane] = (bf16_t)f2bf(v1 * rs * g1);
    }
    __syncthreads();
}

constexpr int NHB = 2 * KTB;
__device__ __forceinline__ void na_unit(LAS unsigned char* lds, const bf16_t* P, const bf16_t* NAVt, bf16_t* MIX, const float* relb, int b, int hg, int qblk) {
    const int tid = otid(), lane = tid & 63, wid = __builtin_amdgcn_readfirstlane(tid >> 6), r32 = lane & 31, hi = lane >> 5;
    const int hh = wid >> 1, qg = wid & 1, head = hg * 4 + hh;
    const bool isctx = qblk >= 256;
    const int n0q = isctx ? SEQ + (qblk - 256) * 64 : qblk * 64;
    const int kr0 = isctx ? 0 : min(max(qblk - 4, 0), 248);
    const int NT = isctx ? 4 : 12;
#define NTILE_OF(i) (isctx ? 256 + (i) : ((i) < 4 ? 256 + (i) : kr0 + (i) - 4))
    LAS float* biasL = (LAS float*)(lds + 4 * NHB);
    LAS float* scr = (LAS float*)(lds + 4 * NHB + 7680) + wid * 32;
    for (int i = tid; i < 4 * 15 * 32; i += 512) { const int hh_ = i / 480, rem = i % 480, dr_ = rem >> 5, dc_ = rem & 31;
        biasL[i] = dc_ < 31 ? relb[(hg * 4 + hh_) * 465 + dr_ * 31 + dc_] * LOG2E : -1e30f; }
    unsigned boff0[4] = {0u, 0u, 0u, 0u}, boff1[4] = {0u, 0u, 0u, 0u};
    { const int qc = qg * 32 + r32, c0 = min(max(qc - 8, 0), 48);
#pragma unroll
      for (int r = 0; r < 16; ++r) { const int kc0 = crow(r, hi), kc1 = kc0 + 32;
          boff0[r >> 2] |= (unsigned)(((kc0 >= c0 && kc0 < c0 + 16) ? (kc0 - qc + 15) : 31) * 4) << (8 * (r & 3));
          boff1[r >> 2] |= (unsigned)(((kc1 >= c0 && kc1 < c0 + 16) ? (kc1 - qc + 15) : 31) * 4) << (8 * (r & 3)); } }
    const bf16_t* qsrc = P + (size_t)prow(b, n0q + qg * 32 + r32) * INWP + head * 64 + hi * 8;
    bf16x8 qf[4];
#pragma unroll
    for (int d0 = 0; d0 < 4; ++d0) qf[d0] = *(const bf16x8*)(qsrc + d0 * 16);
    const int kdst = (tid >> 3) * TSB + (tid & 7) * 16;
    u32x4 rk[4], rv[4];
#define NLOAD(tile) do { const int n0_ = (tile) * 64; const bf16_t* kp_ = P + (size_t)prow(b, n0_ + (tid >> 3)) * INWP + 512 + hg * 256 + (tid & 7) * 8; \
        const bf16_t* vp_ = NAVt + ((size_t)((b * 8 + hg * 4) * 64 + (tid >> 3)) * NKEY) + n0_ + (tid & 7) * 8; \
        _Pragma("unroll") for (int j = 0; j < 4; ++j) { rk[j] = *(const u32x4*)(kp_ + j * 64); rv[j] = *(const u32x4*)(vp_ + (size_t)j * 64 * NKEY); } } while (0)
#define NSTORE() do { _Pragma("unroll") for (int j = 0; j < 4; ++j) { *(LAS u32x4*)(lds + j * NHB + kdst) = rk[j]; *(LAS u32x4*)(lds + j * NHB + KTB + kdst) = rv[j]; } } while (0)
    f32x16 o[2]; o[0] = (f32x16){}; o[1] = (f32x16){};
    float m = -1e30f, l = 0.f;
    NLOAD(NTILE_OF(0));
    for (int i = 0; i < NT; ++i) {
        NSTORE(); __syncthreads();
        const int tl = NTILE_OF(i);
        if (i + 1 < NT) NLOAD(NTILE_OF(i + 1));
        f32x16 s0, s1;
        wave_qk(s0, s1, lds + hh * NHB, qf, r32, hi);
        if (tl < 256) {
            const LAS unsigned char* bl = (const LAS unsigned char*)biasL + hh * 1920 + (tl - qblk + 7) * 128;
#pragma unroll
            for (int r = 0; r < 16; ++r) {
                s0[r] = s0[r] * C2 + *(const LAS float*)(bl + ((boff0[r >> 2] >> (8 * (r & 3))) & 0xffu));
                s1[r] = s1[r] * C2 + *(const LAS float*)(bl + ((boff1[r >> 2] >> (8 * (r & 3))) & 0xffu));
            }
        } else {
#pragma unroll
            for (int r = 0; r < 16; ++r) { s0[r] *= C2; s1[r] *= C2; }
        }
        wave_softmax_pv<2, false>(s0, s1, o, m, l, lds + hh * NHB + KTB, scr, r32, hi);
        __syncthreads();
    }
#undef NLOAD
#undef NSTORE
#undef NTILE_OF
    {
        const float lt = xhalf_sum(l); const float inv = 1.f / lt;
        if (hi == 0) scr[r32] = inv;
        LDS_WAIT();
#pragma unroll
        for (int r = 0; r < 16; ++r) { const float a = scr[crow(r, hi)];
            bf16_t* dst = MIX + (size_t)prow(b, n0q + qg * 32 + crow(r, hi)) * D + head * 64 + r32;
            dst[0] = (bf16_t)f2bf(o[0][r] * a); dst[32] = (bf16_t)f2bf(o[1][r] * a); }
        LDS_WAIT();
    }
    __syncthreads();
}

__device__ __forceinline__ void rope_rows(const Params& p) {
    const bf16_t* P = (const bf16_t*)(p.ws + WS_P); bf16_t* DQ = (bf16_t*)(p.ws + WS_DQ); bf16_t* DK = (bf16_t*)(p.ws + WS_DK);
    const int tid = otid(), rsel = tid >> 8, hp = (tid >> 4) & 15, i2 = (tid & 15) * 2;
    const float inv0 = __builtin_amdgcn_exp2f(-(float)(i2 & 15) * (13.287712379549449f / 16.f));
    const float inv1 = __builtin_amdgcn_exp2f(-(float)((i2 + 1) & 15) * (13.287712379549449f / 16.f));
    for (int m0 = obid() * 8; m0 < MTOT; m0 += gridDim.x * 8) {
        unsigned q1[4], q2[4], k1[4], k2[4];
#pragma unroll
        for (int r = 0; r < 4; ++r) { const bf16_t* src = P + (size_t)(m0 + 2 * r + rsel) * INWP + DIFF_OFF + hp * 64 + i2;
            q1[r] = *(const unsigned*)src; q2[r] = *(const unsigned*)(src + 32); k1[r] = *(const unsigned*)(src + 1024); k2[r] = *(const unsigned*)(src + 1024 + 32); }
#pragma unroll
        for (int r = 0; r < 4; ++r) {
            const int m = m0 + 2 * r + rsel; int b, n; float cs0 = 1.f, sn0 = 0.f, cs1 = 1.f, sn1 = 0.f;
            if (m < MLAT) { b = m >> 14; const int t = m & (SEQ - 1); n = t; const float pos = (float)((i2 < 16) ? (t >> 6) : (t & 63));
                float rev0 = pos * inv0 * 0.15915494309189535f; rev0 -= rintf(rev0); sn0 = __builtin_amdgcn_sinf(rev0); cs0 = __builtin_amdgcn_cosf(rev0);
                float rev1 = pos * inv1 * 0.15915494309189535f; rev1 -= rintf(rev1); sn1 = __builtin_amdgcn_sinf(rev1); cs1 = __builtin_amdgcn_cosf(rev1); }
            else { b = (m - MLAT) >> 8; n = SEQ + ((m - MLAT) & 255); }
            const float qa0 = bf2f(q1[r] & 0xffffu), qa1 = bf2f(q1[r] >> 16), qb0 = bf2f(q2[r] & 0xffffu), qb1 = bf2f(q2[r] >> 16);
            const float ka0 = bf2f(k1[r] & 0xffffu), ka1 = bf2f(k1[r] >> 16), kb0 = bf2f(k2[r] & 0xffffu), kb1 = bf2f(k2[r] >> 16);
            const size_t dst = ((size_t)(b * 16 + hp) * NKEY + n) * 64 + i2;
            *(unsigned*)(DQ + dst) = pk2((qa0 * cs0 - qb0 * sn0) * C2, (qa1 * cs1 - qb1 * sn1) * C2);
            *(unsigned*)(DQ + dst + 32) = pk2((qa0 * sn0 + qb0 * cs0) * C2, (qa1 * sn1 + qb1 * cs1) * C2);
            *(unsigned*)(DK + dst) = pk2(ka0 * cs0 - kb0 * sn0, ka1 * cs1 - kb1 * sn1);
            *(unsigned*)(DK + dst + 32) = pk2(ka0 * sn0 + kb0 * cs0, ka1 * sn1 + kb1 * cs1);
        }
    }
}
template <int DV>
__device__ __forceinline__ void vtrans_item(LAS unsigned char* lds, const bf16_t* P, int colbase, bf16_t* Vt, int b, int hh, int tile) {
    constexpr int ST = DV + 2;
    LAS bf16_t* L = (LAS bf16_t*)lds;
    const int tid = otid();
    constexpr int CPR = DV / 8;
#pragma unroll
    for (int j = 0; j < (64 * CPR) / 512; ++j) {
        const int c = tid + 512 * j, key = c / CPR, ch = c % CPR;
        const u32x4 raw = *(const u32x4*)(P + (size_t)prow(b, tile * 64 + key) * INWP + colbase + hh * DV + ch * 8);
        LAS unsigned* d = (LAS unsigned*)(L + key * ST + ch * 8);
        d[0] = raw.x; d[1] = raw.y; d[2] = raw.z; d[3] = raw.w;
    }
    __syncthreads();
    if (tid < DV * 4) {
        const int d = tid >> 2, pg = tid & 3;
        unsigned w[8];
#pragma unroll
        for (int j2 = 0; j2 < 8; ++j2) {
            const int ja = 2 * j2, jb = 2 * j2 + 1;
            const int ka = 16 * pg + ((ja & 3) | ((ja & 4) << 1) | ((ja & 8) >> 1)), kb = 16 * pg + ((jb & 3) | ((jb & 4) << 1) | ((jb & 8) >> 1));
            w[j2] = (unsigned)L[ka * ST + d] | ((unsigned)L[kb * ST + d] << 16);
        }
        bf16_t* dst = Vt + ((size_t)((b * 8 + hh) * DV + d) * NKEY) + tile * 64 + 16 * pg;
        *(u32x4*)dst = (u32x4){w[0], w[1], w[2], w[3]}; *(u32x4*)(dst + 8) = (u32x4){w[4], w[5], w[6], w[7]};
    }
    __syncthreads();
}

template <int DV>
__device__ __forceinline__ void vtrans_loop(LAS unsigned char* lds, const bf16_t* P, int colbase, bf16_t* Vt, int bx, int G) {
    constexpr int ST = DV + 2, CPR = DV / 8, NCH = (64 * CPR) / 512, NITEMS = NB * 8 * NTILE;
    LAS bf16_t* L = (LAS bf16_t*)lds;
    const int tid = otid();
    u32x4 nx[NCH];
#define VT_LOAD(it_) do { const int b_ = (it_) / (8 * NTILE), hh_ = ((it_) / NTILE) % 8, tile_ = (it_) % NTILE; \
        _Pragma("unroll") for (int j = 0; j < NCH; ++j) { const int c = tid + 512 * j, key = c / CPR, ch = c % CPR; \
            nx[j] = *(const u32x4*)(P + (size_t)prow(b_, tile_ * 64 + key) * INWP + colbase + hh_ * DV + ch * 8); } } while (0)
    int it = bx;
    if (it < NITEMS) VT_LOAD(it);
    for (; it < NITEMS; it += G) {
        const int b = it / (8 * NTILE), hh = (it / NTILE) % 8, tile = it % NTILE;
#pragma unroll
        for (int j = 0; j < NCH; ++j) { const int c = tid + 512 * j, key = c / CPR, ch = c % CPR;
            LAS unsigned* d = (LAS unsigned*)(L + key * ST + ch * 8);
            d[0] = nx[j].x; d[1] = nx[j].y; d[2] = nx[j].z; d[3] = nx[j].w; }
        if (it + G < NITEMS) VT_LOAD(it + G);
        __syncthreads();
        if (tid < DV * 4) {
            const int d = tid >> 2, pg = tid & 3;
            unsigned w[8];
#pragma unroll
            for (int j2 = 0; j2 < 8; ++j2) {
                const int ja = 2 * j2, jb = 2 * j2 + 1;
                const int ka = 16 * pg + ((ja & 3) | ((ja & 4) << 1) | ((ja & 8) >> 1)), kb = 16 * pg + ((jb & 3) | ((jb & 4) << 1) | ((jb & 8) >> 1));
                w[j2] = (unsigned)L[ka * ST + d] | ((unsigned)L[kb * ST + d] << 16);
            }
            bf16_t* dst = Vt + ((size_t)((b * 8 + hh) * DV + d) * NKEY) + tile * 64 + 16 * pg;
            *(u32x4*)dst = (u32x4){w[0], w[1], w[2], w[3]}; *(u32x4*)(dst + 8) = (u32x4){w[4], w[5], w[6], w[7]};
        }
        __syncthreads();
    }
#undef VT_LOAD
}

__device__ __forceinline__ float logsig16(float x) { return (fminf(x, 0.f) - __logf(1.f + __expf(-fabsf(x)))) * (1.f / 16.f); }
__device__ __forceinline__ void gla_gates(LAS unsigned char* lds, const bf16_t* P, const float* wg, const float* bg, int b, int c, int h) {
    LAS float* la = (LAS float*)lds; LAS float* aL = (LAS float*)(lds + 33280);
    const int tid = otid();
    {
        const int t = tid >> 3, q4 = (tid & 7) * 4;
        const u32x2 raw = *(const u32x2*)(P + (size_t)prow(b, c * 64 + t) * INWP + GLA_OFF + 1536 + q4);
        LAS float* dst = aL + ((q4 >> 4) * 64 + t) * 16 + (q4 & 15);
        dst[0] = bf2f(raw.x & 0xffffu); dst[1] = bf2f(raw.x >> 16); dst[2] = bf2f(raw.y & 0xffffu); dst[3] = bf2f(raw.y >> 16);
    }
    const int d = tid & 63, tq = tid >> 6;
    float w0[16], w1[16];
#pragma unroll
    for (int r = 0; r < 16; ++r) { w0[r] = wg[r * 256 + h * 64 + d]; w1[r] = wg[(16 + r) * 256 + h * 64 + d]; }
    const float b0 = bg[h * 64 + d], b1 = bg[256 + h * 64 + d];
    __syncthreads();
#pragma unroll
    for (int tt = 0; tt < 8; ++tt) {
        const int t = tq * 8 + tt;
        float p0 = b0, p1 = b1;
#pragma unroll
        for (int r4 = 0; r4 < 4; ++r4) {
            const f32x4 a0 = *(const LAS f32x4*)(aL + t * 16 + r4 * 4), a1 = *(const LAS f32x4*)(aL + (64 + t) * 16 + r4 * 4);
            p0 += a0.x * w0[r4 * 4] + a0.y * w0[r4 * 4 + 1] + a0.z * w0[r4 * 4 + 2] + a0.w * w0[r4 * 4 + 3];
            p1 += a1.x * w1[r4 * 4] + a1.y * w1[r4 * 4 + 1] + a1.z * w1[r4 * 4 + 2] + a1.w * w1[r4 * 4 + 3];
        }
        la[t * 65 + d] = logsig16(p0); la[4160 + t * 65 + d] = logsig16(p1);
    }
    __syncthreads();
    {
        const int cz = (tid >> 6) & 1, seg = tid >> 7; LAS float* col = la + cz * 4160 + (tid & 63);
        float v[16];
#pragma unroll
        for (int i = 0; i < 16; ++i) v[i] = col[(seg * 16 + i) * 65];
        if (cz == 0) {
#pragma unroll
            for (int i = 1; i < 16; ++i) v[i] += v[i - 1];
        } else {
#pragma unroll
            for (int i = 14; i >= 0; --i) v[i] += v[i + 1];
        }
        LAS float* tot = aL + (tid & 127);
        tot[seg * 128] = cz == 0 ? v[15] : v[0];
        __syncthreads();
        float off = 0.f;
#pragma unroll
        for (int q = 0; q < 4; ++q) { const float tq_ = tot[q * 128]; off += ((cz == 0) ? (q < seg) : (q > seg)) ? tq_ : 0.f; }
#pragma unroll
        for (int i = 0; i < 16; ++i) col[(seg * 16 + i) * 65] = v[i] + off;
    }
    __syncthreads();
}
__device__ __forceinline__ void gla_g1_item(LAS unsigned char* lds, const bf16_t* P, const float* wg, const float* bg, float* GS, float* GD, int b, int c, int h) {
    gla_gates(lds, P, wg, bg, b, c, h);
    const LAS float* la = (const LAS float*)lds; LAS float* kd = (LAS float*)(lds + 41472); LAS float* vL = (LAS float*)(lds + 74240);
    const int tid = otid();
    {   const int t = tid >> 3, ch = tid & 7;
        const u32x4 rk = *(const u32x4*)(P + (size_t)prow(b, c * 64 + t) * INWP + GLA_OFF + 256 + h * 64 + ch * 8);
        u32x4 rv[2];
#pragma unroll
        for (int jj = 0; jj < 2; ++jj) { const int cc_ = tid + 512 * jj; rv[jj] = *(const u32x4*)(P + (size_t)prow(b, c * 64 + (cc_ >> 4)) * INWP + GLA_OFF + 512 + h * 128 + (cc_ & 15) * 8); }
        const unsigned kw[4] = {rk.x, rk.y, rk.z, rk.w};
#pragma unroll
        for (int e = 0; e < 8; ++e) { const int d = ch * 8 + e; const float k = bf2f((e & 1) ? (kw[e >> 1] >> 16) : (kw[e >> 1] & 0xffffu));
            kd[t * 64 + d] = k * __expf(la[63 * 65 + d] - la[t * 65 + d]);
            kd[4096 + t * 64 + d] = k * __expf(la[4160 + d] - la[4160 + t * 65 + d]); }
#pragma unroll
        for (int jj = 0; jj < 2; ++jj) { const int cc_ = tid + 512 * jj; LAS float* dv = vL + (cc_ >> 4) * 128 + (cc_ & 15) * 8;
            *(LAS f32x4*)dv = (f32x4){bf2f(rv[jj].x & 0xffffu), bf2f(rv[jj].x >> 16), bf2f(rv[jj].y & 0xffffu), bf2f(rv[jj].y >> 16)};
            *(LAS f32x4*)(dv + 4) = (f32x4){bf2f(rv[jj].z & 0xffffu), bf2f(rv[jj].z >> 16), bf2f(rv[jj].w & 0xffffu), bf2f(rv[jj].w >> 16)}; }
    }
    __syncthreads();
    const int v = tid & 127, dg = tid >> 7;
    f32x4 af4[4], ab4[4];
#pragma unroll
    for (int i = 0; i < 4; ++i) { af4[i] = (f32x4){0.f, 0.f, 0.f, 0.f}; ab4[i] = (f32x4){0.f, 0.f, 0.f, 0.f}; }
    for (int t = 0; t < 64; ++t) {
        const float vs = vL[t * 128 + v];
#pragma unroll
        for (int q = 0; q < 4; ++q) {
            const f32x4 kf = *(const LAS f32x4*)(kd + t * 64 + dg * 16 + q * 4), kb = *(const LAS f32x4*)(kd + 4096 + t * 64 + dg * 16 + q * 4);
            af4[q] += kf * vs; ab4[q] += kb * vs;
        }
    }
    float* gf = GS + ((size_t)((b * 2 + 0) * 4 + h) * NTILE + c) * 8192 + (dg * 16) * 128 + v;
    float* gb = GS + ((size_t)((b * 2 + 1) * 4 + h) * NTILE + c) * 8192 + (dg * 16) * 128 + v;
#pragma unroll
    for (int i = 0; i < 16; ++i) { gf[i * 128] = af4[i >> 2][i & 3]; gb[i * 128] = ab4[i >> 2][i & 3]; }
    if (tid < 128) { const int z = tid >> 6, d = tid & 63;
        GD[((size_t)((b * 2 + z) * 4 + h) * NTILE + c) * 64 + d] = __expf(z == 0 ? la[63 * 65 + d] : la[4160 + d]); }
    __syncthreads();
}
__device__ __forceinline__ void gla_scan(float* GS, const float* GD) {
    for (int gid = obid() * 512 + otid(); gid < 16 * 8192; gid += gridDim.x * 512) {
        const int v = gid & 127, d = (gid >> 7) & 63, chain = gid >> 13, z = (chain >> 2) & 1;
        float* gs = GS + (size_t)chain * NTILE * 8192 + d * 128 + v; const float* gd = GD + (size_t)chain * NTILE * 64 + d;
        float S = 0.f;
        for (int k0 = 0; k0 < NTILE; k0 += 20) {
            float L[20], Dc[20]; int cc[20];
#pragma unroll
            for (int j = 0; j < 20; ++j) { const int k = k0 + j; const int c = z ? (NTILE - 1 - k) : (k < 4 ? 256 + k : k - 4); cc[j] = c; L[j] = gs[(size_t)c * 8192]; Dc[j] = gd[c * 64]; }
#pragma unroll
            for (int j = 0; j < 20; ++j) { gs[(size_t)cc[j] * 8192] = S; S = Dc[j] * S + L[j]; }
        }
    }
}
__device__ __forceinline__ void gla_g3_item(LAS unsigned char* lds, const bf16_t* P, const float* wg, const float* bg, const float* GS, const float* gn, bf16_t* MIX, int b, int c, int h) {
    gla_gates(lds, P, wg, bg, b, c, h);
    const LAS float* la = (const LAS float*)lds;
    LAS float* QfT = (LAS float*)(lds + 41472); LAS float* QbT = (LAS float*)(lds + 57856);
    LAS float* KfT = (LAS float*)(lds + 74240); LAS float* KbT = (LAS float*)(lds + 90624);
    LAS float* VR = (LAS float*)(lds + 107008);
    LAS float* AT = (LAS float*)lds;
    LAS float* OL = KfT;
    const int tid = otid(), lane = tid & 63, wid = tid >> 6;
    {   const int t = tid >> 3, ch = tid & 7;
        const bf16_t* src = P + (size_t)prow(b, c * 64 + t) * INWP + GLA_OFF + h * 64 + ch * 8;
        const u32x4 rq = *(const u32x4*)src, rk = *(const u32x4*)(src + 256);
        LAS float* dq = VR + t * 65 + ch * 8; LAS float* dk = VR + 4160 + t * 65 + ch * 8;
        dq[0] = bf2f(rq.x & 0xffffu) * 0.125f; dq[1] = bf2f(rq.x >> 16) * 0.125f; dq[2] = bf2f(rq.y & 0xffffu) * 0.125f; dq[3] = bf2f(rq.y >> 16) * 0.125f;
        dq[4] = bf2f(rq.z & 0xffffu) * 0.125f; dq[5] = bf2f(rq.z >> 16) * 0.125f; dq[6] = bf2f(rq.w & 0xffffu) * 0.125f; dq[7] = bf2f(rq.w >> 16) * 0.125f;
        dk[0] = bf2f(rk.x & 0xffffu); dk[1] = bf2f(rk.x >> 16); dk[2] = bf2f(rk.y & 0xffffu); dk[3] = bf2f(rk.y >> 16);
        dk[4] = bf2f(rk.z & 0xffffu); dk[5] = bf2f(rk.z >> 16); dk[6] = bf2f(rk.w & 0xffffu); dk[7] = bf2f(rk.w >> 16); }
    __syncthreads();
    for (int idx = tid; idx < 4096; idx += 512) { const int t = idx & 63, d = idx >> 6;
        const float q = VR[t * 65 + d], k = VR[4160 + t * 65 + d], bp = la[t * 65 + d], bs = la[4160 + t * 65 + d];
        QfT[d * 64 + t] = q * __expf(bp); QbT[d * 64 + t] = q * __expf(bs); KfT[d * 64 + t] = k * __expf(-bp); KbT[d * 64 + t] = k * __expf(-bs); }
    __syncthreads();
#pragma unroll
    for (int jj = 0; jj < 2; ++jj) { const int cc_ = tid + 512 * jj, t = cc_ >> 4, ch = cc_ & 15;
        const u32x4 rv = *(const u32x4*)(P + (size_t)prow(b, c * 64 + t) * INWP + GLA_OFF + 512 + h * 128 + ch * 8);
        LAS float* dv = VR + t * 128 + ch * 8;
        *(LAS f32x4*)dv = (f32x4){bf2f(rv.x & 0xffffu), bf2f(rv.x >> 16), bf2f(rv.y & 0xffffu), bf2f(rv.y >> 16)};
        *(LAS f32x4*)(dv + 4) = (f32x4){bf2f(rv.z & 0xffffu), bf2f(rv.z >> 16), bf2f(rv.w & 0xffffu), bf2f(rv.w >> 16)}; }
    {
        const int t0 = 2 * (tid >> 4), s0 = 4 * (tid & 15);
        f32x4 af[2], ab[2];
#pragma unroll
        for (int i = 0; i < 2; ++i) { af[i] = (f32x4){0.f, 0.f, 0.f, 0.f}; ab[i] = (f32x4){0.f, 0.f, 0.f, 0.f}; }
        for (int d = 0; d < 64; ++d) {
            const f32x2 qf = *(const LAS f32x2*)(QfT + d * 64 + t0), qb = *(const LAS f32x2*)(QbT + d * 64 + t0);
            const f32x4 kf = *(const LAS f32x4*)(KfT + d * 64 + s0), kb = *(const LAS f32x4*)(KbT + d * 64 + s0);
#pragma unroll
            for (int i = 0; i < 2; ++i) { af[i] += kf * qf[i]; ab[i] += kb * qb[i]; }
        }
#pragma unroll
        for (int i = 0; i < 2; ++i)
#pragma unroll
            for (int j = 0; j < 4; ++j) { const int t = t0 + i, s = s0 + j; AT[s * 64 + t] = (s <= t) ? af[i][j] : ab[i][j]; }
    }
    __syncthreads();
    {
        const int v = tid & 127, tg = tid >> 7;
        f32x4 acc4[4];
#pragma unroll
        for (int i = 0; i < 4; ++i) acc4[i] = (f32x4){0.f, 0.f, 0.f, 0.f};
        const float* Sf = GS + ((size_t)((b * 2 + 0) * 4 + h) * NTILE + c) * 8192 + v; const float* Sb = GS + ((size_t)((b * 2 + 1) * 4 + h) * NTILE + c) * 8192 + v;
#define G3_LD(buf, d0) do { _Pragma("unroll") for (int k = 0; k < 4; ++k) { buf[k] = Sf[((d0) + k) * 128]; buf[4 + k] = Sb[((d0) + k) * 128]; } } while (0)
#define G3_FMA(buf, d0) do { _Pragma("unroll") for (int k = 0; k < 4; ++k) { const int d = (d0) + k; const float sf = buf[k], sb = buf[4 + k]; \
            _Pragma("unroll") for (int q = 0; q < 4; ++q) { \
                const f32x4 a = *(const LAS f32x4*)(QfT + d * 64 + tg * 16 + q * 4), bq = *(const LAS f32x4*)(QbT + d * 64 + tg * 16 + q * 4); \
                acc4[q] += a * sf + bq * sb; } } } while (0)
        {   float sA[8], sB[8];
            G3_LD(sA, 0);
            for (int d0 = 0; d0 < 64; d0 += 8) {
                G3_LD(sB, d0 + 4); asm volatile("" ::: "memory");
                G3_FMA(sA, d0);
                if (d0 + 8 < 64) G3_LD(sA, d0 + 8);
                asm volatile("" ::: "memory");
                G3_FMA(sB, d0 + 4);
            }
        }
#undef G3_LD
#undef G3_FMA
        for (int s = 0; s < 64; ++s) {
            const float vs = VR[s * 128 + v];
#pragma unroll
            for (int q = 0; q < 4; ++q) {
                const f32x4 a = *(const LAS f32x4*)(AT + s * 64 + tg * 16 + q * 4);
                acc4[q] += a * vs;
            }
        }
#pragma unroll
        for (int i = 0; i < 16; ++i) OL[(tg * 16 + i) * 128 + v] = acc4[i >> 2][i & 3];
    }
    __syncthreads();
    const float g0 = gn[lane], g1 = gn[64 + lane];
    for (int i = 0; i < 8; ++i) {
        const int t = wid * 8 + i;
        const float v0 = OL[t * 128 + lane], v1 = OL[t * 128 + 64 + lane];
        const float ss = wave_sum(v0 * v0 + v1 * v1);
        const float rs = rsqrtf(ss * (1.f / 128.f) + EPS);
        const size_t row = prow(b, c * 64 + t);
        const bf16_t* gp = P + row * INWP + GLA_OFF + 1024 + h * 128;
        const float ga = bf2f(gp[lane]), gb = bf2f(gp[64 + lane]);
        bf16_t* dst = MIX + row * D + 512 + h * 128;
        dst[lane] = (bf16_t)f2bf(v0 * rs * g0 * (ga / (1.f + __expf(-ga)))); dst[64 + lane] = (bf16_t)f2bf(v1 * rs * g1 * (gb / (1.f + __expf(-gb))));
    }
    __syncthreads();
}

#define XB_TMO      128
#define XB_XCNT(j)  (256  + 64 * (j))
#define XB_XSUB(j)  (1280 + 64 * (j))
#define XB_XGEN(j)  (2304 + 64 * (j))
#define XB_TOP      3328
#define XB_TOPGEN   3392
#define XCD_BAR_WORDS 3456
#define XB_SPIN_CAP (1u << 24)

__device__ __forceinline__ unsigned xb_ld(unsigned* p)              { return __hip_atomic_load(p, __ATOMIC_RELAXED, __HIP_MEMORY_SCOPE_AGENT); }
__device__ __forceinline__ unsigned xb_add(unsigned* p, unsigned v) { return __hip_atomic_fetch_add(p, v, __ATOMIC_RELAXED, __HIP_MEMORY_SCOPE_AGENT); }
__device__ __forceinline__ unsigned xb_xcc_id() { return (unsigned)__builtin_amdgcn_s_getreg((3 << 11) | 20) & 0xFu; }
#define XB_SPIN(cond, bar) do { unsigned _sp = 0; while (cond) { __builtin_amdgcn_s_sleep(1); \
    if ((++_sp & 255u) == 0u) { if (xb_ld(&(bar)[XB_TMO])) break; if (_sp > XB_SPIN_CAP) { atomicAdd(&(bar)[XB_TMO], 1u); break; } } } } while (0)

struct XcdBarrier {
    unsigned* bar; unsigned x;
    volatile LAS unsigned* st;
};

__device__ __forceinline__ XcdBarrier xcd_barrier_post(unsigned* bar, volatile LAS unsigned* st) {
    XcdBarrier b; b.bar = bar; b.x = xb_xcc_id(); b.st = st;
    if (threadIdx.x == 0) (void)xb_add(&bar[XB_XCNT(b.x)], 1u);
    return b;
}
__device__ __forceinline__ void xcd_barrier_complete(unsigned* bar, unsigned x, unsigned& nloc, unsigned& nx) {
    const unsigned G = gridDim.x * gridDim.y * gridDim.z;
    unsigned sum, cnt, mine, sp = 0u;
    for (;;) {
        sum = 0u; cnt = 0u; mine = 0u;
#pragma unroll
        for (unsigned j = 0; j < 16; ++j) { const unsigned c = xb_ld(&bar[XB_XCNT(j)]); sum += c; cnt += (c > 0u) ? 1u : 0u; mine = (j == x) ? c : mine; }
        if (sum == G) break;
        __builtin_amdgcn_s_sleep(1);
        if ((++sp & 255u) == 0u) { if (xb_ld(&bar[XB_TMO])) break; if (sp > XB_SPIN_CAP) { atomicAdd(&bar[XB_TMO], 1u); break; } }
    }
    nloc = mine > 0u ? mine : 1u; nx = cnt > 0u ? cnt : 1u;
}

__device__ __forceinline__ void xcd_barrier(const XcdBarrier& b) {
    asm volatile("s_waitcnt vmcnt(0)" ::: "memory");
    __syncthreads();
    if (threadIdx.x == 0) {
        unsigned* bar = b.bar;
        __builtin_amdgcn_s_waitcnt(0);
        unsigned nloc = b.st[0], nx = b.st[1];
        if (nloc == 0u) { xcd_barrier_complete(bar, b.x, nloc, nx); b.st[0] = nloc; b.st[1] = nx; }
        const unsigned old = xb_add(&bar[XB_XSUB(b.x)], 1u);
        const unsigned gen = old / nloc;
        if (old + 1u == (gen + 1u) * nloc) {
            __builtin_amdgcn_fence(__ATOMIC_RELEASE, "agent");
            asm volatile("s_waitcnt vmcnt(0)" ::: "memory");
            const unsigned og = xb_add(&bar[XB_TOP], 1u);
            const unsigned tg = og / nx;
            if (og + 1u == (tg + 1u) * nx) xb_add(&bar[XB_TOPGEN], 1u);
            else XB_SPIN(xb_ld(&bar[XB_TOPGEN]) == tg, bar);
            __builtin_amdgcn_fence(__ATOMIC_ACQUIRE, "agent");
            xb_add(&bar[XB_XGEN(b.x)], 1u);
            asm volatile("s_waitcnt vmcnt(0)" ::: "memory");
        } else {
            XB_SPIN(xb_ld(&bar[XB_XGEN(b.x)]) == gen, bar);
            __builtin_amdgcn_fence(__ATOMIC_ACQUIRE, "agent");
            asm volatile("s_waitcnt vmcnt(0)" ::: "memory");
        }
    }
    __syncthreads();
}

__global__ void __launch_bounds__(512) fwd_kernel(Params p) {
    extern __shared__ __attribute__((aligned(16))) unsigned char lds_raw[];
    LAS unsigned char* lds = (LAS unsigned char*)lds_raw;
    cg::grid_group grid = cg::this_grid();
    { const int t_ = otid(); if (t_ < 16) ((LAS unsigned*)(lds + LDS_BYTES - 64))[t_] = 0u; }
    __syncthreads();
    XcdBarrier xbar = xcd_barrier_post((unsigned*)p.ws, (volatile LAS unsigned*)(lds + LDS_BYTES - 64));
    const int G = gridDim.x, bx = obid();
    bf16_t* P = (bf16_t*)(p.ws + WS_P); bf16_t* MIX = (bf16_t*)(p.ws + WS_MIX); bf16_t* XN = (bf16_t*)(p.ws + WS_XN);
    bf16_t* YB = (bf16_t*)(p.ws + WS_YG); bf16_t* HB = (bf16_t*)(p.ws + WS_H);
    float* GS = (float*)(p.ws + WS_YG); float* GD = (float*)(p.ws + WS_GD);
    bf16_t* DQ = (bf16_t*)(p.ws + WS_DQ); bf16_t* DK = (bf16_t*)(p.ws + WS_DK); bf16_t* DVt = (bf16_t*)(p.ws + WS_DVT); bf16_t* NAVt = (bf16_t*)(p.ws + WS_NAVT);
    for (int ph = p.ph_lo; ph < p.ph_hi; ++ph) {
        bool is_gemm = false; pg8::Gemm g{nullptr, nullptr, 0, 0, 0}; pg8::EpiAct E{nullptr, 0, 0};
        if (ph == 0) { if (EN(0)) { ph_mod(p, lds); ph_wconv(p, lds, 0); } }
        else if (ph == 1) { if (EN(1)) row_pass(p, 0, 0); }
        else {
            const int l = (ph - 2) / 9, s = (ph - 2) % 9;
            const bool need_ctx = (l + 1 < DEPTH);
            const int Mpost = need_ctx ? MTOT : MLAT;
            if (s == 0) { is_gemm = true; g = pg8::Gemm{XN, (const bf16_t*)(p.ws + WS_WIN), MTOT, INWP, D}; E = pg8::EpiAct{P, INWP, 0}; }
            else if (s == 4) { is_gemm = true; g = pg8::Gemm{MIX, (const bf16_t*)(p.ws + WS_WOUT), Mpost, D, D}; E = pg8::EpiAct{YB, D, 0}; }
            else if (s == 6) { is_gemm = true; g = pg8::Gemm{XN, (const bf16_t*)(p.ws + WS_W1), Mpost, HID, D}; E = pg8::EpiAct{HB, HID, 1}; }
            else if (s == 7) { is_gemm = true; g = pg8::Gemm{HB, (const bf16_t*)(p.ws + WS_W2), Mpost, D, HID}; E = pg8::EpiAct{YB, D, 0}; }
            else if (s == 1 && EN(2)) {
                rope_rows(p);
                vtrans_loop<128>(lds, P, DIFF_OFF + 2048, DVt, bx, G);
                vtrans_loop<64>(lds, P, 1024, NAVt, bx, G);
                const float* wg = p.gla_w_gate + (size_t)l * 2 * 16 * 256; const float* bg = p.gla_b_gate + (size_t)l * 2 * 256;
                for (int it = bx; it < NB * NTILE * 4; it += G) { const int h = it & 3, c = (it >> 2) % NTILE, b = it / (4 * NTILE); gla_g1_item(lds, P, wg, bg, GS, GD, b, c, h); }
            }
            else if (s == 2 && EN(3)) {
                if (EN(11)) gla_scan(GS, GD);
                const float* relb = p.na_rel_bias + (size_t)l * 8 * 465;
                const int nq = need_ctx ? 260 : 256;
                if (EN(10)) for (int it = bx; it < NB * 2 * nq; it += G) { int hg, qblk, b;
                    if (it < NB * 2 * 256) {
                        if (G == 256) { const int u = (it >> 8) * 32 + (bx >> 3), x = bx & 7; hg = u & 1; qblk = (x & 3) * 64 + (u >> 1); b = x >> 2; }
                        else { hg = it & 1; qblk = (it >> 1) & 255; b = it >> 9; } }
                    else { const int r = it - NB * 2 * 256; hg = r & 1; qblk = 256 + ((r >> 1) & 3); b = r >> 3; }
                    na_unit(lds, P, NAVt, MIX, relb, b, hg, qblk); }
            }
            else if (s == 3 && EN(4)) {
                const float* wg = p.gla_w_gate + (size_t)l * 2 * 16 * 256; const float* bg = p.gla_b_gate + (size_t)l * 2 * 256;
                const int nc = need_ctx ? NTILE : 256;
                if (EN(8)) for (int it = bx; it < NB * nc * 4; it += G) { const int h = it & 3, c = (it >> 2) % nc, b = it / (4 * nc); gla_g3_item(lds, P, wg, bg, GS, p.gla_g_norm + l * 128, MIX, b, c, h); }
                const float* lp = p.diff_lambda + (size_t)l * 4 * 64;
                float d01 = 0.f, d23 = 0.f;
                for (int i = 0; i < 64; ++i) { d01 += lp[i] * lp[64 + i]; d23 += lp[128 + i] * lp[192 + i]; }
                const float lam_init = 0.8f - 0.6f * __expf(-0.3f * (float)l);
                const float lam = __expf(d01) - __expf(d23) + lam_init;
                const int nqb = need_ctx ? 130 : 128;
                if (EN(9)) for (int it = bx; it < NB * 8 * nqb; it += G) {
                    int qb, h, b;
                    if (it < NB * 8 * 128) { qb = it & 127; h = (it >> 7) & 7; b = it >> 10; }
                    else { const int r = it - NB * 8 * 128; qb = 128 + (r & 1); h = (r >> 1) & 7; b = r >> 4; }
                    const bool isctx = qb >= 128;
                    diff_unit(lds, DQ, DK, DVt, MIX, b, h, qb * 128, isctx ? 256 : 0, NTILE, lam, p.diff_g_norm + l * 128, 1.f - lam_init);
                }
            }
            else if (s == 5 && EN(5)) { row_pass(p, l, 1); }
            else if (s == 8 && EN(6)) { row_pass(p, l, 2); if (l + 1 < DEPTH) ph_wconv(p, lds, l + 1); }
        }
        if (is_gemm && EN(7)) { pg8::StaticOrder S; S.init(g.M, g.N, G, bx); pg8::gemm_phase<pg8::EpiAct, pg8::StaticOrder, true, true>(lds, g, S, E); }
        if (ph + 1 < p.ph_hi) { if (ph == 0) grid.sync(); else xcd_barrier(xbar); }
    }

}

extern "C" void kernel_launch(void* const* d_in, const int* in_sizes, int n_in, void* d_out, int out_size, void* d_ws, size_t ws_size, hipStream_t stream) {
    static int grid = 0;
    if (grid == 0) {
        if (n_in != 20 || in_sizes[0] != MLAT * D || out_size != MLAT * D || ws_size < WS_END) {
            fprintf(stderr, "kernel_launch: unexpected shapes (n_in %d, in0 %d, out %d, ws %zu); nothing launched\n", n_in, n_in > 0 ? in_sizes[0] : -1, out_size, ws_size); grid = -1; return; }
        int dev = 0, cus = 0, per_cu = 0;
        if (hipGetDevice(&dev) != hipSuccess || hipDeviceGetAttribute(&cus, hipDeviceAttributeMultiprocessorCount, dev) != hipSuccess) { grid = -1; return; }
        if (hipFuncSetAttribute((const void*)fwd_kernel, hipFuncAttributeMaxDynamicSharedMemorySize, LDS_BYTES) != hipSuccess) { fprintf(stderr, "kernel_launch: hipFuncSetAttribute failed\n"); grid = -1; return; }
        if (hipOccupancyMaxActiveBlocksPerMultiprocessor(&per_cu, (const void*)fwd_kernel, 512, LDS_BYTES) != hipSuccess || per_cu < 1) { fprintf(stderr, "kernel_launch: occupancy query gave %d\n", per_cu); per_cu = 1; }
        (void)hipGetLastError();
        grid = cus * per_cu;
    }
    if (grid < 0) return;
    (void)hipMemsetAsync(d_ws, 0, WS_ZERO_BYTES, stream);
    Params p{};
    const float** pp = (const float**)&p;
    for (int i = 0; i < 20; ++i) pp[i] = (const float*)d_in[i];
    p.out = (float*)d_out; p.ws = (unsigned char*)d_ws; p.ph_lo = 0; p.ph_hi = NPH;
    void* args[] = {&p};
    hipError_t e = hipLaunchCooperativeKernel((const void*)fwd_kernel, dim3(grid), dim3(512), args, LDS_BYTES, stream);
    if (e != hipSuccess) fprintf(stderr, "cooperative launch failed: %s (grid %d)\n", hipGetErrorString(e), grid);
}
```
